# Optimizing an MI355X kernel written in HIP

```python
import math
import jax, jax.numpy as jnp
from jax import lax
import numpy as np

D_MODEL = 1024
BATCH = 2
SEQ = 8192
DEPTH = 2

PLE_DIM = 256
NSA_HEADS = 8
NSA_KV_GROUPS = 2
NSA_HEAD_DIM = 64
NSA_HPG = NSA_HEADS // NSA_KV_GROUPS
NSA_Q_W = NSA_HEADS * NSA_HEAD_DIM
NSA_KV_W = NSA_KV_GROUPS * NSA_HEAD_DIM
CMP_BLOCK = 32
CMP_STRIDE = 16
CMP_HIDDEN = 256
SEL_BLOCK = 64
SEL_TOPN = 16
WINDOW = 512
Q_BLOCK = 128
FORCE_SCORE = 1e4
MASK_VALUE = -1e30
SSD_HEADS = 8
SSD_HEAD_DIM = 64
SSD_INNER = SSD_HEADS * SSD_HEAD_DIM
SSD_GROUPS = 2
SSD_STATE = 64
SSD_CHUNK = 128
SSD_XBC_W = SSD_INNER + 2 * SSD_GROUPS * SSD_STATE
CONV_WIDTH = 4
LRU_WIDTH = 512
LRU_BLOCKS = 8
LRU_BLOCK_DIM = LRU_WIDTH // LRU_BLOCKS
LRU_C = 8.0
N_EXPERTS = 16
N_EXPERT_GROUPS = 4
EXPERTS_PER_GROUP = N_EXPERTS // N_EXPERT_GROUPS
TOP_K = 2
D_EXPERT = 256
ALPHA = (2 * DEPTH) ** 0.25
BETA = (8 * DEPTH) ** -0.25
LN_EPS = 1e-5
RMS_EPS = 1e-5
IN_SIZES = (NSA_Q_W, NSA_KV_W, NSA_KV_W, NSA_KV_W, NSA_KV_W, NSA_KV_W, NSA_KV_W, NSA_HEADS * 3,
            SSD_INNER, SSD_XBC_W, SSD_HEADS, LRU_WIDTH, LRU_WIDTH, 3 * D_MODEL)
IN_WIDTH = sum(IN_SIZES)

kernel_name = 'hybrid_nsa_ssd_rglru_moe_block'


def layer_norm(x, g, b):
    xf = x.astype(jnp.float32)
    mu = jnp.mean(xf, -1, keepdims=True)
    xc = xf - mu
    var = jnp.mean(xc * xc, -1, keepdims=True)
    return (xc * lax.rsqrt(var + LN_EPS) * g.astype(jnp.float32) + b.astype(jnp.float32)).astype(x.dtype)


def rms_norm(x, w):
    xf = x.astype(jnp.float32)
    ms = jnp.mean(xf * xf, -1, keepdims=True)
    return (xf * lax.rsqrt(ms + RMS_EPS) * w.astype(jnp.float32)).astype(x.dtype)


def causal_depthwise_conv(x, w, b):
    width = w.shape[0]
    S = x.shape[1]
    xp = jnp.pad(x, ((0, 0), (width - 1, 0), (0, 0)))
    y = b
    for k in range(width):
        y = y + xp[:, k:k + S] * w[k]
    return y


def masked_softmax(s, mask):
    s = jnp.where(mask, s.astype(jnp.float32), MASK_VALUE)
    m = jnp.max(s, -1, keepdims=True)
    e = jnp.where(mask, jnp.exp(s - m), 0.0)
    return e / jnp.maximum(jnp.sum(e, -1, keepdims=True), 1e-30)


def nsa_compress(kv, pe, w1, w2):
    Bsz, S, G, dk = kv.shape
    n_cmp = (S - CMP_BLOCK) // CMP_STRIDE + 1
    idx = np.arange(n_cmp)[:, None] * CMP_STRIDE + np.arange(CMP_BLOCK)[None, :]
    blk = kv[:, idx] + pe[None, None, :, None, :]
    blk = jnp.transpose(blk, (0, 1, 3, 2, 4)).reshape(Bsz, n_cmp, G, CMP_BLOCK * dk)
    return jax.nn.gelu(blk @ w1) @ w2


def nsa_attention(q, k_cmp, v_cmp, k_sel, v_sel, k_win, v_win, gate_logits,
                  pe_k, w1_k, w2_k, pe_v, w1_v, w2_v):
    Bsz, S = q.shape[:2]
    G, Hg, dk = NSA_KV_GROUPS, NSA_HPG, NSA_HEAD_DIM
    scale = dk ** -0.5
    q = q.reshape(Bsz, S, G, Hg, dk)
    k_cmp, v_cmp, k_sel, v_sel, k_win, v_win = [a.reshape(Bsz, S, G, dk) for a in (k_cmp, v_cmp, k_sel, v_sel, k_win, v_win)]
    t = jnp.arange(S)
    kc = nsa_compress(k_cmp, pe_k, w1_k, w2_k)
    vc = nsa_compress(v_cmp, pe_v, w1_v, w2_v)
    n_cmp = kc.shape[1]
    s_cmp = jnp.einsum('bsgjd,bngd->bgjsn', q, kc) * scale
    cmp_mask = (jnp.arange(n_cmp) * CMP_STRIDE + CMP_BLOCK - 1)[None, :] <= t[:, None]
    p_cmp = masked_softmax(s_cmp, cmp_mask)
    o_cmp = jnp.einsum('bgjsn,bngd->bsgjd', p_cmp, vc)
    n_sel = S // SEL_BLOCK
    ratio = SEL_BLOCK // CMP_STRIDE
    strides = np.arange(n_cmp)[:, None] + np.arange(CMP_BLOCK // CMP_STRIDE)[None, :]
    overlap = jnp.sum(jax.nn.one_hot(strides // ratio, n_sel, dtype=jnp.float32), axis=1)
    imp = jnp.einsum('bgjsn,nm->bgsm', p_cmp, overlap)
    blk = jnp.arange(n_sel)
    cur = t // SEL_BLOCK
    forced = (blk[None, :] == 0) | (blk[None, :] == cur[:, None]) | (blk[None, :] == cur[:, None] - 1)
    causal_blk = blk[None, :] * SEL_BLOCK <= t[:, None]
    imp = jnp.where(forced, FORCE_SCORE, jnp.where(causal_blk, imp, -1.0))
    n_top = min(SEL_TOPN, n_sel)
    _, sel_idx = lax.top_k(imp, n_top)
    ks_blocks = k_sel.reshape(Bsz, n_sel, SEL_BLOCK, G, dk).transpose(0, 3, 1, 2, 4)
    vs_blocks = v_sel.reshape(Bsz, n_sel, SEL_BLOCK, G, dk).transpose(0, 3, 1, 2, 4)
    kw_pad = jnp.pad(k_win, ((0, 0), (WINDOW, 0), (0, 0), (0, 0)))
    vw_pad = jnp.pad(v_win, ((0, 0), (WINDOW, 0), (0, 0), (0, 0)))
    bi = jnp.arange(Bsz)[:, None, None, None]
    gi = jnp.arange(G)[None, :, None, None]
    n_qb = S // Q_BLOCK
    q_blocks = q.reshape(Bsz, n_qb, Q_BLOCK, G, Hg, dk).transpose(1, 0, 2, 3, 4, 5)
    idx_blocks = sel_idx.reshape(Bsz, G, n_qb, Q_BLOCK, n_top).transpose(2, 0, 1, 3, 4)
    win_len = WINDOW + Q_BLOCK

    def block_fn(args):
        qb, idxb, t0 = args
        tq = t0 + jnp.arange(Q_BLOCK)
        ksg = ks_blocks[bi, gi, idxb]
        vsg = vs_blocks[bi, gi, idxb]
        s = jnp.einsum('bqgjd,bgqkld->bgjqkl', qb, ksg) * scale
        s = s.reshape(Bsz, G, Hg, Q_BLOCK, n_top * SEL_BLOCK)
        pos = idxb[..., None] * SEL_BLOCK + jnp.arange(SEL_BLOCK)
        smask = (pos <= tq[None, None, :, None, None]).reshape(Bsz, G, 1, Q_BLOCK, n_top * SEL_BLOCK)
        ps = masked_softmax(s, smask)
        o_s = jnp.einsum('bgjqm,bgqmd->bqgjd', ps, vsg.reshape(Bsz, G, Q_BLOCK, n_top * SEL_BLOCK, dk))
        kw = lax.dynamic_slice_in_dim(kw_pad, t0, win_len, axis=1)
        vw = lax.dynamic_slice_in_dim(vw_pad, t0, win_len, axis=1)
        sw = jnp.einsum('bqgjd,bmgd->bgjqm', qb, kw) * scale
        kpos = t0 - WINDOW + jnp.arange(win_len)
        diff = tq[:, None] - kpos[None, :]
        wmask = (diff >= 0) & (diff < WINDOW) & (kpos[None, :] >= 0)
        pw = masked_softmax(sw, wmask)
        o_w = jnp.einsum('bgjqm,bmgd->bqgjd', pw, vw)
        return o_s, o_w

    o_slc, o_win = lax.map(block_fn, (q_blocks, idx_blocks, jnp.arange(n_qb) * Q_BLOCK))
    o_slc = o_slc.transpose(1, 0, 2, 3, 4, 5).reshape(Bsz, S, G, Hg, dk)
    o_win = o_win.transpose(1, 0, 2, 3, 4, 5).reshape(Bsz, S, G, Hg, dk)
    g = jax.nn.sigmoid(gate_logits.reshape(Bsz, S, G, Hg, 3))
    o = g[..., 0:1] * o_cmp + g[..., 1:2] * o_slc + g[..., 2:3] * o_win
    return o.reshape(Bsz, S, NSA_Q_W)


def segsum(a):
    T = a.shape[-1]
    ae = jnp.broadcast_to(a[..., None], a.shape + (T,))
    ae = jnp.where(jnp.tril(jnp.ones((T, T), bool), -1), ae, 0.0)
    cs = jnp.cumsum(ae, axis=-2)
    return jnp.where(jnp.tril(jnp.ones((T, T), bool)), cs, -jnp.inf)


def ssd_chunked(x, dt, A, Bm, Cm):
    Bsz, S, H, P = x.shape
    G, N = Bm.shape[2], Bm.shape[3]
    Hg = H // G
    L = SSD_CHUNK
    nc = S // L
    a = (dt * A).reshape(Bsz, nc, L, H).transpose(0, 3, 1, 2)
    a_cum = jnp.cumsum(a, axis=-1)
    X = (x * dt[..., None]).reshape(Bsz, nc, L, G, Hg, P)
    Bc = Bm.reshape(Bsz, nc, L, G, N)
    Cc = Cm.reshape(Bsz, nc, L, G, N)
    Lmat = jnp.exp(segsum(a)).reshape(Bsz, G, Hg, nc, L, L)
    CB = jnp.einsum('bclgn,bcsgn->bcgls', Cc, Bc)
    y_diag = jnp.einsum('bcgls,bgjcls,bcsgjp->bclgjp', CB, Lmat, X)
    decay_states = jnp.exp(a_cum[..., -1:] - a_cum).reshape(Bsz, G, Hg, nc, L)
    states = jnp.einsum('bclgn,bgjcl,bclgjp->bcgjpn', Bc, decay_states, X)
    a_chunk = jnp.pad(a_cum[..., -1], ((0, 0), (0, 0), (1, 0)))
    decay_chunk = jnp.exp(segsum(a_chunk)).reshape(Bsz, G, Hg, nc + 1, nc + 1)
    states0 = jnp.concatenate([jnp.zeros_like(states[:, :1]), states], axis=1)
    new_states = jnp.einsum('bgjzc,bcgjpn->bzgjpn', decay_chunk, states0)
    prev_states = new_states[:, :-1]
    decay_out = jnp.exp(a_cum).reshape(Bsz, G, Hg, nc, L)
    y_off = jnp.einsum('bclgn,bcgjpn,bgjcl->bclgjp', Cc, prev_states, decay_out)
    return (y_diag + y_off).reshape(Bsz, S, H, P)


def ssd_mixer(z, xbc, dt_raw, conv_w, conv_b, dt_bias, a_log, d_skip, norm_w):
    Bsz, S = z.shape[:2]
    xbc = jax.nn.silu(causal_depthwise_conv(xbc, conv_w, conv_b))
    xs, Bm, Cm = jnp.split(xbc, [SSD_INNER, SSD_INNER + SSD_GROUPS * SSD_STATE], axis=-1)
    xs = xs.reshape(Bsz, S, SSD_HEADS, SSD_HEAD_DIM)
    Bm = Bm.reshape(Bsz, S, SSD_GROUPS, SSD_STATE)
    Cm = Cm.reshape(Bsz, S, SSD_GROUPS, SSD_STATE)
    dt = jax.nn.softplus(dt_raw + dt_bias)
    A = -jnp.exp(a_log)
    y = ssd_chunked(xs, dt, A, Bm, Cm) + d_skip[:, None] * xs
    y = y.reshape(Bsz, S, SSD_INNER) * jax.nn.silu(z)
    return rms_norm(y, norm_w)


def lru_combine(c1, c2):
    a1, b1 = c1
    a2, b2 = c2
    return a1 * a2, a2 * b1 + b2


def rglru_mixer(xr, yr, conv_w, conv_b, wa, ba, wx, bx, lam):
    Bsz, S = xr.shape[:2]
    xr = causal_depthwise_conv(xr, conv_w, conv_b)
    xb = xr.reshape(Bsz, S, LRU_BLOCKS, LRU_BLOCK_DIM)
    r = jax.nn.sigmoid(jnp.einsum('bsnc,ncd->bsnd', xb, wa).reshape(Bsz, S, LRU_WIDTH) + ba)
    i = jax.nn.sigmoid(jnp.einsum('bsnc,ncd->bsnd', xb, wx).reshape(Bsz, S, LRU_WIDTH) + bx)
    log_a = -LRU_C * r * jax.nn.softplus(-lam)
    a = jnp.exp(log_a)
    b = jnp.sqrt(-jnp.expm1(2.0 * log_a)) * (i * xr)
    _, h = lax.associative_scan(lru_combine, (a, b), axis=1)
    return h * jax.nn.gelu(yr)


def moe(x, router_w, router_b, w_gate, w_up, w_down):
    Bsz, S, D = x.shape
    xt = x.reshape(-1, D)
    aff = jax.nn.sigmoid((xt @ router_w).astype(jnp.float32))
    sel = aff + router_b.astype(jnp.float32)
    grp_score = jnp.sum(lax.top_k(sel.reshape(-1, N_EXPERT_GROUPS, EXPERTS_PER_GROUP), TOP_K)[0], axis=-1)
    best = jnp.argmax(grp_score, axis=-1)
    in_grp = (jnp.arange(N_EXPERTS) // EXPERTS_PER_GROUP)[None, :] == best[:, None]
    _, top_idx = lax.top_k(jnp.where(in_grp, sel, -jnp.inf), TOP_K)
    w = jnp.take_along_axis(aff, top_idx, axis=-1)
    w = w / jnp.sum(w, -1, keepdims=True)
    gates = jnp.sum(jax.nn.one_hot(top_idx, N_EXPERTS, dtype=jnp.float32) * w[..., None], axis=1)
    h = jax.nn.silu(jnp.einsum('td,edf->etf', xt, w_gate)) * jnp.einsum('td,edf->etf', xt, w_up)
    h = h * gates.T[:, :, None].astype(h.dtype)
    return jnp.einsum('etf,efd->td', h, w_down).reshape(Bsz, S, D)


def setup_inputs(seed: int = 0) -> dict:
    key = jax.random.key(seed)
    ks = iter(jax.random.split(key, 48))

    def nrm(shape, scale):
        return jax.random.normal(next(ks), shape, jnp.float32) * scale

    def unif(shape, lo, hi):
        return jax.random.uniform(next(ks), shape, jnp.float32, lo, hi)

    dk = NSA_HEAD_DIM
    dt0 = jnp.exp(unif((DEPTH, SSD_HEADS), math.log(1e-3), math.log(1e-1)))
    a0 = unif((DEPTH, LRU_WIDTH), 0.9, 0.999) ** (1.0 / LRU_C)
    return {
        'x': nrm((BATCH, SEQ, D_MODEL), 1.0),
        'p': nrm((DEPTH, BATCH, SEQ, PLE_DIM), 1.0),
        'w_in': nrm((DEPTH, D_MODEL, IN_WIDTH), D_MODEL ** -0.5),
        'nsa_pe_k': nrm((DEPTH, CMP_BLOCK, dk), 0.1),
        'nsa_w1_k': nrm((DEPTH, CMP_BLOCK * dk, CMP_HIDDEN), (CMP_BLOCK * dk) ** -0.5),
        'nsa_w2_k': nrm((DEPTH, CMP_HIDDEN, dk), CMP_HIDDEN ** -0.5),
        'nsa_pe_v': nrm((DEPTH, CMP_BLOCK, dk), 0.1),
        'nsa_w1_v': nrm((DEPTH, CMP_BLOCK * dk, CMP_HIDDEN), (CMP_BLOCK * dk) ** -0.5),
        'nsa_w2_v': nrm((DEPTH, CMP_HIDDEN, dk), CMP_HIDDEN ** -0.5),
        'ssd_conv_w': nrm((DEPTH, CONV_WIDTH, SSD_XBC_W), CONV_WIDTH ** -0.5),
        'ssd_conv_b': nrm((DEPTH, SSD_XBC_W), 0.02),
        'ssd_dt_bias': dt0 + jnp.log(-jnp.expm1(-dt0)),
        'ssd_a_log': jnp.log(unif((DEPTH, SSD_HEADS), 1.0, 16.0)),
        'ssd_d': 1.0 + nrm((DEPTH, SSD_HEADS), 0.1),
        'ssd_norm_w': 1.0 + nrm((DEPTH, SSD_INNER), 0.1),
        'lru_conv_w': nrm((DEPTH, CONV_WIDTH, LRU_WIDTH), CONV_WIDTH ** -0.5),
        'lru_conv_b': nrm((DEPTH, LRU_WIDTH), 0.02),
        'lru_wa': nrm((DEPTH, LRU_BLOCKS, LRU_BLOCK_DIM, LRU_BLOCK_DIM), LRU_BLOCK_DIM ** -0.5),
        'lru_ba': nrm((DEPTH, LRU_WIDTH), 0.02),
        'lru_wx': nrm((DEPTH, LRU_BLOCKS, LRU_BLOCK_DIM, LRU_BLOCK_DIM), LRU_BLOCK_DIM ** -0.5),
        'lru_bx': nrm((DEPTH, LRU_WIDTH), 0.02),
        'lru_lambda': jnp.log(a0) - jnp.log1p(-a0),
        'proj_nsa': nrm((DEPTH, NSA_Q_W, D_MODEL), NSA_Q_W ** -0.5),
        'proj_ssd': nrm((DEPTH, SSD_INNER, D_MODEL), SSD_INNER ** -0.5),
        'proj_lru': nrm((DEPTH, LRU_WIDTH, D_MODEL), LRU_WIDTH ** -0.5),
        'w_out': nrm((DEPTH, D_MODEL, D_MODEL), D_MODEL ** -0.5 * BETA),
        'ln1_g': 1.0 + nrm((DEPTH, D_MODEL), 0.05),
        'ln1_b': nrm((DEPTH, D_MODEL), 0.02),
        'router_w': nrm((D_MODEL, N_EXPERTS), D_MODEL ** -0.5),
        'router_b': nrm((N_EXPERTS,), 0.01),
        'exp_w_gate': nrm((DEPTH, N_EXPERTS, D_MODEL, D_EXPERT), D_MODEL ** -0.5),
        'exp_w_up': nrm((DEPTH, N_EXPERTS, D_MODEL, D_EXPERT), D_MODEL ** -0.5),
        'exp_w_down': nrm((DEPTH, N_EXPERTS, D_EXPERT, D_MODEL), D_EXPERT ** -0.5 * BETA),
        'ple_w_gate': nrm((DEPTH, D_MODEL, D_MODEL), D_MODEL ** -0.5),
        'ple_w_proj': nrm((DEPTH, PLE_DIM, D_MODEL), PLE_DIM ** -0.5 * BETA),
        'ln2_g': 1.0 + nrm((DEPTH, D_MODEL), 0.05),
        'ln2_b': nrm((DEPTH, D_MODEL), 0.02),
    }


def reference(x, p, w_in, nsa_pe_k, nsa_w1_k, nsa_w2_k, nsa_pe_v, nsa_w1_v, nsa_w2_v,
              ssd_conv_w, ssd_conv_b, ssd_dt_bias, ssd_a_log, ssd_d, ssd_norm_w,
              lru_conv_w, lru_conv_b, lru_wa, lru_ba, lru_wx, lru_bx, lru_lambda,
              proj_nsa, proj_ssd, proj_lru, w_out, ln1_g, ln1_b,
              router_w, router_b, exp_w_gate, exp_w_up, exp_w_down,
              ple_w_gate, ple_w_proj, ln2_g, ln2_b):
    offsets = np.cumsum(IN_SIZES)[:-1].tolist()
    for i in range(DEPTH):
        proj = x @ w_in[i]
        (q, k_cmp, v_cmp, k_sel, v_sel, k_win, v_win, nsa_gate,
         ssd_z, ssd_xbc, ssd_dt, lru_x, lru_y, merge) = jnp.split(proj, offsets, axis=-1)
        o_nsa = nsa_attention(q, k_cmp, v_cmp, k_sel, v_sel, k_win, v_win, nsa_gate,
                              nsa_pe_k[i], nsa_w1_k[i], nsa_w2_k[i], nsa_pe_v[i], nsa_w1_v[i], nsa_w2_v[i])
        o_ssd = ssd_mixer(ssd_z, ssd_xbc, ssd_dt, ssd_conv_w[i], ssd_conv_b[i], ssd_dt_bias[i],
                          ssd_a_log[i], ssd_d[i], ssd_norm_w[i])
        o_lru = rglru_mixer(lru_x, lru_y, lru_conv_w[i], lru_conv_b[i], lru_wa[i], lru_ba[i],
                            lru_wx[i], lru_bx[i], lru_lambda[i])
        g_nsa, g_ssd, g_lru = jnp.split(jax.nn.sigmoid(merge), 3, axis=-1)
        mixed = g_nsa * (o_nsa @ proj_nsa[i]) + g_ssd * (o_ssd @ proj_ssd[i]) + g_lru * (o_lru @ proj_lru[i])
        x = layer_norm(ALPHA * x + mixed @ w_out[i], ln1_g[i], ln1_b[i])
        ple = jax.nn.sigmoid(x @ ple_w_gate[i]) * (p[i] @ ple_w_proj[i])
        y = moe(x, router_w, router_b, exp_w_gate[i], exp_w_up[i], exp_w_down[i])
        x = layer_norm(ALPHA * x + y + ple, ln2_g[i], ln2_b[i])
    return x
```

```cpp
#include <hip/hip_runtime.h>
#include <hip/hip_cooperative_groups.h>
#include <cstdio>
#include <cstdint>
namespace cg = cooperative_groups;

#define LAS __attribute__((address_space(3)))
typedef unsigned short bf16_t;
typedef short bf16x8 __attribute__((ext_vector_type(8)));
typedef float f32x4 __attribute__((ext_vector_type(4)));
typedef float f32x2 __attribute__((ext_vector_type(2)));
typedef unsigned u32x4 __attribute__((ext_vector_type(4)));
typedef unsigned u32x2 __attribute__((ext_vector_type(2)));

constexpr int D_MODEL = 1024, BATCH = 2, SEQ = 8192, DEPTH = 2, TOK = BATCH * SEQ;
constexpr int PLE_DIM = 256;
constexpr int IN_WIDTH = 6688;
constexpr int N_EXPERTS = 16, D_EXPERT = 256;
constexpr float ALPHA = 1.4142135623730951f;
constexpr float LN_EPS = 1e-5f, RMS_EPS = 1e-5f;
constexpr int NWAVES = 8, NTHREADS = 512;

__device__ __forceinline__ float bf2f(unsigned h) { return __uint_as_float(h << 16); }
__device__ __forceinline__ unsigned f2bf(float f) { unsigned u = __float_as_uint(f); return (u + 0x7fffu + ((u >> 16) & 1u)) >> 16; }
__device__ __forceinline__ unsigned pk2(float lo, float hi) { return f2bf(lo) | (f2bf(hi) << 16); }
__device__ __forceinline__ float sigmoidf_(float x) { return 1.0f / (1.0f + __expf(-x)); }
__device__ __forceinline__ float siluf_(float x) { return x / (1.0f + __expf(-x)); }
__device__ __forceinline__ float gelu_tanh(float x) { const float u = 0.7978845608028654f * (x + 0.044715f * x * x * x); const float t = 1.0f - 2.0f / (1.0f + __expf(2.0f * u)); return 0.5f * x * (1.0f + t); }
__device__ __forceinline__ float softplusf_(float x) { return x > 20.f ? x : log1pf(__expf(x)); }
__device__ __forceinline__ float shx(float v, int o, int lane) { return __int_as_float(__builtin_amdgcn_ds_bpermute((lane ^ o) << 2, __float_as_int(v))); }
__device__ __forceinline__ int shxi(int v, int o, int lane) { return __builtin_amdgcn_ds_bpermute((lane ^ o) << 2, v); }
__device__ __forceinline__ float wave_sum(float v, int lane) {
#pragma unroll
    for (int o = 1; o < 64; o <<= 1) v += shx(v, o, lane);
    return v;
}
__device__ __forceinline__ float wave_max(float v, int lane) {
#pragma unroll
    for (int o = 1; o < 64; o <<= 1) v = fmaxf(v, shx(v, o, lane));
    return v;
}
__device__ __forceinline__ int tid_fresh(int wave0) { unsigned m = ~0u; asm volatile("" : "+s"(m)); const int l = (int)__builtin_amdgcn_mbcnt_hi(m, __builtin_amdgcn_mbcnt_lo(m, 0u)); return wave0 * 64 + l; }
namespace pg8 {
#define PG8_LAS __attribute__((address_space(3)))
typedef unsigned short bf16_t;
typedef short bf16x8 __attribute__((ext_vector_type(8)));
typedef float f32x4 __attribute__((ext_vector_type(4)));
typedef unsigned u32x4 __attribute__((ext_vector_type(4)));
constexpr int BM = 256, BK = 64, HALF = 128, HTB = HALF * BK * 2  , STAGE_BYTES = 8 * HTB, NXCD = 8, WGM = 8;

__host__ __device__ __forceinline__ int lds_byte(int r, int c) { const int st = (r >> 4) * 2 + (c >> 5), rr = r & 15, cc = c & 31, ob = rr * 64 + cc * 2; return st * 1024 + (ob ^ (((ob >> 9) & 1) << 5)); }
__host__ __device__ __forceinline__ void stage_rc(int b, int& R, int& C) { const int st = b / 1024, sb = b % 1024, swz = sb ^ (((sb >> 9) & 1) << 5); R = (st >> 1) * 16 + swz / 64; C = (st & 1) * 32 + (swz % 64) / 2; }
__host__ __device__ __forceinline__ int perm32(int rho) { const int n = rho >> 4, i = rho & 15; return 8 * (i >> 2) + 4 * n + (i & 3); }

struct Unit { int pm, pn; };
struct Gemm { const bf16_t* A; const bf16_t* Bt; int M, N, K, lda, ldb; };

struct StaticOrder {
    int nM, nN, nwg, G, c;
    __host__ __device__ __forceinline__ void init(int M, int N, int G_, int c_) { nM = M / BM; nN = N / BM; nwg = nM * nN; G = G_; c = c_; }
    __host__ __device__ __forceinline__ bool next(int i, Unit& u) const {
        const long L = (long)i * G + c; if (L >= nwg) return false;
        int wgid = (int)L; { const int q = nwg / NXCD, r = nwg % NXCD, xcd = wgid % NXCD, off = wgid / NXCD; wgid = (xcd < r ? xcd * (q + 1) : r * (q + 1) + (xcd - r) * q) + off; }
        const int nig = WGM * nN, gid = wgid / nig, fm = gid * WGM, gsz = (nM - fm) < WGM ? (nM - fm) : WGM;
        u.pm = fm + ((wgid % nig) % gsz); u.pn = (wgid % nig) / gsz; return true;
    }
    __device__ __forceinline__ void a_ready(const Unit&) const {}
    __device__ __forceinline__ void done(const Unit&) const {}
};

__device__ __forceinline__ int lane_fresh() { unsigned m = ~0u; asm volatile("" : "+s"(m)); return (int)__builtin_amdgcn_mbcnt_hi(m, __builtin_amdgcn_mbcnt_lo(m, 0u)); }
typedef __bf16 bf16x2_t_ __attribute__((ext_vector_type(2)));
__device__ __forceinline__ unsigned cvt_pk_bf16(float lo, float hi) { f32x2 v = {lo, hi}; bf16x2_t_ b = __builtin_convertvector(v, bf16x2_t_); return __builtin_bit_cast(unsigned, b); }
__device__ __forceinline__ u32x4 pack8(const f32x4 a, const f32x4 b) { u32x4 w; w.x = cvt_pk_bf16(a[0], a[1]); w.y = cvt_pk_bf16(a[2], a[3]); w.z = cvt_pk_bf16(b[0], b[1]); w.w = cvt_pk_bf16(b[2], b[3]); return w; }
__device__ __forceinline__ void unpack8(const u32x4 w, f32x4& a, f32x4& b) {
    a[0] = __uint_as_float(w.x << 16); a[1] = __uint_as_float(w.x & 0xffff0000u); a[2] = __uint_as_float(w.y << 16); a[3] = __uint_as_float(w.y & 0xffff0000u);
    b[0] = __uint_as_float(w.z << 16); b[1] = __uint_as_float(w.z & 0xffff0000u); b[2] = __uint_as_float(w.w << 16); b[3] = __uint_as_float(w.w & 0xffff0000u); }
__device__ __forceinline__ f32x4 sig4(const f32x4 v) { f32x4 o; o[0] = __builtin_amdgcn_rcpf(1.f + __expf(-v[0])); o[1] = __builtin_amdgcn_rcpf(1.f + __expf(-v[1])); o[2] = __builtin_amdgcn_rcpf(1.f + __expf(-v[2])); o[3] = __builtin_amdgcn_rcpf(1.f + __expf(-v[3])); return o; }

struct EpiInProj {
    static constexpr bool PERM = true, AFTER_DRAIN = false;
    bf16_t *Q, *KV, *Z, *XBC, *LX, *LY; float* SMALL; size_t kvstride;
    __device__ __forceinline__ void operator()(const f32x4 (&acc)[2][2][4][2], const Unit& u, int wr, int wc, int, int) const { const int ln_ = lane_fresh(), fr = ln_ & 15, fq = ln_ >> 4;
        const int pn = u.pn, row0 = u.pm * BM + wr * 64 + fr, cw = wc * 32 + 8 * fq;
        if (pn >= 2 && pn < 5) {
            const int g = cw >> 6, d = cw & 63;
#pragma unroll
            for (int bj = 0; bj < 2; ++bj) { bf16_t* base = KV + (size_t)((pn - 2) * 2 + bj) * kvstride;
                if (bj == 1 && pn >= 3) {
#pragma unroll
                    for (int ai = 0; ai < 2; ++ai)
#pragma unroll
                        for (int m = 0; m < 4; ++m) { const int r = row0 + ai * HALF + m * 16, b = r >> 13, s = r & (SEQ - 1); const u32x4 w = pack8(acc[ai][bj][m][0], acc[ai][bj][m][1]);
                            bf16_t* tp = base + ((size_t)((b * 2 + g) * 64 + d)) * SEQ + s;
                            tp[0] = (bf16_t)(w.x & 0xffffu); tp[SEQ] = (bf16_t)(w.x >> 16); tp[2 * SEQ] = (bf16_t)(w.y & 0xffffu); tp[3 * SEQ] = (bf16_t)(w.y >> 16);
                            tp[4 * SEQ] = (bf16_t)(w.z & 0xffffu); tp[5 * SEQ] = (bf16_t)(w.z >> 16); tp[6 * SEQ] = (bf16_t)(w.w & 0xffffu); tp[7 * SEQ] = (bf16_t)(w.w >> 16); }
                } else {
#pragma unroll
                for (int ai = 0; ai < 2; ++ai)
#pragma unroll
                    for (int m = 0; m < 4; ++m) { const int r = row0 + ai * HALF + m * 16, b = r >> 13, s = r & (SEQ - 1);
                        *(u32x4*)(base + ((size_t)((b * 2 + g) * SEQ + s)) * 64 + d) = pack8(acc[ai][bj][m][0], acc[ai][bj][m][1]); } } }
        } else if (pn == 14) {
            if (wc == 0) {
#pragma unroll
                for (int ai = 0; ai < 2; ++ai)
#pragma unroll
                    for (int m = 0; m < 4; ++m) { const int r = row0 + ai * HALF + m * 16; float* p = SMALL + (size_t)r * 32 + 8 * fq;
                        *(f32x4*)p = acc[ai][0][m][0]; *(f32x4*)(p + 4) = acc[ai][0][m][1]; } }
        } else {
            bf16_t* dst; int pitch, cb;
            if (pn < 2) { dst = Q; pitch = 512; cb = pn * 256; }
            else if (pn < 7) { dst = Z; pitch = 512; cb = (pn - 5) * 256; }
            else if (pn < 10) { dst = XBC; pitch = 768; cb = (pn - 7) * 256; }
            else if (pn < 12) { dst = LX; pitch = 512; cb = (pn - 10) * 256; }
            else { dst = LY; pitch = 512; cb = (pn - 12) * 256; }
#pragma unroll
            for (int ai = 0; ai < 2; ++ai)
#pragma unroll
                for (int m = 0; m < 4; ++m) { bf16_t* rowp = dst + (size_t)(row0 + ai * HALF + m * 16) * pitch + cb + cw;
#pragma unroll
                    for (int bj = 0; bj < 2; ++bj) *(u32x4*)(rowp + bj * HALF) = pack8(acc[ai][bj][m][0], acc[ai][bj][m][1]); }
        }
    }
};
struct EpiSigBf16 {
    static constexpr bool PERM = true, AFTER_DRAIN = false;
    bf16_t* O; int ldc;
    __device__ __forceinline__ void operator()(const f32x4 (&acc)[2][2][4][2], const Unit& u, int wr, int wc, int, int) const { const int ln_ = lane_fresh(), fr = ln_ & 15, fq = ln_ >> 4;
        const int row0 = u.pm * BM + wr * 64 + fr, col0 = u.pn * BM + wc * 32 + 8 * fq;
#pragma unroll
        for (int ai = 0; ai < 2; ++ai)
#pragma unroll
            for (int m = 0; m < 4; ++m) { bf16_t* rowp = O + (size_t)(row0 + ai * HALF + m * 16) * ldc + col0;
#pragma unroll
                for (int bj = 0; bj < 2; ++bj) *(u32x4*)(rowp + bj * HALF) = pack8(sig4(acc[ai][bj][m][0]), sig4(acc[ai][bj][m][1])); }
    }
};
struct EpiMix {
    static constexpr bool PERM = true, AFTER_DRAIN = false;
    bf16_t* MIX; const bf16_t* G; int goff; int first; const float* SSQ;
    __device__ __forceinline__ void operator()(const f32x4 (&acc)[2][2][4][2], const Unit& u, int wr, int wc, int, int) const { const int ln_ = lane_fresh(), fr = ln_ & 15, fq = ln_ >> 4;
        const int row0 = u.pm * BM + wr * 64 + fr, col0 = u.pn * BM + wc * 32 + 8 * fq;
#pragma unroll
        for (int ai = 0; ai < 2; ++ai)
#pragma unroll
            for (int m = 0; m < 4; ++m) { const size_t r = (size_t)(row0 + ai * HALF + m * 16);
                float rs = 1.f; if (SSQ) { const f32x2 q2 = *(const f32x2*)(SSQ + r * 2); rs = 1.0f / sqrtf((q2[0] + q2[1]) * (1.f / 512.f) + 1e-5f); }
#pragma unroll
                for (int bj = 0; bj < 2; ++bj) { const int c = col0 + bj * HALF;
                    f32x4 g0, g1; unpack8(*(const u32x4*)(G + r * 3072 + goff + c), g0, g1);
                    f32x4 v0 = acc[ai][bj][m][0] * g0 * rs, v1 = acc[ai][bj][m][1] * g1 * rs;
                    if (!first) { f32x4 p0, p1; unpack8(*(const u32x4*)(MIX + r * 1024 + c), p0, p1); v0 += p0; v1 += p1; }
                    *(u32x4*)(MIX + r * 1024 + c) = pack8(v0, v1); }
                asm volatile("" ::: "memory"); }
    }
};
struct EpiResid {
    static constexpr bool PERM = false, AFTER_DRAIN = false;
    const float* XIN; float* XF; float alpha;
    __device__ __forceinline__ void operator()(const f32x4 (&acc)[2][2][4][2], const Unit& u, int wr, int wc, int, int) const { const int ln_ = lane_fresh(), fr = ln_ & 15, fq = ln_ >> 4;
        const int row0 = u.pm * BM + wr * 64 + fr, col0 = u.pn * BM + wc * 32 + 4 * fq;
#pragma unroll
        for (int ai = 0; ai < 2; ++ai)
#pragma unroll
            for (int m = 0; m < 4; ++m) { const size_t off = (size_t)(row0 + ai * HALF + m * 16) * 1024 + col0;
#pragma unroll
                for (int bj = 0; bj < 2; ++bj)
#pragma unroll
                    for (int n = 0; n < 2; ++n) { const size_t o = off + bj * HALF + n * 16; const f32x4 x = *(const f32x4*)(XIN + o); *(f32x4*)(XF + o) = x * alpha + acc[ai][bj][m][n]; }
                asm volatile("" ::: "memory"); }
    }
};
struct EpiSigNat {
    static constexpr bool PERM = false, AFTER_DRAIN = false;
    bf16_t* SG; float* XFDBG;
    __device__ __forceinline__ void operator()(const f32x4 (&acc)[2][2][4][2], const Unit& u, int wr, int wc, int, int) const { const int ln_ = lane_fresh(), fr = ln_ & 15, fq = ln_ >> 4;
        const int row0 = u.pm * BM + wr * 64 + fr, col0 = u.pn * BM + wc * 32 + 4 * fq;
#pragma unroll
        for (int ai = 0; ai < 2; ++ai)
#pragma unroll
            for (int m = 0; m < 4; ++m) { const size_t off = (size_t)(row0 + ai * HALF + m * 16) * 1024 + col0;
#pragma unroll
                for (int bj = 0; bj < 2; ++bj)
#pragma unroll
                    for (int n = 0; n < 2; ++n) { const f32x4 s = sig4(acc[ai][bj][m][n]); u32x2 w; w.x = cvt_pk_bf16(s[0], s[1]); w.y = cvt_pk_bf16(s[2], s[3]); *(u32x2*)(SG + off + bj * HALF + n * 16) = w;
#ifdef SIG_TO_XF
                        { float* xf = XFDBG + off + bj * HALF + n * 16; const f32x4 x = *(const f32x4*)xf; *(f32x4*)xf = x + s; }
#endif
                    } }
    }
};
struct EpiPleProj {
    static constexpr bool PERM = false, AFTER_DRAIN = false;
    float* XF; const bf16_t* SG; float alpha;
    __device__ __forceinline__ void operator()(const f32x4 (&acc)[2][2][4][2], const Unit& u, int wr, int wc, int, int) const { const int ln_ = lane_fresh(), fr = ln_ & 15, fq = ln_ >> 4;
        const int row0 = u.pm * BM + wr * 64 + fr, col0 = u.pn * BM + wc * 32 + 4 * fq;
#pragma unroll
        for (int ai = 0; ai < 2; ++ai)
#pragma unroll
            for (int m = 0; m < 4; ++m) { const size_t off = (size_t)(row0 + ai * HALF + m * 16) * 1024 + col0;
#pragma unroll
                for (int bj = 0; bj < 2; ++bj)
#pragma unroll
                    for (int n = 0; n < 2; ++n) { const size_t o = off + bj * HALF + n * 16; const u32x2 w = *(const u32x2*)(SG + o);
                        f32x4 s; s[0] = __uint_as_float(w.x << 16); s[1] = __uint_as_float(w.x & 0xffff0000u); s[2] = __uint_as_float(w.y << 16); s[3] = __uint_as_float(w.y & 0xffff0000u);

#ifdef PLE_NOSG
                        s = (f32x4){1.f, 1.f, 1.f, 1.f};
#endif
                        const f32x4 x = *(const f32x4*)(XF + o); *(f32x4*)(XF + o) = x * alpha + s * acc[ai][bj][m][n]; }
                asm volatile("" ::: "memory"); }
    }
};
struct EpiMoeUp {
    static constexpr bool PERM = true, AFTER_DRAIN = false;
    bf16_t* H; const float* GATES;
    __device__ __forceinline__ void operator()(const f32x4 (&acc)[2][2][4][2], const Unit& u, int wr, int wc, int, int) const { const int ln_ = lane_fresh(), fr = ln_ & 15, fq = ln_ >> 4;
        const int e = u.pn >> 1, hf = u.pn & 1, row0 = u.pm * BM + wr * 64 + fr, col0 = e * 256 + hf * 128 + wc * 32 + 8 * fq;
#pragma unroll
        for (int ai = 0; ai < 2; ++ai)
#pragma unroll
            for (int m = 0; m < 4; ++m) { const size_t r = (size_t)(row0 + ai * HALF + m * 16); const float gt = GATES[r * 16 + e];
                f32x4 h0, h1;
#pragma unroll
                for (int j = 0; j < 4; ++j) { const float a = acc[ai][0][m][0][j], b = acc[ai][0][m][1][j];
                    h0[j] = gt * (a * __builtin_amdgcn_rcpf(1.f + __expf(-a))) * acc[ai][1][m][0][j]; h1[j] = gt * (b * __builtin_amdgcn_rcpf(1.f + __expf(-b))) * acc[ai][1][m][1][j]; }
                *(u32x4*)(H + r * 4096 + col0) = pack8(h0, h1); asm volatile("" ::: "memory"); }
    }
};
struct EpiAccum {
    static constexpr bool PERM = false, AFTER_DRAIN = false;
    float* XF;
    __device__ __forceinline__ void operator()(const f32x4 (&acc)[2][2][4][2], const Unit& u, int wr, int wc, int, int) const { const int ln_ = lane_fresh(), fr = ln_ & 15, fq = ln_ >> 4;
        const int row0 = u.pm * BM + wr * 64 + fr, col0 = u.pn * BM + wc * 32 + 4 * fq;
#pragma unroll
        for (int ai = 0; ai < 2; ++ai)
#pragma unroll
            for (int m = 0; m < 4; ++m) { const size_t off = (size_t)(row0 + ai * HALF + m * 16) * 1024 + col0;
#pragma unroll
                for (int bj = 0; bj < 2; ++bj)
#pragma unroll
                    for (int n = 0; n < 2; ++n) { const size_t o = off + bj * HALF + n * 16; const f32x4 x = *(const f32x4*)(XF + o); *(f32x4*)(XF + o) = x + acc[ai][bj][m][n]; }
                asm volatile("" ::: "memory"); }
    }
};
struct EpiCompress {
    static constexpr bool PERM = false, AFTER_DRAIN = true;
    const float* bias; const bf16_t* w2t; bf16_t* out; int transposed;
    __device__ __forceinline__ void fused(f32x4 (&acc)[2][2][4][2], const Unit& u, int wr, int wc, int, int, PG8_LAS unsigned char* lds, int wid, int lane) const {
        const int ln_ = lane_fresh(), fr = ln_ & 15, fq = ln_ >> 4; (void)lane;
        PG8_LAS bf16_t* H = (PG8_LAS bf16_t*)lds; constexpr int HP = 264;
        const int row0 = wr * 64 + fr, col0 = wc * 32 + 4 * fq;
#pragma unroll
        for (int bj = 0; bj < 2; ++bj)
#pragma unroll
            for (int n = 0; n < 2; ++n) { const int c = bj * HALF + col0 + n * 16; const f32x4 bv = *(const f32x4*)(bias + c);
#pragma unroll
                for (int ai = 0; ai < 2; ++ai)
#pragma unroll
                    for (int m = 0; m < 4; ++m) { const f32x4 v = acc[ai][bj][m][n] + bv; f32x4 gl;
#pragma unroll
                        for (int j = 0; j < 4; ++j) { const float x = v[j], uu = 0.7978845608028654f * (x + 0.044715f * x * x * x); const float th = 1.0f - 2.0f * __builtin_amdgcn_rcpf(1.0f + __expf(2.0f * uu)); gl[j] = 0.5f * x * (1.0f + th); }
                        u32x2 w; w.x = cvt_pk_bf16(gl[0], gl[1]); w.y = cvt_pk_bf16(gl[2], gl[3]);
                        *(PG8_LAS u32x2*)(H + (ai * HALF + row0 + m * 16) * HP + c) = w; } }
        __syncthreads();
        const int q = fq, c16 = fr;
#pragma unroll
        for (int mt = 0; mt < 2; ++mt)
#pragma unroll
            for (int nt = 0; nt < 4; ++nt) { f32x4 d = {0.f, 0.f, 0.f, 0.f};
#pragma unroll
                for (int ks = 0; ks < 8; ++ks) { const bf16x8 af = *(const PG8_LAS bf16x8*)(H + (32 * wid + 16 * mt + c16) * HP + 32 * ks + 8 * q);
                    const bf16x8 bf = *(const bf16x8*)(w2t + (16 * nt + c16) * 256 + 32 * ks + 8 * q); d = __builtin_amdgcn_mfma_f32_16x16x32_bf16(af, bf, d, 0, 0, 0); }
#pragma unroll
                for (int j = 0; j < 4; ++j) { const int R = u.pm * BM + 32 * wid + 16 * mt + 4 * q + j, col = 16 * nt + c16; const unsigned hv = cvt_pk_bf16(d[j], d[j]) & 0xffffu;
                    if (!transposed) out[(size_t)R * 64 + col] = (bf16_t)hv; else out[((size_t)(R >> 9) * 64 + col) * 512 + (R & 511)] = (bf16_t)hv; } }
        __syncthreads();
    }
};
struct StrideOrder {
    int pm, pn0, dn, cnt;
    __device__ __forceinline__ bool next(int i, Unit& u) const { if (i >= cnt) return false; u.pm = pm; u.pn = pn0 + dn * i; return true; }
    __device__ __forceinline__ void a_ready(const Unit&) const {}
    __device__ __forceinline__ void done(const Unit&) const {}
};
template <class Epi, class Sched, bool ALIGN_EPI = false, bool SP2 = false>
__device__ __forceinline__ void gemm_phase(PG8_LAS unsigned char* lds, const Gemm g, const Sched& S, const Epi& E, int wave0) {
    int tid_ = tid_fresh(wave0); asm volatile("" : "+v"(tid_));
    const int tid = tid_, wid = __builtin_amdgcn_readfirstlane(tid >> 6), lane = tid & 63, wr = wid >> 2, wc = wid & 3, fr = lane & 15, fq = lane >> 4;
    const int K = g.K, nt = K / BK;
    unsigned voffA[2], voffB[2];
#pragma unroll
    for (int i = 0; i < 2; ++i) { int R, C; stage_rc(tid * 16 + i * 8192, R, C); const int Rb = Epi::PERM ? ((R & ~31) + perm32(R & 31)) : R;
        voffA[i] = (unsigned)(R * g.lda + C) * 2u; voffB[i] = (unsigned)(Rb * g.ldb + C) * 2u; }
    const size_t kstep = (size_t)(BK * 2);
    const size_t hstepA = (size_t)HALF * g.lda * 2, hstepB = (size_t)HALF * g.ldb * 2;
    const size_t tstepA = 2 * hstepA, tstepB = 2 * hstepB;
    const unsigned ldsw = (unsigned)wid * 1024u;
    const int aoff = lds_byte(wr * 64 + fr, fq * 8), boff = lds_byte(wc * 32 + fr, fq * 8);
#define PG8_SA(b, h) (((b) * 2 + (h)) * HTB)
#define PG8_SB(b, h) ((4 + (b) * 2 + (h)) * HTB)
#define PG8_STAGE(bufoff, gbase, voff) do { _Pragma("unroll") for (int _i = 0; _i < 2; ++_i) \
        __builtin_amdgcn_global_load_lds((const unsigned*)((const char*)(gbase) + (voff)[_i]), (PG8_LAS unsigned*)(lds + (bufoff) + ldsw + _i * 8192), 16, 0, 0); } while (0)
#define PG8_LDA(dst, b, h) do { _Pragma("unroll") for (int m = 0; m < 4; ++m) _Pragma("unroll") for (int k = 0; k < 2; ++k) dst[m][k] = *(const PG8_LAS bf16x8*)(lds + PG8_SA(b, h) + aoff + m * 2048 + k * 1024); } while (0)
#define PG8_LDB(dst, b, h) do { _Pragma("unroll") for (int n = 0; n < 2; ++n) _Pragma("unroll") for (int k = 0; k < 2; ++k) dst[n][k] = *(const PG8_LAS bf16x8*)(lds + PG8_SB(b, h) + boff + n * 2048 + k * 1024); } while (0)
#define PG8_MMA(ai, bj, At, Bt) do { __builtin_amdgcn_s_setprio(1); _Pragma("unroll") for (int m = 0; m < 4; ++m) _Pragma("unroll") for (int n = 0; n < 2; ++n) _Pragma("unroll") for (int k = 0; k < 2; ++k) \
        acc[ai][bj][m][n] = __builtin_amdgcn_mfma_f32_16x16x32_bf16(Bt[n][k], At[m][k], acc[ai][bj][m][n], 0, 0, 0); __builtin_amdgcn_s_setprio(0); } while (0)
#define PG8_WAIT_V(n) asm volatile("s_waitcnt vmcnt(" #n ")" ::: "memory")
#define PG8_WAIT_L(n) asm volatile("s_waitcnt lgkmcnt(" #n ")" ::: "memory")
#define PG8_BAR __builtin_amdgcn_s_barrier()
#define PG8_SCHED __builtin_amdgcn_sched_barrier(0)
    Unit cur, nxt; int ui = 0;
    if (!S.next(0, cur)) return;
    f32x4 acc[2][2][4][2]; float zf_ = 0.f; asm volatile("" : "+v"(zf_));
#pragma unroll
    for (int a = 0; a < 2; ++a)
#pragma unroll
        for (int b = 0; b < 2; ++b)
#pragma unroll
            for (int m = 0; m < 4; ++m)
#pragma unroll
                for (int n = 0; n < 2; ++n) acc[a][b][m][n] = (f32x4){zf_, zf_, zf_, zf_};
    bf16x8 At[4][2], B0[2][2], B1[2][2];
    const char* cA = (const char*)g.A + (size_t)cur.pm * tstepA; const char* cB = (const char*)g.Bt + (size_t)cur.pn * tstepB;
    S.a_ready(cur);
    if constexpr (SP2) {
        PG8_STAGE(PG8_SB(0, 0), cB, voffB); PG8_STAGE(PG8_SB(0, 1), cB + hstepB, voffB); PG8_STAGE(PG8_SA(0, 0), cA, voffA); PG8_STAGE(PG8_SA(0, 1), cA + hstepA, voffA);
        if (wr == 1) PG8_BAR;
        PG8_WAIT_V(2); PG8_BAR;
        PG8_STAGE(PG8_SB(1, 0), cB + kstep, voffB); PG8_STAGE(PG8_SA(1, 0), cA + kstep, voffA); PG8_STAGE(PG8_SB(1, 1), cB + hstepB + kstep, voffB);
        PG8_WAIT_V(6); PG8_BAR;
    } else {
        PG8_STAGE(PG8_SB(0, 0), cB, voffB); PG8_STAGE(PG8_SA(0, 0), cA, voffA); PG8_STAGE(PG8_SB(0, 1), cB + hstepB, voffB); PG8_STAGE(PG8_SA(0, 1), cA + hstepA, voffA);
        if (wr == 1) PG8_BAR;
        PG8_WAIT_V(4); PG8_BAR;
        PG8_STAGE(PG8_SB(1, 0), cB + kstep, voffB); PG8_STAGE(PG8_SA(1, 0), cA + kstep, voffA); PG8_STAGE(PG8_SB(1, 1), cB + hstepB + kstep, voffB);
        PG8_WAIT_V(6); PG8_BAR;
    }
    for (;;) {
        const bool has_next = S.next(ui + 1, nxt);
        const char* nA = has_next ? (const char*)g.A + (size_t)nxt.pm * tstepA : cA; const char* nB = has_next ? (const char*)g.Bt + (size_t)nxt.pn * tstepB : cB;
        for (int t = 0; t < nt; t += 2) {
            const bool last = (t == nt - 2);
            const char* a1 = cA + (size_t)(t + 1) * kstep;
            const char* a2 = last ? nA : cA + (size_t)(t + 2) * kstep; const char* b2 = last ? nB : cB + (size_t)(t + 2) * kstep;
            const char* a3 = a2 + kstep; const char* b3 = b2 + kstep;
            if (last && has_next) S.a_ready(nxt);
            if constexpr (SP2) {
            PG8_LDB(B0, 0, 0); PG8_LDB(B1, 0, 1); PG8_SCHED; PG8_LDA(At, 0, 0); PG8_STAGE(PG8_SA(1, 1), a1 + hstepA, voffA);
            PG8_WAIT_V(8); PG8_WAIT_L(0); PG8_BAR; PG8_MMA(0, 0, At, B0); PG8_MMA(0, 1, At, B1); PG8_BAR; PG8_SCHED;
            PG8_LDA(At, 0, 1); PG8_STAGE(PG8_SB(0, 0), b2, voffB); PG8_STAGE(PG8_SB(0, 1), b2 + hstepB, voffB); PG8_STAGE(PG8_SA(0, 0), a2, voffA);
            PG8_WAIT_V(8); PG8_WAIT_L(0); PG8_BAR; PG8_MMA(1, 0, At, B0); PG8_MMA(1, 1, At, B1); PG8_BAR; PG8_SCHED;
            PG8_LDB(B0, 1, 0); PG8_LDB(B1, 1, 1); PG8_SCHED; PG8_LDA(At, 1, 0); PG8_STAGE(PG8_SA(0, 1), a2 + hstepA, voffA);
            PG8_WAIT_V(8); PG8_WAIT_L(0); PG8_BAR; PG8_MMA(0, 0, At, B0); PG8_MMA(0, 1, At, B1); PG8_BAR; PG8_SCHED;
            PG8_LDA(At, 1, 1); PG8_STAGE(PG8_SB(1, 0), b3, voffB); PG8_STAGE(PG8_SB(1, 1), b3 + hstepB, voffB); PG8_STAGE(PG8_SA(1, 0), a3, voffA);
            PG8_WAIT_V(8); PG8_WAIT_L(0); PG8_BAR; PG8_MMA(1, 0, At, B0); PG8_MMA(1, 1, At, B1); PG8_BAR; PG8_SCHED;
            } else {
            PG8_LDB(B0, 0, 0); PG8_SCHED; PG8_LDA(At, 0, 0); PG8_STAGE(PG8_SA(1, 1), a1 + hstepA, voffA);
            PG8_WAIT_L(8); PG8_BAR; PG8_WAIT_L(0); PG8_MMA(0, 0, At, B0); PG8_BAR; PG8_SCHED;
            PG8_LDB(B1, 0, 1); PG8_STAGE(PG8_SB(0, 0), b2, voffB);
            PG8_BAR; PG8_WAIT_L(0); PG8_MMA(0, 1, At, B1); PG8_BAR;
            PG8_LDA(At, 0, 1); PG8_STAGE(PG8_SA(0, 0), a2, voffA);
            PG8_BAR; PG8_WAIT_L(0); PG8_MMA(1, 0, At, B0); PG8_BAR; PG8_SCHED;
            PG8_STAGE(PG8_SB(0, 1), b2 + hstepB, voffB);
            PG8_WAIT_V(6); PG8_BAR; PG8_MMA(1, 1, At, B1); PG8_BAR;
            PG8_LDB(B0, 1, 0); PG8_SCHED; PG8_LDA(At, 1, 0); PG8_STAGE(PG8_SA(0, 1), a2 + hstepA, voffA);
            PG8_WAIT_L(8); PG8_BAR; PG8_WAIT_L(0); PG8_MMA(0, 0, At, B0); PG8_BAR; PG8_SCHED;
            PG8_LDB(B1, 1, 1); PG8_STAGE(PG8_SB(1, 0), b3, voffB);
            PG8_BAR; PG8_WAIT_L(0); PG8_MMA(0, 1, At, B1); PG8_BAR;
            PG8_LDA(At, 1, 1); PG8_STAGE(PG8_SA(1, 0), a3, voffA);
            PG8_BAR; PG8_WAIT_L(0); PG8_MMA(1, 0, At, B0); PG8_BAR; PG8_SCHED;
            PG8_STAGE(PG8_SB(1, 1), b3 + hstepB, voffB);
            PG8_WAIT_V(6); PG8_BAR; PG8_MMA(1, 1, At, B1); PG8_BAR;
            }
        }
        if constexpr (ALIGN_EPI) { if (wr == 0) PG8_BAR; }
        if constexpr (!Epi::AFTER_DRAIN) { E(acc, cur, wr, wc, fr, fq); S.done(cur); }
        if (!has_next) break;
#pragma unroll
        for (int a = 0; a < 2; ++a)
#pragma unroll
            for (int b = 0; b < 2; ++b)
#pragma unroll
                for (int m = 0; m < 4; ++m)
#pragma unroll
                    for (int n = 0; n < 2; ++n) acc[a][b][m][n] = (f32x4){zf_, zf_, zf_, zf_};
        cur = nxt; cA = nA; cB = nB; ++ui;
        if constexpr (ALIGN_EPI) { if (wr == 1) PG8_BAR; }
    }
    PG8_WAIT_V(0);
    if constexpr (!ALIGN_EPI) { if (wr == 0) PG8_BAR; }
    PG8_BAR;
    if constexpr (Epi::AFTER_DRAIN) { E.fused(acc, cur, wr, wc, fr, fq, lds, wid, lane); S.done(cur); }
#undef PG8_SA
#undef PG8_SB
#undef PG8_STAGE
#undef PG8_LDA
#undef PG8_LDB
#undef PG8_MMA
#undef PG8_WAIT_V
#undef PG8_WAIT_L
#undef PG8_BAR
#undef PG8_SCHED
}
}
using pg8::bf16x8;
constexpr size_t MiB = 1u << 20;
constexpr size_t WS_CTL = 0;
constexpr size_t CTL_ZERO_BYTES = 65536;
constexpr size_t WS_BIASP = 384 * 1024;
constexpr size_t WS_BIASR = 448 * 1024;
constexpr size_t WS_AEND = 128 * 1024;
constexpr size_t WS_GATES = 1 * MiB;
constexpr size_t WS_SMALL = 2 * MiB;
constexpr size_t WS_KC = 4 * MiB;
constexpr size_t WS_LRUSUM = 5 * MiB;
constexpr size_t WS_W = 6 * MiB;
constexpr size_t W_WIN = 0, W_W1K = 13 * MiB + MiB / 2, W_W1V = W_W1K + MiB, W_W2K = W_W1V + MiB, W_W2V = W_W2K + 32768, W_LRUW = W_W2V + 32768  , W_PROJ = 16 * MiB, W_WOUT = 19 * MiB, W_PLEG = 21 * MiB,
                 W_PLEP = 23 * MiB, W_WGU = 24 * MiB, W_WD = 40 * MiB, W_END = 48 * MiB;
constexpr size_t WS_XB = WS_W + W_END;
constexpr size_t WS_PB = WS_XB + 32 * MiB;
constexpr size_t WS_A = WS_PB + 8 * MiB;
constexpr size_t KV_STRIDE = (size_t)4 * SEQ * 64 + 4096;
constexpr size_t WS_Q = WS_A, WS_KV = WS_Q + 16 * MiB, WS_Z = WS_KV + 25 * MiB, WS_XBC = WS_Z + 16 * MiB, WS_LX = WS_XBC + 24 * MiB, WS_LY = WS_LX + 16 * MiB,
                 WS_STATES = WS_LY + 16 * MiB, WS_ONSA = WS_STATES + 16 * MiB, WS_OSSD = WS_ONSA + 16 * MiB, WS_OLRU = WS_OSSD + 16 * MiB, WS_END = WS_OLRU + 16 * MiB;
constexpr size_t WS_MERGE = WS_A;
constexpr size_t WS_MIXB = WS_LY;
constexpr size_t WS_HBUF = WS_A;
constexpr size_t WS_SG = WS_A + 128 * MiB;
static_assert(KV_STRIDE * 2 * 6 <= 25 * MiB, "kv");
static_assert(WS_MERGE + 96 * MiB <= WS_LY && WS_MIXB + 32 * MiB <= WS_ONSA, "overlay map");
static_assert(WS_SG + 32 * MiB <= WS_END && WS_END <= 283 * MiB, "ws map");

constexpr int LDS_BYTES = 147456;

struct Args { const float* in[37]; float* out; unsigned char* ws; int ph_lo, ph_hi; };

__device__ __forceinline__ void tr_job(const float* __restrict__ W, int ld, int K, int c0, int ncols, bf16_t* dst, int ldd, int koff, LAS float* scr, int lane, int gw, int NGW, int& base) {
    const int ncb = (ncols + 31) >> 5, items = (K >> 6) * ncb;
    int first = (gw - (base % NGW) + NGW) % NGW; base += items;
    for (int it = first; it < items; it += NGW) {
        const int kb = it / ncb, nb = it - kb * ncb, k0 = kb << 6, n0 = nb << 5, nv = (ncols - n0) < 32 ? (ncols - n0) : 32;
        const int col = lane & 31;
        if (col < nv) {
#pragma unroll 8
            for (int i = 0; i < 32; ++i) { const int kk = 2 * i + (lane >> 5); scr[kk * 33 + col] = W[(size_t)(k0 + kk) * ld + c0 + n0 + col]; }
        }
        asm volatile("s_waitcnt lgkmcnt(0)" ::: "memory");
        const int c = lane & 7;
#pragma unroll
        for (int j = 0; j < 4; ++j) { const int n = (lane >> 3) + 8 * j;
            if (n < nv) { const LAS float* s = scr + (8 * c) * 33 + n;
                u32x4 o; o.x = pk2(s[0 * 33], s[1 * 33]); o.y = pk2(s[2 * 33], s[3 * 33]); o.z = pk2(s[4 * 33], s[5 * 33]); o.w = pk2(s[6 * 33], s[7 * 33]);
                *(u32x4*)(dst + (size_t)(n0 + n) * ldd + koff + k0 + 8 * c) = o; } }
        asm volatile("s_waitcnt lgkmcnt(0)" ::: "memory");
    }
}
struct TJob { const float* src; int ld, K, c0, ncols; bf16_t* dst; int ldd, koff; };
__device__ __forceinline__ TJob get_job(const Args& a, int L, int j, unsigned char* W) {
    TJob t;
    if (j < 6) {
        t.src = a.in[2] + (size_t)L * D_MODEL * IN_WIDTH; t.ld = IN_WIDTH; t.K = 1024; t.ldd = 1024; t.koff = 0; bf16_t* win = (bf16_t*)(W + W_WIN);
        const int c0s = j == 0 ? 0 : j == 1 ? 1304 : j == 2 ? 2592 : j == 3 ? 1280 : j == 4 ? 2584 : 3616;
        const int ncs = j == 0 ? 1280 : j == 1 ? 1280 : j == 2 ? 1024 : j == 3 ? 24 : j == 4 ? 8 : 3072;
        const int r0 = j == 0 ? 0 : j == 1 ? 1280 : j == 2 ? 2560 : j == 3 ? 3584 : j == 4 ? 3608 : 3840;
        t.c0 = c0s; t.ncols = ncs; t.dst = win + (size_t)r0 * 1024;
    } else if (j < 8) { const int v = j - 6; t.src = a.in[v ? 7 : 4] + (size_t)L * 2048 * 256; t.ld = 256; t.K = 2048; t.c0 = 0; t.ncols = 256; t.dst = (bf16_t*)(W + (v ? W_W1V : W_W1K)); t.ldd = 2048; t.koff = 0;
    } else if (j < 10) { const int v = j - 8; t.src = a.in[v ? 8 : 5] + (size_t)L * 256 * 64; t.ld = 64; t.K = 256; t.c0 = 0; t.ncols = 64; t.dst = (bf16_t*)(W + (v ? W_W2V : W_W2K)); t.ldd = 256; t.koff = 0;
    } else if (j < 13) { const int v = j - 10; t.src = a.in[22 + v] + (size_t)L * 512 * 1024; t.ld = 1024; t.K = 512; t.c0 = 0; t.ncols = 1024; t.dst = (bf16_t*)(W + W_PROJ) + (size_t)v * 1024 * 512; t.ldd = 512; t.koff = 0;
    } else if (j == 13) { t.src = a.in[25] + (size_t)L * 1024 * 1024; t.ld = 1024; t.K = 1024; t.c0 = 0; t.ncols = 1024; t.dst = (bf16_t*)(W + W_WOUT); t.ldd = 1024; t.koff = 0;
    } else if (j == 14) { t.src = a.in[33] + (size_t)L * 1024 * 1024; t.ld = 1024; t.K = 1024; t.c0 = 0; t.ncols = 1024; t.dst = (bf16_t*)(W + W_PLEG); t.ldd = 1024; t.koff = 0;
    } else if (j == 15) { t.src = a.in[34] + (size_t)L * 256 * 1024; t.ld = 1024; t.K = 256; t.c0 = 0; t.ncols = 1024; t.dst = (bf16_t*)(W + W_PLEP); t.ldd = 256; t.koff = 0;
    } else if (j < 32) { const int v = j - 16, which = v >> 3, n = v & 7; t.src = a.in[which ? 19 : 17] + (size_t)(L * 8 + n) * 4096; t.ld = 64; t.K = 64; t.c0 = 0; t.ncols = 64;
        t.dst = (bf16_t*)(W + W_LRUW) + (size_t)v * 4096; t.ldd = 64; t.koff = 0;
    } else { const int q = j - 32, e = q / 5, k = q - 5 * e;
        if (k < 4) { const int hf = k >> 1, up = k & 1; t.src = a.in[up ? 31 : 30] + (size_t)(L * N_EXPERTS + e) * 1024 * 256; t.ld = 256; t.K = 1024; t.c0 = 128 * hf; t.ncols = 128;
            t.dst = (bf16_t*)(W + W_WGU) + (size_t)(256 * (2 * e + hf) + 128 * up) * 1024; t.ldd = 1024; t.koff = 0; }
        else { t.src = a.in[32] + (size_t)(L * N_EXPERTS + e) * 256 * 1024; t.ld = 1024; t.K = 256; t.c0 = 0; t.ncols = 1024; t.dst = (bf16_t*)(W + W_WD); t.ldd = 4096; t.koff = e * 256; }
    }
    return t;
}
constexpr int N_TJOBS = 32 + 5 * N_EXPERTS;
__device__ __forceinline__ void convert_weights(const Args& a, unsigned char* wsp, int L, LAS unsigned char* lds, int vcu, int G, int wave0) {
    const int tid = tid_fresh(wave0), lane = tid & 63, wave = tid >> 6;
    LAS float* scr = (LAS float*)(lds + wave * 16384);
    const int gw = vcu * NWAVES + wave, NGW = G * NWAVES;
    unsigned char* W = wsp + WS_W;
    int base = 0;
    for (int j = 0; j < N_TJOBS; ++j) { const TJob t = get_job(a, L, j, W); tr_job(t.src, t.ld, t.K, t.c0, t.ncols, t.dst, t.ldd, t.koff, scr, lane, gw, NGW, base); }
    {
        u32x4* z = (u32x4*)((bf16_t*)(W + W_WIN) + (size_t)3616 * 1024);
        unsigned zz = 0u; asm volatile("" : "+v"(zz));
        for (int i = gw * 64 + lane; i < 224 * 128; i += NGW * 64) z[i] = (u32x4){zz, zz, zz, zz};
    }
    float* part = (float*)(wsp + WS_BIASP);
    for (int j = gw; j < 256; j += NGW) {
        const int which = j >> 7, hg = (j >> 5) & 3, ks = j & 31;
        const float* pe = a.in[which ? 6 : 3] + (size_t)L * 2048; const float* w1 = a.in[which ? 7 : 4] + (size_t)L * 2048 * 256;
        float s = 0.f;
#pragma unroll 8
        for (int kk = ks * 64; kk < ks * 64 + 64; ++kk) s += pe[kk] * w1[(size_t)kk * 256 + hg * 64 + lane];
        part[(which * 32 + ks) * 256 + hg * 64 + lane] = s;
    }
}
__device__ __forceinline__ void cvt_rows(const float* __restrict__ src, bf16_t* dst, size_t n, int vcu, int G, int wave0) {
    const size_t stride = (size_t)G * NTHREADS; const int tid = tid_fresh(wave0);
    for (size_t i = (size_t)vcu * NTHREADS + tid; i < n / 8; i += stride) {
        const f32x4 a = *(const f32x4*)(src + i * 8), b = *(const f32x4*)(src + i * 8 + 4);
        u32x4 o; o.x = pk2(a[0], a[1]); o.y = pk2(a[2], a[3]); o.z = pk2(b[0], b[1]); o.w = pk2(b[2], b[3]);
        *(u32x4*)(dst + i * 8) = o;
    }
}
template <bool ROUTER>
__device__ __forceinline__ void ln_rows(float* XF, const float* __restrict__ g, const float* __restrict__ b, bf16_t* XB, const float* __restrict__ rw, const float* __restrict__ rb, float* GATES,
                                        LAS unsigned char* lds, int vcu, int G, int wave0) {
    const int tid = tid_fresh(wave0), lane = tid & 63, wave = tid >> 6;
    LAS float* rwT = (LAS float*)lds;
    if (ROUTER) {
        for (int i = tid; i < 16384; i += NTHREADS) rwT[(i & 15) * 1024 + (i >> 4)] = rw[i];
        __syncthreads();
    }
    f32x4 gv[4], bv[4];
#pragma unroll
    for (int j = 0; j < 4; ++j) { gv[j] = *(const f32x4*)(g + 256 * j + 4 * lane); bv[j] = *(const f32x4*)(b + 256 * j + 4 * lane); }
    const int gw = vcu * NWAVES + wave, NGW = G * NWAVES;
    for (int row = gw; row < TOK; row += NGW) {
        float* xr = XF + (size_t)row * 1024;
        f32x4 v[4]; float s = 0.f;
#pragma unroll
        for (int j = 0; j < 4; ++j) { v[j] = *(const f32x4*)(xr + 256 * j + 4 * lane); s += (v[j][0] + v[j][1]) + (v[j][2] + v[j][3]); }
        const float mean = wave_sum(s, lane) * (1.f / 1024.f); float s2 = 0.f;
#pragma unroll
        for (int j = 0; j < 4; ++j) { v[j] = v[j] - mean; s2 += (v[j][0] * v[j][0] + v[j][1] * v[j][1]) + (v[j][2] * v[j][2] + v[j][3] * v[j][3]); }
        const float rstd = 1.0f / sqrtf(wave_sum(s2, lane) * (1.f / 1024.f) + LN_EPS);
#pragma unroll
        for (int j = 0; j < 4; ++j) { v[j] = v[j] * rstd * gv[j] + bv[j]; *(f32x4*)(xr + 256 * j + 4 * lane) = v[j];
            u32x2 w; w.x = pk2(v[j][0], v[j][1]); w.y = pk2(v[j][2], v[j][3]); *(u32x2*)(XB + (size_t)row * 1024 + 256 * j + 4 * lane) = w; }
        if (ROUTER) {
            float aff[16], sel[16];
#pragma unroll
            for (int e = 0; e < 16; ++e) { float p = 0.f;
#pragma unroll
                for (int j = 0; j < 4; ++j) { const f32x4 w = *(const LAS f32x4*)(rwT + e * 1024 + 256 * j + 4 * lane); p += (v[j][0] * w[0] + v[j][1] * w[1]) + (v[j][2] * w[2] + v[j][3] * w[3]); }
                p = wave_sum(p, lane); aff[e] = 1.0f / (1.0f + expf(-p)); sel[e] = aff[e] + rb[e]; }
            int best = 0; float bs = -INFINITY;
#pragma unroll
            for (int q = 0; q < 4; ++q) { float m1 = -INFINITY, m2 = -INFINITY;
#pragma unroll
                for (int k = 0; k < 4; ++k) { const float x = sel[4 * q + k]; if (x > m1) { m2 = m1; m1 = x; } else if (x > m2) m2 = x; }
                const float sc = m1 + m2; if (sc > bs) { bs = sc; best = q; } }
            int i1 = 0, i2 = 0; float m1 = -INFINITY, m2 = -INFINITY;
#pragma unroll
            for (int e = 0; e < 16; ++e) { const float x = ((e >> 2) == best) ? sel[e] : -INFINITY; if (x > m1) { m2 = m1; i2 = i1; m1 = x; i1 = e; } else if (x > m2) { m2 = x; i2 = e; } }
            float a1 = 0.f, a2 = 0.f;
#pragma unroll
            for (int e = 0; e < 16; ++e) { a1 = (e == i1) ? aff[e] : a1; a2 = (e == i2) ? aff[e] : a2; }
            const float inv = 1.0f / (a1 + a2);
            if (lane < 16) GATES[(size_t)row * 16 + lane] = (lane == i1) ? a1 * inv : ((lane == i2) ? a2 * inv : 0.f);
        }
    }
    if (ROUTER) __syncthreads();
}
#ifndef HAVE_NSA
#define HAVE_NSA 1
#endif
#ifndef HAVE_SSD
#define HAVE_SSD 1
#endif
#ifndef HAVE_LRU
#define HAVE_LRU 1
#endif
typedef float f32x16 __attribute__((ext_vector_type(16)));
#define MFMA16(a, b, c) __builtin_amdgcn_mfma_f32_16x16x32_bf16((a), (b), (c), 0, 0, 0)
#define MFMA32(a, b, c) __builtin_amdgcn_mfma_f32_32x32x16_bf16((a), (b), (c), 0, 0, 0)
__device__ __forceinline__ void unpack8f(const u32x4 w, f32x4& a, f32x4& b) {
    a[0] = __uint_as_float(w.x << 16); a[1] = __uint_as_float(w.x & 0xffff0000u); a[2] = __uint_as_float(w.y << 16); a[3] = __uint_as_float(w.y & 0xffff0000u);
    b[0] = __uint_as_float(w.z << 16); b[1] = __uint_as_float(w.z & 0xffff0000u); b[2] = __uint_as_float(w.w << 16); b[3] = __uint_as_float(w.w & 0xffff0000u); }
__device__ __forceinline__ u32x4 pack8f(const f32x4 a, const f32x4 b) { u32x4 w; w.x = pk2(a[0], a[1]); w.y = pk2(a[2], a[3]); w.z = pk2(b[0], b[1]); w.w = pk2(b[2], b[3]); return w; }

constexpr int LRU_XP = 520;
template <bool FINAL>
__device__ __forceinline__ void lru_tile(const Args& a, unsigned char* wsp, int L, int unit, LAS unsigned char* lds, int tid) {
    const int lane = tid & 63, wave = tid >> 6, q = lane >> 4, c16 = lane & 15;
    const int b = unit >> 7, ck = unit & 127, s0 = ck * 64; const size_t t0 = (size_t)b * SEQ + s0;
    const bf16_t* LX = (const bf16_t*)(wsp + WS_LX); const bf16_t* LY = (const bf16_t*)(wsp + WS_LY); bf16_t* OL = (bf16_t*)(wsp + WS_OLRU);
    float* SUM = (float*)(wsp + WS_LRUSUM) + (size_t)(b * 128 + ck) * 1024;
    LAS bf16_t* XT = (LAS bf16_t*)lds;
    const float* cw = a.in[15] + (size_t)L * 4 * 512; const float* cbias = a.in[16] + (size_t)L * 512;
    for (int it = tid; it < 64 * 64; it += NTHREADS) {
        const int tok = it >> 6, ch0 = (it & 63) * 8;
        f32x4 lo = *(const f32x4*)(cbias + ch0), hi = *(const f32x4*)(cbias + ch0 + 4);
#pragma unroll
        for (int k = 0; k < 4; ++k) {
            if (s0 + tok - 3 + k >= 0) {
                f32x4 xl, xh; unpack8f(*(const u32x4*)(LX + (t0 + tok - 3 + k) * 512 + ch0), xl, xh);
                const f32x4 wl = *(const f32x4*)(cw + k * 512 + ch0), wh = *(const f32x4*)(cw + k * 512 + ch0 + 4);
                lo += wl * xl; hi += wh * xh; }
        }
        *(LAS u32x4*)(XT + tok * LRU_XP + ch0) = pack8f(lo, hi);
    }
    __syncthreads();
    const int n = wave;
    const bf16_t* WA = (const bf16_t*)(wsp + WS_W + W_LRUW) + (size_t)n * 4096; const bf16_t* WX = WA + 8 * 4096;
    const float* pba = a.in[18] + (size_t)L * 512; const float* pbx = a.in[20] + (size_t)L * 512; const float* plam = a.in[21] + (size_t)L * 512;
#pragma unroll 1
    for (int nt = 0; nt < 4; ++nt) {
        const int d = nt * 16 + c16, ch = n * 64 + d;
        const bf16x8 wa0 = *(const bf16x8*)(WA + d * 64 + 8 * q), wa1 = *(const bf16x8*)(WA + d * 64 + 32 + 8 * q);
        const bf16x8 wx0 = *(const bf16x8*)(WX + d * 64 + 8 * q), wx1 = *(const bf16x8*)(WX + d * 64 + 32 + 8 * q);
        const float vba = pba[ch], vbx = pbx[ch], sp = softplusf_(-plam[ch]);
        float av[4][4], bv[4][4];
#pragma unroll
        for (int mt = 0; mt < 4; ++mt) {
            const LAS bf16_t* xr = XT + (16 * mt + c16) * LRU_XP + n * 64 + 8 * q;
            const bf16x8 x0 = *(const LAS bf16x8*)xr, x1 = *(const LAS bf16x8*)(xr + 32);
            f32x4 ga = {0.f, 0.f, 0.f, 0.f}, gx = {0.f, 0.f, 0.f, 0.f};
            ga = MFMA16(x0, wa0, ga); ga = MFMA16(x1, wa1, ga); gx = MFMA16(x0, wx0, gx); gx = MFMA16(x1, wx1, gx);
#pragma unroll
            for (int j = 0; j < 4; ++j) {
                const float r = sigmoidf_(ga[j] + vba), ii = sigmoidf_(gx[j] + vbx), la = -8.0f * r * sp;
                const float xv = bf2f(XT[(16 * mt + 4 * q + j) * LRU_XP + ch]);
                av[mt][j] = __expf(la); bv[mt][j] = sqrtf(fmaxf(-expm1f(2.0f * la), 0.f)) * (ii * xv);
            }
        }
        float P[4], H[4];
#pragma unroll
        for (int mt = 0; mt < 4; ++mt) { float p = av[mt][0], h = bv[mt][0];
#pragma unroll
            for (int j = 1; j < 4; ++j) { h = av[mt][j] * h + bv[mt][j]; p *= av[mt][j]; }
            P[mt] = p; H[mt] = h; }
        float h = FINAL ? SUM[512 + ch] : 0.f; float hin[4] = {0.f, 0.f, 0.f, 0.f};
#pragma unroll
        for (int mt = 0; mt < 4; ++mt)
#pragma unroll
            for (int qq = 0; qq < 4; ++qq) { if (q == qq) hin[mt] = h; const float ho = P[mt] * h + H[mt]; h = __int_as_float(__builtin_amdgcn_ds_bpermute((c16 + 16 * qq) << 2, __float_as_int(ho))); }
        if (!FINAL) {
            float pt = (P[0] * P[1]) * (P[2] * P[3]); pt *= shx(pt, 16, lane); pt *= shx(pt, 32, lane);
            if (q == 0) { SUM[ch] = pt; SUM[512 + ch] = h; }
        } else {
#pragma unroll
            for (int mt = 0; mt < 4; ++mt) { float hh = hin[mt];
#pragma unroll
                for (int j = 0; j < 4; ++j) { hh = av[mt][j] * hh + bv[mt][j]; const size_t o = (t0 + 16 * mt + 4 * q + j) * 512 + ch; OL[o] = (bf16_t)f2bf(hh * gelu_tanh(bf2f(LY[o]))); } }
        }
    }
    __syncthreads();
}
__device__ __forceinline__ void lru_carry(const Args& a, unsigned char* wsp, int id) {
    const int b = id >> 9, ch = id & 511; float* S = (float*)(wsp + WS_LRUSUM) + (size_t)b * 128 * 1024 + ch; float carry = 0.f;
#pragma unroll 8
    for (int c = 0; c < 128; ++c) { const float A = S[c * 1024], Hh = S[c * 1024 + 512]; S[c * 1024 + 512] = carry; carry = A * carry + Hh; }
}


constexpr size_t WS_SSQ = 256 * 1024;
__device__ __forceinline__ void ssd_conv8(const bf16_t* XBC, const float* cw, const float* cb, size_t trow, int s, int ch0, f32x4& lo, f32x4& hi) {
    lo = *(const f32x4*)(cb + ch0); hi = *(const f32x4*)(cb + ch0 + 4);
#pragma unroll
    for (int k = 0; k < 4; ++k) {
        if (s - 3 + k >= 0) {
            f32x4 xl, xh; unpack8f(*(const u32x4*)(XBC + (trow - 3 + k) * 768 + ch0), xl, xh);
            const f32x4 wl = *(const f32x4*)(cw + k * 768 + ch0), wh = *(const f32x4*)(cw + k * 768 + ch0 + 4);
            lo += wl * xl; hi += wh * xh; }
    }
#pragma unroll
    for (int i = 0; i < 4; ++i) { lo[i] = siluf_(lo[i]); hi[i] = siluf_(hi[i]); }
}
__device__ __forceinline__ void ssd_prep(const Args& a, unsigned char* wsp, int L, size_t t0, int g, LAS float* dtl, LAS float* acum, int tid) {
    const int lane = tid & 63, wave = tid >> 6;
    {   const int hh = tid >> 7, l = tid & 127, h = g * 4 + hh;
        const float raw = ((const float*)(wsp + WS_SMALL))[(t0 + l) * 32 + 24 + h] + a.in[11][L * 8 + h];
        const float dt = softplusf_(raw), A = -__expf(a.in[12][L * 8 + h]);
        dtl[hh * 128 + l] = dt; acum[hh * 128 + l] = dt * A; }
    __syncthreads();
    if (wave < 4) {
        const float v0 = acum[wave * 128 + 2 * lane], v1 = acum[wave * 128 + 2 * lane + 1]; const float sm = v0 + v1; float inc = sm;
#pragma unroll
        for (int o = 1; o < 64; o <<= 1) { const float t = __int_as_float(__builtin_amdgcn_ds_bpermute(((lane - o) & 63) << 2, __float_as_int(inc))); if (lane >= o) inc += t; }
        const float ex = inc - sm; acum[wave * 128 + 2 * lane] = ex + v0; acum[wave * 128 + 2 * lane + 1] = ex + sm; }
    __syncthreads();
}
__device__ __forceinline__ void ssd_a_unit(const Args& a, unsigned char* wsp, int L, int unit, LAS unsigned char* lds, int tid) {
    const int lane = tid & 63, wave = tid >> 6, q = lane >> 4, c16 = lane & 15;
    const int b = unit >> 7, c = (unit & 127) >> 1, g = unit & 1; const size_t t0 = (size_t)b * SEQ + c * 128;
    LAS float* dtl = (LAS float*)lds; LAS float* acum = dtl + 512; LAS bf16_t* BT = (LAS bf16_t*)(lds + 4096); LAS bf16_t* XdT = BT + 64 * 136;
    const bf16_t* XBC = (const bf16_t*)(wsp + WS_XBC); const float* cw = a.in[9] + (size_t)L * 4 * 768; const float* cb = a.in[10] + (size_t)L * 768;
    ssd_prep(a, wsp, L, t0, g, dtl, acum, tid);
    for (int it = tid; it < 128 * 40; it += NTHREADS) {
        const int l = it / 40, cg = it - l * 40; const int ch0 = cg < 32 ? g * 256 + cg * 8 : 512 + g * 64 + (cg - 32) * 8;
        f32x4 lo, hi; ssd_conv8(XBC, cw, cb, t0 + l, c * 128 + l, ch0, lo, hi);
        if (cg < 32) { const int hh = cg >> 3, p0 = (cg & 7) * 8; const float sc = dtl[hh * 128 + l] * __expf(acum[hh * 128 + 127] - acum[hh * 128 + l]);
            LAS bf16_t* d = XdT + (hh * 64 + p0) * 136 + l;
#pragma unroll
            for (int i = 0; i < 4; ++i) { d[i * 136] = (bf16_t)f2bf(lo[i] * sc); d[(i + 4) * 136] = (bf16_t)f2bf(hi[i] * sc); } }
        else { LAS bf16_t* d = BT + ((cg - 32) * 8) * 136 + l;
#pragma unroll
            for (int i = 0; i < 4; ++i) { d[i * 136] = (bf16_t)f2bf(lo[i]); d[(i + 4) * 136] = (bf16_t)f2bf(hi[i]); } }
    }
    __syncthreads();
    {   const int hh = wave >> 1, nt0 = (wave & 1) * 2, h = g * 4 + hh;
        float* S = (float*)(wsp + WS_STATES) + ((size_t)((b * 64 + c) * 8 + h)) * 4096;
#pragma unroll
        for (int nt = 0; nt < 2; ++nt)
#pragma unroll
            for (int pt = 0; pt < 4; ++pt) { f32x4 acc = {0.f, 0.f, 0.f, 0.f};
#pragma unroll
                for (int ks = 0; ks < 4; ++ks) { const bf16x8 af = *(const LAS bf16x8*)(BT + (16 * (nt0 + nt) + c16) * 136 + 32 * ks + 8 * q);
                    const bf16x8 bf = *(const LAS bf16x8*)(XdT + (hh * 64 + 16 * pt + c16) * 136 + 32 * ks + 8 * q); acc = MFMA16(af, bf, acc); }
                *(f32x4*)(S + (16 * pt + c16) * 64 + 16 * (nt0 + nt) + 4 * q) = acc; }
    }
    if (tid < 4) ((float*)(wsp + WS_AEND))[(b * 64 + c) * 8 + g * 4 + tid] = acum[tid * 128 + 127];
    __syncthreads();
}
__device__ __forceinline__ void ssd_scan(const Args& a, unsigned char* wsp, int id) {
    const int e = id & 4095, h = (id >> 12) & 7, b = id >> 15; float* S = (float*)(wsp + WS_STATES) + (size_t)b * 64 * 8 * 4096 + (size_t)h * 4096 + e;
    const float* AE = (const float*)(wsp + WS_AEND) + b * 64 * 8 + h; float run = 0.f;
#pragma unroll 8
    for (int c = 0; c < 64; ++c) { const float t = S[(size_t)c * 8 * 4096]; const float dec = __expf(AE[c * 8]); S[(size_t)c * 8 * 4096] = run; run = run * dec + t; }
}
__device__ __forceinline__ void ssd_b_unit(const Args& a, unsigned char* wsp, int L, int unit, LAS unsigned char* lds, int tid) {
    const int lane = tid & 63, wave = tid >> 6, q = lane >> 4, c16 = lane & 15;
    const int b = unit >> 7, c = (unit & 127) >> 1, g = unit & 1; const size_t t0 = (size_t)b * SEQ + c * 128;
    LAS float* dtl = (LAS float*)lds; LAS float* acum = dtl + 512;
    LAS bf16_t* CM = (LAS bf16_t*)(lds + 4096); LAS bf16_t* BM = CM + 128 * 72; LAS bf16_t* XS = BM + 128 * 72; LAS bf16_t* XT = XS + 128 * 72; LAS bf16_t* SI = XT + 64 * 136; LAS bf16_t* M1 = SI + 64 * 72 + wave * (16 * 136);
    const bf16_t* XBC = (const bf16_t*)(wsp + WS_XBC); const float* cw = a.in[9] + (size_t)L * 4 * 768; const float* cb = a.in[10] + (size_t)L * 768;
    const bf16_t* Z = (const bf16_t*)(wsp + WS_Z); bf16_t* OS = (bf16_t*)(wsp + WS_OSSD);
    ssd_prep(a, wsp, L, t0, g, dtl, acum, tid);
    for (int it = tid; it < 128 * 16; it += NTHREADS) {
        const int l = it >> 4, cg = it & 15; const int ch0 = 512 + (cg >> 3) * 128 + g * 64 + (cg & 7) * 8;
        f32x4 lo, hi; ssd_conv8(XBC, cw, cb, t0 + l, c * 128 + l, ch0, lo, hi);
        *(LAS u32x4*)((cg < 8 ? BM : CM) + l * 72 + (cg & 7) * 8) = pack8f(lo, hi);
    }
    __syncthreads();
    f32x4 cbm[8];
#pragma unroll
    for (int st = 0; st < 8; ++st) { cbm[st] = (f32x4){0.f, 0.f, 0.f, 0.f};
        if (st <= wave) {
#pragma unroll
            for (int ks = 0; ks < 2; ++ks) { const bf16x8 af = *(const LAS bf16x8*)(CM + (16 * wave + c16) * 72 + 32 * ks + 8 * q), bf = *(const LAS bf16x8*)(BM + (16 * st + c16) * 72 + 32 * ks + 8 * q); cbm[st] = MFMA16(af, bf, cbm[st]); } } }
    float ssq[4] = {0.f, 0.f, 0.f, 0.f};
#pragma unroll 1
    for (int hh = 0; hh < 4; ++hh) {
        const int h = g * 4 + hh;
        __syncthreads();
        for (int it = tid; it < 128 * 8; it += NTHREADS) {
            const int l = it >> 3, p0 = (it & 7) * 8; f32x4 lo, hi; ssd_conv8(XBC, cw, cb, t0 + l, c * 128 + l, h * 64 + p0, lo, hi);
            *(LAS u32x4*)(XS + l * 72 + p0) = pack8f(lo, hi);
            const float dt = dtl[hh * 128 + l]; LAS bf16_t* d = XT + p0 * 136 + l;
#pragma unroll
            for (int i = 0; i < 4; ++i) { d[i * 136] = (bf16_t)f2bf(lo[i] * dt); d[(i + 4) * 136] = (bf16_t)f2bf(hi[i] * dt); }
        }
        {   const float* S = (const float*)(wsp + WS_STATES) + ((size_t)((b * 64 + c) * 8 + h)) * 4096;
            const int p = tid >> 3, n0 = (tid & 7) * 8; const f32x4 s0 = *(const f32x4*)(S + p * 64 + n0), s1 = *(const f32x4*)(S + p * 64 + n0 + 4);
            *(LAS u32x4*)(SI + p * 72 + n0) = pack8f(s0, s1); }
        __syncthreads();
#pragma unroll
        for (int st = 0; st < 8; ++st) { const float as = acum[hh * 128 + 16 * st + c16];
#pragma unroll
            for (int j = 0; j < 4; ++j) { const int l = 16 * wave + 4 * q + j, s = 16 * st + c16;
                const float v = (st <= wave && s <= l) ? cbm[st][j] * __expf(acum[hh * 128 + l] - as) : 0.f; M1[(4 * q + j) * 136 + s] = (bf16_t)f2bf(v); } }
        f32x4 y[4], yo[4];
#pragma unroll
        for (int pt = 0; pt < 4; ++pt) { y[pt] = (f32x4){0.f, 0.f, 0.f, 0.f}; yo[pt] = (f32x4){0.f, 0.f, 0.f, 0.f}; }
        const int nks = (16 * wave + 15) / 32 + 1;
        for (int ks = 0; ks < nks; ++ks) { const bf16x8 af = *(const LAS bf16x8*)(M1 + c16 * 136 + 32 * ks + 8 * q);
#pragma unroll
            for (int pt = 0; pt < 4; ++pt) { const bf16x8 bf = *(const LAS bf16x8*)(XT + (16 * pt + c16) * 136 + 32 * ks + 8 * q); y[pt] = MFMA16(af, bf, y[pt]); } }
#pragma unroll
        for (int ks = 0; ks < 2; ++ks) { const bf16x8 af = *(const LAS bf16x8*)(CM + (16 * wave + c16) * 72 + 32 * ks + 8 * q);
#pragma unroll
            for (int pt = 0; pt < 4; ++pt) { const bf16x8 bf = *(const LAS bf16x8*)(SI + (16 * pt + c16) * 72 + 32 * ks + 8 * q); yo[pt] = MFMA16(af, bf, yo[pt]); } }
        const float Dh = a.in[13][L * 8 + h];
#pragma unroll
        for (int j = 0; j < 4; ++j) { const int l = 16 * wave + 4 * q + j; const float ea = __expf(acum[hh * 128 + l]);
#pragma unroll
            for (int pt = 0; pt < 4; ++pt) { const int p = 16 * pt + c16; const size_t o = (t0 + l) * 512 + h * 64 + p;
                float v = y[pt][j] + ea * yo[pt][j] + Dh * bf2f(XS[l * 72 + p]); v *= siluf_(bf2f(Z[o])); ssq[j] += v * v;
                OS[o] = (bf16_t)f2bf(v * a.in[14][L * 512 + h * 64 + p]); } }
    }
#pragma unroll
    for (int j = 0; j < 4; ++j) { float v = ssq[j]; v += shx(v, 1, lane); v += shx(v, 2, lane); v += shx(v, 4, lane); v += shx(v, 8, lane);
        if (c16 == 0) ((float*)(wsp + WS_SSQ))[(t0 + 16 * wave + 4 * q + j) * 2 + g] = v; }
    __syncthreads();
}


constexpr int ATT_KP = 72;
__device__ __forceinline__ f32x16 att_scores(const LAS bf16_t* kt, const bf16x8 (&qf)[4], int r, int h) {
    f32x16 s = {0.f, 0.f, 0.f, 0.f, 0.f, 0.f, 0.f, 0.f, 0.f, 0.f, 0.f, 0.f, 0.f, 0.f, 0.f, 0.f};
#pragma unroll
    for (int ks = 0; ks < 4; ++ks) { const bf16x8 kf = *(const LAS bf16x8*)(kt + r * ATT_KP + 16 * ks + 8 * h); s = MFMA32(kf, qf[ks], s); }
    return s * 0.125f;
}
__device__ __forceinline__ void att_pv(f32x16& o0, f32x16& o1, const LAS bf16_t* vt, const f32x16& p, int r, int h) {
#pragma unroll
    for (int s = 0; s < 2; ++s) {
        u32x4 pw; pw.x = pk2(p[8 * s + 0], p[8 * s + 1]); pw.y = pk2(p[8 * s + 2], p[8 * s + 3]); pw.z = pk2(p[8 * s + 4], p[8 * s + 5]); pw.w = pk2(p[8 * s + 6], p[8 * s + 7]);
        const bf16x8 pb = __builtin_bit_cast(bf16x8, pw);
        {   const u32x2 lo = *(const LAS u32x2*)(vt + r * ATT_KP + 16 * s + 4 * h), hi = *(const LAS u32x2*)(vt + r * ATT_KP + 16 * s + 8 + 4 * h);
            const u32x4 vw = {lo.x, lo.y, hi.x, hi.y}; o0 = MFMA32(__builtin_bit_cast(bf16x8, vw), pb, o0); }
        {   const u32x2 lo = *(const LAS u32x2*)(vt + (32 + r) * ATT_KP + 16 * s + 4 * h), hi = *(const LAS u32x2*)(vt + (32 + r) * ATT_KP + 16 * s + 8 + 4 * h);
            const u32x4 vw = {lo.x, lo.y, hi.x, hi.y}; o1 = MFMA32(__builtin_bit_cast(bf16x8, vw), pb, o1); }
    }
}
__device__ __forceinline__ void att_online(float& m, float& l, f32x16& o0, f32x16& o1, const f32x16& s, unsigned vm, const LAS bf16_t* vt, int r, int h, int lane) {
    float mx = -1e30f;
#pragma unroll
    for (int i = 0; i < 16; ++i) mx = fmaxf(mx, ((vm >> i) & 1u) ? s[i] : -1e30f);
    mx = fmaxf(mx, shx(mx, 32, lane));
    const float mn = fmaxf(m, mx), alpha = __expf(m - mn); f32x16 p; float ps = 0.f;
#pragma unroll
    for (int i = 0; i < 16; ++i) { p[i] = ((vm >> i) & 1u) ? __expf(s[i] - mn) : 0.f; ps += p[i]; }
    l = l * alpha + ps; m = mn; o0 = o0 * alpha; o1 = o1 * alpha;
    att_pv(o0, o1, vt, p, r, h);
}
__device__ __forceinline__ void att_stage(LAS bf16_t* KT, LAS bf16_t* VT, const bf16_t* kg, const bf16_t* vg, int vpitch, int tid, bool with_v) {
    const int rr = tid >> 3, ch = (tid & 7) * 8;
    *(LAS u32x4*)(KT + rr * ATT_KP + ch) = *(const u32x4*)(kg + (size_t)rr * 64 + ch);
    if (with_v) *(LAS u32x4*)(VT + rr * ATT_KP + ch) = *(const u32x4*)(vg + (size_t)rr * vpitch + ch);
}
__device__ __forceinline__ void nsa_unit(const Args& a, unsigned char* wsp, int L, int bg, int qb, LAS unsigned char* lds, int tid) {
    const int lane = tid & 63, wave = tid >> 6, r = lane & 31, h = lane >> 5;
    const int b = bg >> 1, g = bg & 1, t0 = qb * 64; const size_t rowbase = (size_t)b * SEQ + t0;
    LAS bf16_t* KT = (LAS bf16_t*)lds; LAS bf16_t* VT = KT + 64 * ATT_KP; LAS float* IMP = (LAS float*)(lds + 2 * 64 * ATT_KP * 2); LAS unsigned* SELM = (LAS unsigned*)(IMP + 64 * 128); LAS unsigned* UM = SELM + 256;
    const bf16_t* KV = (const bf16_t*)(wsp + WS_KV); const bf16_t* KC = (const bf16_t*)(wsp + WS_KC) + (size_t)bg * 512 * 64; const bf16_t* VCT = (const bf16_t*)(wsp + WS_KC + 256 * 1024) + (size_t)bg * 64 * 512;
    const bf16_t* KSEL = KV + 2 * KV_STRIDE + (size_t)bg * SEQ * 64; const bf16_t* VSELT = KV + 3 * KV_STRIDE + (size_t)bg * 64 * SEQ;
    const bf16_t* KWIN = KV + 4 * KV_STRIDE + (size_t)bg * SEQ * 64; const bf16_t* VWINT = KV + 5 * KV_STRIDE + (size_t)bg * 64 * SEQ;
    const int tokl = 8 * wave + (r >> 2), hd = g * 4 + (r & 3), tq = t0 + tokl;
    bf16x8 qf[4];
    {   const bf16_t* qp = (const bf16_t*)(wsp + WS_Q) + (rowbase + tokl) * 512 + hd * 64 + 8 * h;
#pragma unroll
        for (int ks = 0; ks < 4; ++ks) qf[ks] = *(const bf16x8*)(qp + 16 * ks); }
    const float* gl = (const float*)(wsp + WS_SMALL) + (rowbase + tokl) * 32 + hd * 3;
    const float g_cmp = sigmoidf_(gl[0]), g_slc = sigmoidf_(gl[1]), g_win = sigmoidf_(gl[2]);
    for (int i = lane; i < 8 * 128; i += 64) IMP[wave * 8 * 128 + i] = 0.f;
    f32x16 fin0, fin1;
#pragma unroll
    for (int i = 0; i < 16; ++i) { fin0[i] = 0.f; fin1[i] = 0.f; }
    const f32x16 zero16 = fin0;
    const int nmaxq = tq >= 31 ? (((tq - 31) >> 4) < 510 ? ((tq - 31) >> 4) : 510) : -1;
    const int ncb = (((t0 + 63 - 31) >> 4) >> 6) + 1;
    float m = -1e30f, l = 0.f;
    for (int cbk = 0; cbk < ncb; ++cbk) {
        __syncthreads();
        att_stage(KT, VT, KC + (size_t)cbk * 64 * 64, VCT + cbk * 64, 512, tid, false);
        __syncthreads();
#pragma unroll
        for (int tl = 0; tl < 2; ++tl) {
            const int n0 = cbk * 64 + tl * 32; unsigned vm = 0u;
#pragma unroll
            for (int i = 0; i < 16; ++i) vm |= ((n0 + (i & 3) + 8 * (i >> 2) + 4 * h) <= nmaxq ? 1u : 0u) << i;
            if (!__any(vm != 0u)) continue;
            const f32x16 s = att_scores(KT + tl * 32 * ATT_KP, qf, r, h);
            float mx = -1e30f;
#pragma unroll
            for (int i = 0; i < 16; ++i) mx = fmaxf(mx, ((vm >> i) & 1u) ? s[i] : -1e30f);
            mx = fmaxf(mx, shx(mx, 32, lane));
            const float mn = fmaxf(m, mx); float ps = 0.f;
#pragma unroll
            for (int i = 0; i < 16; ++i) ps += ((vm >> i) & 1u) ? __expf(s[i] - mn) : 0.f;
            l = l * __expf(m - mn) + ps; m = mn;
        }
    }
    l += shx(l, 32, lane);
    {
        const float invl = 1.0f / fmaxf(l, 1e-30f); f32x16 o0 = zero16, o1 = zero16;
        for (int cbk = 0; cbk < ncb; ++cbk) {
            __syncthreads();
            att_stage(KT, VT, KC + (size_t)cbk * 64 * 64, VCT + cbk * 64, 512, tid, true);
            __syncthreads();
#pragma unroll
            for (int tl = 0; tl < 2; ++tl) {
                const int n0 = cbk * 64 + tl * 32; unsigned vm = 0u;
#pragma unroll
                for (int i = 0; i < 16; ++i) vm |= ((n0 + (i & 3) + 8 * (i >> 2) + 4 * h) <= nmaxq ? 1u : 0u) << i;
                if (!__any(vm != 0u)) continue;
                const f32x16 s = att_scores(KT + tl * 32 * ATT_KP, qf, r, h); f32x16 p;
#pragma unroll
                for (int i = 0; i < 16; ++i) p[i] = ((vm >> i) & 1u) ? __expf(s[i] - m) * invl : 0.f;
                att_pv(o0, o1, VT + tl * 32, p, r, h);
#pragma unroll
                for (int rq = 0; rq < 4; ++rq) {
                    float av = 2.0f * (p[4 * rq] + p[4 * rq + 1] + p[4 * rq + 2]) + p[4 * rq + 3], bvv = p[4 * rq + 3];
                    av += shx(av, 1, lane); av += shx(av, 2, lane); bvv += shx(bvv, 1, lane); bvv += shx(bvv, 2, lane);
                    const int mb = (n0 >> 2) + 2 * rq + h;
                    if ((r & 3) == 0) { LAS float* ip = IMP + tokl * 128 + mb; ip[0] += av; }
                    if ((r & 3) == 0 && mb + 1 < 128) { LAS float* ip = IMP + tokl * 128 + mb + 1; ip[0] += bvv; }
                }
            }
        }
        fin0 += o0 * g_cmp; fin1 += o1 * g_cmp;
    }
    {
        const int cur = qb;
        for (int tk = 0; tk < 8; ++tk) {
            const int tokw = 8 * wave + tk;
            float v0 = IMP[tokw * 128 + lane], v1 = IMP[tokw * 128 + 64 + lane];
            {   const int b0 = lane, b1 = lane + 64;
                v0 = (b0 == 0 || b0 == cur || b0 == cur - 1) ? 1e4f : (b0 <= cur ? v0 : -1.0f);
                v1 = (b1 == 0 || b1 == cur || b1 == cur - 1) ? 1e4f : (b1 <= cur ? v1 : -1.0f); }
            bool s0 = false, s1 = false;
            for (int it = 0; it < 16; ++it) {
                float bv = v0; int bi = lane; if (v1 > bv) { bv = v1; bi = lane + 64; }
#pragma unroll
                for (int o = 1; o < 64; o <<= 1) { const float ov = shx(bv, o, lane); const int oi = shxi(bi, o, lane); if (ov > bv || (ov == bv && oi < bi)) { bv = ov; bi = oi; } }
                if (bi == lane) { s0 = true; v0 = -INFINITY; } if (bi == lane + 64) { s1 = true; v1 = -INFINITY; }
            }
            const unsigned long long m0 = __ballot(s0), m1 = __ballot(s1);
            if (lane == 0) { SELM[tokw * 4 + 0] = (unsigned)m0; SELM[tokw * 4 + 1] = (unsigned)(m0 >> 32); SELM[tokw * 4 + 2] = (unsigned)m1; SELM[tokw * 4 + 3] = (unsigned)(m1 >> 32); }
        }
    }
    __syncthreads();
    if (tid < 4) { unsigned u = 0u; for (int t = 0; t < 64; ++t) u |= SELM[t * 4 + tid]; UM[tid] = u; }
    __syncthreads();
    {
        m = -1e30f; l = 0.f; f32x16 o0 = zero16, o1 = zero16;
        const unsigned sw0 = SELM[tokl * 4 + 0], sw1 = SELM[tokl * 4 + 1], sw2 = SELM[tokl * 4 + 2], sw3 = SELM[tokl * 4 + 3];
        const unsigned um0 = UM[0], um1 = UM[1], um2 = UM[2], um3 = UM[3];
        for (int blk = 0; blk <= qb; ++blk) {
            const unsigned uw = blk < 32 ? um0 : (blk < 64 ? um1 : (blk < 96 ? um2 : um3));
            if (!((uw >> (blk & 31)) & 1u)) continue;
            __syncthreads();
            att_stage(KT, VT, KSEL + (size_t)blk * 64 * 64, VSELT + blk * 64, SEQ, tid, true);
            __syncthreads();
            const unsigned sw = blk < 32 ? sw0 : (blk < 64 ? sw1 : (blk < 96 ? sw2 : sw3));
            const bool mine = (sw >> (blk & 31)) & 1u;
            if (!__any(mine)) continue;
#pragma unroll
            for (int tl = 0; tl < 2; ++tl) {
                const int p0 = blk * 64 + tl * 32; unsigned vm = 0u;
#pragma unroll
                for (int i = 0; i < 16; ++i) vm |= ((mine && (p0 + (i & 3) + 8 * (i >> 2) + 4 * h) <= tq) ? 1u : 0u) << i;
                if (!__any(vm != 0u)) continue;
                const f32x16 s = att_scores(KT + tl * 32 * ATT_KP, qf, r, h);
                att_online(m, l, o0, o1, s, vm, VT + tl * 32, r, h, lane);
            }
        }
        l += shx(l, 32, lane); const float sc = g_slc / fmaxf(l, 1e-30f);
        fin0 += o0 * sc; fin1 += o1 * sc;
    }
    {
        m = -1e30f; l = 0.f; f32x16 o0 = zero16, o1 = zero16;
        for (int blk = (qb >= 8 ? qb - 8 : 0); blk <= qb; ++blk) {
            __syncthreads();
            att_stage(KT, VT, KWIN + (size_t)blk * 64 * 64, VWINT + blk * 64, SEQ, tid, true);
            __syncthreads();
#pragma unroll
            for (int tl = 0; tl < 2; ++tl) {
                const int p0 = blk * 64 + tl * 32; unsigned vm = 0u;
#pragma unroll
                for (int i = 0; i < 16; ++i) { const int pos = p0 + (i & 3) + 8 * (i >> 2) + 4 * h; vm |= ((pos <= tq && pos + 512 > tq) ? 1u : 0u) << i; }
                if (!__any(vm != 0u)) continue;
                const f32x16 s = att_scores(KT + tl * 32 * ATT_KP, qf, r, h);
                att_online(m, l, o0, o1, s, vm, VT + tl * 32, r, h, lane);
            }
        }
        l += shx(l, 32, lane); const float sc = g_win / fmaxf(l, 1e-30f);
        fin0 += o0 * sc; fin1 += o1 * sc;
    }
    {   bf16_t* op = (bf16_t*)(wsp + WS_ONSA) + (rowbase + tokl) * 512 + hd * 64 + 4 * h;
#pragma unroll
        for (int rq = 0; rq < 4; ++rq) {
            u32x2 w0; w0.x = pk2(fin0[4 * rq], fin0[4 * rq + 1]); w0.y = pk2(fin0[4 * rq + 2], fin0[4 * rq + 3]); *(u32x2*)(op + 8 * rq) = w0;
            u32x2 w1; w1.x = pk2(fin1[4 * rq], fin1[4 * rq + 1]); w1.y = pk2(fin1[4 * rq + 2], fin1[4 * rq + 3]); *(u32x2*)(op + 32 + 8 * rq) = w1; }
    }
    __syncthreads();
}

__device__ __forceinline__ void mixers_p2(const Args& a, unsigned char* wsp, int L, LAS unsigned char* lds, int bid, int G, int wave0) {
#if HAVE_NSA
    for (int u = bid; u < 16; u += G) {
        const int which = u >> 3;
        {   const int tid_ = tid_fresh(wave0); float* br = (float*)(wsp + WS_BIASR) + u * 256;
            if (tid_ < 256) { const float* pp = (const float*)(wsp + WS_BIASP) + which * 32 * 256 + tid_; float sacc = 0.f;
#pragma unroll 8
                for (int ks = 0; ks < 32; ++ks) sacc += pp[ks * 256];
                br[tid_] = sacc; }
            asm volatile("s_waitcnt vmcnt(0)" ::: "memory"); __syncthreads(); }
        pg8::Gemm g{(const bf16_t*)(wsp + WS_KV) + (size_t)which * KV_STRIDE, (const bf16_t*)(wsp + WS_W + (which ? W_W1V : W_W1K)), 2048, 256, 2048, 1024, 2048};
        pg8::StrideOrder S{u & 7, 0, 0, 1};
        pg8::EpiCompress E{(const float*)(wsp + WS_BIASR) + u * 256, (const bf16_t*)(wsp + WS_W + (which ? W_W2V : W_W2K)), (bf16_t*)(wsp + WS_KC + (which ? 256 * 1024 : 0)), which};
        pg8::gemm_phase<pg8::EpiCompress, pg8::StrideOrder, false, true>(lds, g, S, E, wave0);
    }
#endif
    const int tid = tid_fresh(wave0);
#if HAVE_SSD
    for (int u = bid; u < 256; u += G) ssd_a_unit(a, wsp, L, u, lds, tid);
#endif
#if HAVE_LRU
    for (int u = bid; u < 256; u += G) lru_tile<false>(a, wsp, L, u, lds, tid);
#endif
}
__device__ __forceinline__ void mixers_p3(const Args& a, unsigned char* wsp, int L, LAS unsigned char* lds, int bid, int G, int wave0) {
    const int tid = tid_fresh(wave0);
#if HAVE_NSA
    for (int pr = bid; pr < 256; pr += G) { const int bgp = pr >> 6, i = pr & 63; nsa_unit(a, wsp, L, bgp, 127 - i, lds, tid); nsa_unit(a, wsp, L, bgp, i, lds, tid); }
#endif
#if HAVE_SSD
    for (int id = bid * NTHREADS + tid; id < 65536; id += G * NTHREADS) ssd_scan(a, wsp, id);
#endif
#if HAVE_LRU
    for (int id = bid * NTHREADS + tid; id < 1024; id += G * NTHREADS) lru_carry(a, wsp, id);
#endif
}
__device__ __forceinline__ void mixers_p4(const Args& a, unsigned char* wsp, int L, LAS unsigned char* lds, int bid, int G, int wave0) {
    const int tid = tid_fresh(wave0);
#if HAVE_SSD
    for (int u = bid; u < 256; u += G) ssd_b_unit(a, wsp, L, u, lds, tid);
#endif
#if HAVE_LRU
    for (int u = bid; u < 256; u += G) lru_tile<true>(a, wsp, L, u, lds, tid);
#endif
}
#ifndef PH_MASK
#define PH_MASK 0xFFFF
#endif
#define PHON(k) (((PH_MASK) >> (k)) & 1)
#ifndef MIXERS
#define MIXERS 1
#endif
constexpr int PH_PER_LAYER = 10, N_PHASES = 1 + PH_PER_LAYER * DEPTH;

#define FRESH() int G = G0, bid = bid0; asm volatile("" : "+s"(G), "+s"(bid)); unsigned char* ws = a.ws; asm volatile("" : "+s"(ws)); float* XF = a.out; asm volatile("" : "+s"(XF)); bf16_t* XB = (bf16_t*)(ws + WS_XB); bf16_t* PB = (bf16_t*)(ws + WS_PB); unsigned char* W = ws + WS_W; float* GATES = (float*)(ws + WS_GATES); (void)XB; (void)PB; (void)W; (void)GATES; (void)XF;
#define RUN(k) (lo <= (k) && (k) < hi)
#define SEAM(k) do { if (RUN(k) && RUN((k) + 1)) { nbar += 1u; grid_barrier((unsigned*)(a.ws + WS_CTL + 8192), nbar * (unsigned)G0, wave0); } } while (0)
__device__ __forceinline__ void grid_barrier(unsigned* bar, unsigned target, int wave0) {
    asm volatile("s_waitcnt vmcnt(0) lgkmcnt(0)" ::: "memory");
    __syncthreads();
    if (wave0 == 0) {
        unsigned m = ~0u; asm volatile("" : "+s"(m));
        if (__builtin_amdgcn_mbcnt_hi(m, __builtin_amdgcn_mbcnt_lo(m, 0u)) == 0u) {
            __builtin_amdgcn_fence(__ATOMIC_RELEASE, "agent");
            asm volatile("s_waitcnt vmcnt(0)" ::: "memory");
            __hip_atomic_fetch_add(bar, 1u, __ATOMIC_RELAXED, __HIP_MEMORY_SCOPE_AGENT);
            unsigned spins = 0u;
            while (__hip_atomic_load(bar, __ATOMIC_RELAXED, __HIP_MEMORY_SCOPE_AGENT) < target) { __builtin_amdgcn_s_sleep(2); if (++spins > (1u << 27)) break; }
            __builtin_amdgcn_fence(__ATOMIC_ACQUIRE, "agent");
            asm volatile("s_waitcnt vmcnt(0)" ::: "memory");
        }
    }
    __syncthreads();
}
template <int L>
__device__ __forceinline__ void layer_phases(const Args& a, LAS unsigned char* lds, unsigned& nbar, const int G0, const int bid0, const int wave0, const int lo, const int hi) {
        const int P = 1 + PH_PER_LAYER * L;
        if (PHON(1) && RUN(P + 0)) { FRESH();
            pg8::Gemm g{XB, (const bf16_t*)(W + W_WIN), TOK, 3840, 1024, 1024, 1024}; pg8::StaticOrder S; S.init(TOK, 3840, G, bid);
            pg8::EpiInProj E{(bf16_t*)(ws + WS_Q), (bf16_t*)(ws + WS_KV), (bf16_t*)(ws + WS_Z), (bf16_t*)(ws + WS_XBC), (bf16_t*)(ws + WS_LX), (bf16_t*)(ws + WS_LY), (float*)(ws + WS_SMALL), KV_STRIDE};
            pg8::gemm_phase<pg8::EpiInProj, pg8::StaticOrder, true, true>(lds, g, S, E, wave0);
        }
        SEAM(P + 0);
#if MIXERS
        if (PHON(2) && RUN(P + 1)) { FRESH(); mixers_p2(a, ws, L, lds, bid, G, wave0); }
        SEAM(P + 1);
        if (PHON(3) && RUN(P + 2)) { FRESH(); mixers_p3(a, ws, L, lds, bid, G, wave0); }
        SEAM(P + 2);
        if (PHON(4) && RUN(P + 3)) { FRESH(); mixers_p4(a, ws, L, lds, bid, G, wave0); }
        SEAM(P + 3);
        if (PHON(5) && RUN(P + 4)) { FRESH();
            pg8::StaticOrder S4; S4.init(TOK, 1024, G, bid); pg8::Unit base;
            for (int j = 0; S4.next(j, base); ++j) {
                {   pg8::Gemm g{XB, (const bf16_t*)(W + W_WIN) + (size_t)3840 * 1024, TOK, 3072, 1024, 1024, 1024}; pg8::StrideOrder S{base.pm, base.pn, 4, 3};
                    pg8::EpiSigBf16 E{(bf16_t*)(ws + WS_MERGE), 3072};
                    pg8::gemm_phase<pg8::EpiSigBf16, pg8::StrideOrder, true, true>(lds, g, S, E, wave0); }
                int first = 1;
#pragma unroll 1
                for (int i = 0; i < 3; ++i) {
                    if ((i == 0 && !HAVE_NSA) || (i == 1 && !HAVE_SSD) || (i == 2 && !HAVE_LRU)) continue;
                    const bf16_t* A = (const bf16_t*)(ws + (i == 0 ? WS_ONSA : (i == 1 ? WS_OSSD : WS_OLRU)));
                    pg8::Gemm g{A, (const bf16_t*)(W + W_PROJ) + (size_t)i * 1024 * 512, TOK, 1024, 512, 512, 512}; pg8::StrideOrder S{base.pm, base.pn, 0, 1};
                    pg8::EpiMix E{(bf16_t*)(ws + WS_MIXB), (const bf16_t*)(ws + WS_MERGE), i * 1024, first, i == 1 ? (const float*)(ws + WS_SSQ) : nullptr}; first = 0;
                    pg8::gemm_phase<pg8::EpiMix, pg8::StrideOrder, true, true>(lds, g, S, E, wave0); }
            }
        }
        SEAM(P + 4);
        if (PHON(6) && RUN(P + 5)) { FRESH();
            pg8::Gemm g{(const bf16_t*)(ws + WS_MIXB), (const bf16_t*)(W + W_WOUT), TOK, 1024, 1024, 1024, 1024}; pg8::StaticOrder S; S.init(TOK, 1024, G, bid);
            pg8::EpiResid E{L == 0 ? a.in[0] : (const float*)XF, XF, ALPHA};
            pg8::gemm_phase<pg8::EpiResid, pg8::StaticOrder, true, true>(lds, g, S, E, wave0);
        }
        SEAM(P + 5);
#else
        if (PHON(6) && RUN(P + 5)) { FRESH();
            const float* xin = L == 0 ? a.in[0] : (const float*)XF;
            const int tid = tid_fresh(wave0); for (size_t i = (size_t)bid * NTHREADS + tid; i < (size_t)TOK * 256; i += (size_t)G * NTHREADS) { const f32x4 v = *(const f32x4*)(xin + 4 * i); *(f32x4*)(XF + 4 * i) = v * ALPHA; }
        }
        SEAM(P + 5);
#endif
        if (PHON(7) && RUN(P + 6)) { FRESH(); ln_rows<true>(XF, a.in[26] + L * 1024, a.in[27] + L * 1024, XB, a.in[28], a.in[29], GATES, lds, bid, G, wave0); }
        SEAM(P + 6);
        if (PHON(8) && RUN(P + 7)) { FRESH();
            if (PHON(11)) {   pg8::Gemm g{XB, (const bf16_t*)(W + W_PLEG), TOK, 1024, 1024, 1024, 1024}; pg8::StaticOrder S; S.init(TOK, 1024, G, bid);
                pg8::EpiSigNat E{(bf16_t*)(ws + WS_SG), XF};
                pg8::gemm_phase<pg8::EpiSigNat, pg8::StaticOrder, true, true>(lds, g, S, E, wave0); }
#ifdef FENCE_TEST
            __threadfence(); asm volatile("s_waitcnt vmcnt(0) lgkmcnt(0)" ::: "memory"); __syncthreads();
#endif
            if (PHON(12)) {   pg8::Gemm g{PB, (const bf16_t*)(W + W_PLEP), TOK, 1024, 256, 256, 256}; pg8::StaticOrder S; S.init(TOK, 1024, G, bid);
                pg8::EpiPleProj E{XF, (const bf16_t*)(ws + WS_SG), ALPHA};
                pg8::gemm_phase<pg8::EpiPleProj, pg8::StaticOrder, true, true>(lds, g, S, E, wave0); }
            if (PHON(13)) {   pg8::Gemm g{XB, (const bf16_t*)(W + W_WGU), TOK, 8192, 1024, 1024, 1024}; pg8::StaticOrder S; S.init(TOK, 8192, G, bid);
                pg8::EpiMoeUp E{(bf16_t*)(ws + WS_HBUF), GATES};
                pg8::gemm_phase<pg8::EpiMoeUp, pg8::StaticOrder, true, true>(lds, g, S, E, wave0); }
        }
        SEAM(P + 7);
        if (PHON(9) && RUN(P + 8)) { FRESH();
            pg8::Gemm g{(const bf16_t*)(ws + WS_HBUF), (const bf16_t*)(W + W_WD), TOK, 1024, 4096, 4096, 4096}; pg8::StaticOrder S; S.init(TOK, 1024, G, bid);
            pg8::EpiAccum E{XF};
            pg8::gemm_phase<pg8::EpiAccum, pg8::StaticOrder, true, true>(lds, g, S, E, wave0);
        }
        SEAM(P + 8);
        if (PHON(10) && RUN(P + 9)) { FRESH();
            if (L >= 0) { ln_rows<false>(XF, a.in[35] + L * 1024, a.in[36] + L * 1024, XB, nullptr, nullptr, nullptr, lds, bid, G, wave0); __syncthreads(); }
            else cvt_rows(a.in[0], XB, (size_t)TOK * 1024, bid, G, wave0);
            if (L + 1 < DEPTH) { convert_weights(a, ws, L + 1, lds, bid, G, wave0); cvt_rows(a.in[1] + (size_t)(L + 1) * TOK * 256, PB, (size_t)TOK * 256, bid, G, wave0); }
        }
        if (L + 1 < DEPTH) SEAM(P + 9);
}
#undef RUN
#undef SEAM
#undef FRESH

__global__ void __launch_bounds__(NTHREADS, 2) fwd_kernel(Args a) {
    extern __shared__ __attribute__((aligned(16))) unsigned char lds_raw[];
    LAS unsigned char* lds = (LAS unsigned char*)lds_raw;
    const int G0 = gridDim.x, bid0 = blockIdx.x, wave0 = __builtin_amdgcn_readfirstlane(threadIdx.x >> 6);
    const int lo = a.ph_lo, hi = a.ph_hi;
    if (hi - lo > 1) { cg::grid_group grid = cg::this_grid(); grid.sync(); }
    unsigned nbar = 0u;
    layer_phases<-1>(a, lds, nbar, G0, bid0, wave0, lo, hi);
    layer_phases<0>(a, lds, nbar, G0, bid0, wave0, lo, hi);
    layer_phases<1>(a, lds, nbar, G0, bid0, wave0, lo, hi);
    static_assert(DEPTH == 2, "layer_phases instantiations");
}

extern "C" void kernel_launch(void* const* d_in, const int* in_sizes, int n_in, void* d_out, int out_size, void* d_ws, size_t ws_size, hipStream_t stream) {
    static int grid = 0;
    if (grid == 0) {
        if (n_in != 37 || out_size != TOK * D_MODEL || ws_size < WS_END) { fprintf(stderr, "kernel_launch: unexpected shapes (n_in %d, out %d, ws %zu < %zu)\n", n_in, out_size, ws_size, (size_t)WS_END); grid = -1; return; }
        int dev = 0, cus = 0, per_cu = 0;
        hipGetDevice(&dev); hipDeviceGetAttribute(&cus, hipDeviceAttributeMultiprocessorCount, dev);
        if (hipFuncSetAttribute((const void*)fwd_kernel, hipFuncAttributeMaxDynamicSharedMemorySize, LDS_BYTES) != hipSuccess) { fprintf(stderr, "kernel_launch: hipFuncSetAttribute failed\n"); grid = -1; return; }
        if (hipOccupancyMaxActiveBlocksPerMultiprocessor(&per_cu, (const void*)fwd_kernel, NTHREADS, LDS_BYTES) != hipSuccess || per_cu < 1) { fprintf(stderr, "kernel_launch: occupancy query says %d blocks per CU\n", per_cu); grid = -1; return; }
        (void)hipGetLastError();
        grid = cus;
    }
    if (grid < 0) return;
    hipMemsetAsync((char*)d_ws + WS_CTL, 0, CTL_ZERO_BYTES, stream);
    Args a{};
    for (int i = 0; i < 37; ++i) a.in[i] = (const float*)d_in[i];
    a.out = (float*)d_out; a.ws = (unsigned char*)d_ws;
#ifndef N_LAUNCH_SPLIT
    a.ph_lo = 0; a.ph_hi = N_PHASES;
    void* args[] = {&a};
    hipError_t e = hipLaunchCooperativeKernel((const void*)fwd_kernel, dim3(grid), dim3(NTHREADS), args, LDS_BYTES, stream);
    if (e != hipSuccess) fprintf(stderr, "cooperative launch failed: %s (grid %d)\n", hipGetErrorString(e), grid);
#else
    for (int p = 0; p < N_PHASES; ++p) { a.ph_lo = p; a.ph_hi = p + 1; void* args[] = {&a};
        hipError_t e = hipLaunchCooperativeKernel((const void*)fwd_kernel, dim3(grid), dim3(NTHREADS), args, LDS_BYTES, stream);
        if (e != hipSuccess) { fprintf(stderr, "launch %d failed: %s\n", p, hipGetErrorString(e)); break; } }
#endif
}
```

```cpp
#include <hip/hip_runtime.h>
#include <hip/hip_cooperative_groups.h>
#include <cstdio>
#include <cstdint>
namespace cg = cooperative_groups;

#define LAS __attribute__((address_space(3)))
typedef unsigned short bf16_t;
typedef short bf16x8 __attribute__((ext_vector_type(8)));
typedef float f32x4 __attribute__((ext_vector_type(4)));
typedef float f32x2 __attribute__((ext_vector_type(2)));
typedef unsigned u32x4 __attribute__((ext_vector_type(4)));
typedef unsigned u32x2 __attribute__((ext_vector_type(2)));

constexpr int D_MODEL = 1024, BATCH = 2, SEQ = 8192, DEPTH = 2, TOK = BATCH * SEQ;
constexpr int PLE_DIM = 256;
constexpr int IN_WIDTH = 6688;
constexpr int N_EXPERTS = 16, D_EXPERT = 256;
constexpr float ALPHA = 1.4142135623730951f;
constexpr float LN_EPS = 1e-5f, RMS_EPS = 1e-5f;
constexpr int NWAVES = 8, NTHREADS = 512;

__device__ __forceinline__ float bf2f(unsigned h) { return __uint_as_float(h << 16); }
__device__ __forceinline__ unsigned f2bf(float f) { unsigned u = __float_as_uint(f); return (u + 0x7fffu + ((u >> 16) & 1u)) >> 16; }
__device__ __forceinline__ unsigned pk2(float lo, float hi) { return f2bf(lo) | (f2bf(hi) << 16); }
__device__ __forceinline__ float sigmoidf_(float x) { return 1.0f / (1.0f + __expf(-x)); }
__device__ __forceinline__ float siluf_(float x) { return x / (1.0f + __expf(-x)); }
__device__ __forceinline__ float gelu_tanh(float x) { const float u = 0.7978845608028654f * (x + 0.044715f * x * x * x); const float t = 1.0f - 2.0f / (1.0f + __expf(2.0f * u)); return 0.5f * x * (1.0f + t); }
__device__ __forceinline__ float softplusf_(float x) { return x > 20.f ? x : log1pf(__expf(x)); }
__device__ __forceinline__ float shx(float v, int o, int lane) { return __int_as_float(__builtin_amdgcn_ds_bpermute((lane ^ o) << 2, __float_as_int(v))); }
__device__ __forceinline__ int shxi(int v, int o, int lane) { return __builtin_amdgcn_ds_bpermute((lane ^ o) << 2, v); }
__device__ __forceinline__ float wave_sum(float v, int lane) {
#pragma unroll
    for (int o = 1; o < 64; o <<= 1) v += shx(v, o, lane);
    return v;
}
__device__ __forceinline__ float wave_max(float v, int lane) {
#pragma unroll
    for (int o = 1; o < 64; o <<= 1) v = fmaxf(v, shx(v, o, lane));
    return v;
}
__device__ __forceinline__ int tid_fresh(int wave0) { unsigned m = ~0u; asm volatile("" : "+s"(m)); const int l = (int)__builtin_amdgcn_mbcnt_hi(m, __builtin_amdgcn_mbcnt_lo(m, 0u)); return wave0 * 64 + l; }
#ifndef DUP_MASK
#define DUP_MASK 0
#endif
#define NREP(k) ((((DUP_MASK) >> (k)) & 1) ? 2 : 1)
namespace pg8 {
#define PG8_LAS __attribute__((address_space(3)))
typedef unsigned short bf16_t;
typedef short bf16x8 __attribute__((ext_vector_type(8)));
typedef float f32x4 __attribute__((ext_vector_type(4)));
typedef unsigned u32x4 __attribute__((ext_vector_type(4)));
constexpr int BM = 256, BK = 64, HALF = 128, HTB = HALF * BK * 2  , STAGE_BYTES = 8 * HTB, NXCD = 8, WGM = 8;

__host__ __device__ __forceinline__ int lds_byte(int r, int c) { const int st = (r >> 4) * 2 + (c >> 5), rr = r & 15, cc = c & 31, ob = rr * 64 + cc * 2; return st * 1024 + (ob ^ (((ob >> 9) & 1) << 5)); }
__host__ __device__ __forceinline__ void stage_rc(int b, int& R, int& C) { const int st = b / 1024, sb = b % 1024, swz = sb ^ (((sb >> 9) & 1) << 5); R = (st >> 1) * 16 + swz / 64; C = (st & 1) * 32 + (swz % 64) / 2; }
__host__ __device__ __forceinline__ int perm32(int rho) { const int n = rho >> 4, i = rho & 15; return 8 * (i >> 2) + 4 * n + (i & 3); }

struct Unit { int pm, pn; };
struct Gemm { const bf16_t* A; const bf16_t* Bt; int M, N, K, lda, ldb; };

struct StaticOrder {
    int nM, nN, nwg, G, c;
    __host__ __device__ __forceinline__ void init(int M, int N, int G_, int c_) { nM = M / BM; nN = N / BM; nwg = nM * nN; G = G_; c = c_; }
    __host__ __device__ __forceinline__ bool next(int i, Unit& u) const {
        const long L = (long)i * G + c; if (L >= nwg) return false;
        int wgid = (int)L; { const int q = nwg / NXCD, r = nwg % NXCD, xcd = wgid % NXCD, off = wgid / NXCD; wgid = (xcd < r ? xcd * (q + 1) : r * (q + 1) + (xcd - r) * q) + off; }
        const int nig = WGM * nN, gid = wgid / nig, fm = gid * WGM, gsz = (nM - fm) < WGM ? (nM - fm) : WGM;
        u.pm = fm + ((wgid % nig) % gsz); u.pn = (wgid % nig) / gsz; return true;
    }
    __device__ __forceinline__ void a_ready(const Unit&) const {}
    __device__ __forceinline__ void done(const Unit&) const {}
};

__device__ __forceinline__ int lane_fresh() { unsigned m = ~0u; asm volatile("" : "+s"(m)); return (int)__builtin_amdgcn_mbcnt_hi(m, __builtin_amdgcn_mbcnt_lo(m, 0u)); }
typedef __bf16 bf16x2_t_ __attribute__((ext_vector_type(2)));
__device__ __forceinline__ unsigned cvt_pk_bf16(float lo, float hi) { f32x2 v = {lo, hi}; bf16x2_t_ b = __builtin_convertvector(v, bf16x2_t_); return __builtin_bit_cast(unsigned, b); }
__device__ __forceinline__ u32x4 pack8(const f32x4 a, const f32x4 b) { u32x4 w; w.x = cvt_pk_bf16(a[0], a[1]); w.y = cvt_pk_bf16(a[2], a[3]); w.z = cvt_pk_bf16(b[0], b[1]); w.w = cvt_pk_bf16(b[2], b[3]); return w; }
__device__ __forceinline__ void unpack8(const u32x4 w, f32x4& a, f32x4& b) {
    a[0] = __uint_as_float(w.x << 16); a[1] = __uint_as_float(w.x & 0xffff0000u); a[2] = __uint_as_float(w.y << 16); a[3] = __uint_as_float(w.y & 0xffff0000u);
    b[0] = __uint_as_float(w.z << 16); b[1] = __uint_as_float(w.z & 0xffff0000u); b[2] = __uint_as_float(w.w << 16); b[3] = __uint_as_float(w.w & 0xffff0000u); }
__device__ __forceinline__ f32x4 sig4(const f32x4 v) { f32x4 o; o[0] = __builtin_amdgcn_rcpf(1.f + __expf(-v[0])); o[1] = __builtin_amdgcn_rcpf(1.f + __expf(-v[1])); o[2] = __builtin_amdgcn_rcpf(1.f + __expf(-v[2])); o[3] = __builtin_amdgcn_rcpf(1.f + __expf(-v[3])); return o; }

struct EpiInProj {
    static constexpr bool PERM = true, AFTER_DRAIN = false;
    bf16_t *Q, *KV, *Z, *XBC, *LX, *LY; float* SMALL; size_t kvstride;
    __device__ __forceinline__ void operator()(const f32x4 (&acc)[2][2][4][2], const Unit& u, int wr, int wc, int, int) const { const int ln_ = lane_fresh(), fr = ln_ & 15, fq = ln_ >> 4;
        const int pn = u.pn, row0 = u.pm * BM + wr * 64 + fr, cw = wc * 32 + 8 * fq;
        if (pn >= 2 && pn < 5) {
            const int g = cw >> 6, d = cw & 63;
#pragma unroll
            for (int bj = 0; bj < 2; ++bj) { bf16_t* base = KV + (size_t)((pn - 2) * 2 + bj) * kvstride;
                if (bj == 1 && pn >= 3) {
#pragma unroll
                    for (int ai = 0; ai < 2; ++ai)
#pragma unroll
                        for (int m = 0; m < 4; ++m) { const int r = row0 + ai * HALF + m * 16, b = r >> 13, s = r & (SEQ - 1); const u32x4 w = pack8(acc[ai][bj][m][0], acc[ai][bj][m][1]);
                            bf16_t* tp = base + ((size_t)((b * 2 + g) * 64 + d)) * SEQ + s;
                            tp[0] = (bf16_t)(w.x & 0xffffu); tp[SEQ] = (bf16_t)(w.x >> 16); tp[2 * SEQ] = (bf16_t)(w.y & 0xffffu); tp[3 * SEQ] = (bf16_t)(w.y >> 16);
                            tp[4 * SEQ] = (bf16_t)(w.z & 0xffffu); tp[5 * SEQ] = (bf16_t)(w.z >> 16); tp[6 * SEQ] = (bf16_t)(w.w & 0xffffu); tp[7 * SEQ] = (bf16_t)(w.w >> 16); }
                } else {
#pragma unroll
                for (int ai = 0; ai < 2; ++ai)
#pragma unroll
                    for (int m = 0; m < 4; ++m) { const int r = row0 + ai * HALF + m * 16, b = r >> 13, s = r & (SEQ - 1);
                        *(u32x4*)(base + ((size_t)((b * 2 + g) * SEQ + s)) * 64 + d) = pack8(acc[ai][bj][m][0], acc[ai][bj][m][1]); } } }
        } else if (pn == 14) {
            if (wc == 0) {
#pragma unroll
                for (int ai = 0; ai < 2; ++ai)
#pragma unroll
                    for (int m = 0; m < 4; ++m) { const int r = row0 + ai * HALF + m * 16; float* p = SMALL + (size_t)r * 32 + 8 * fq;
                        *(f32x4*)p = acc[ai][0][m][0]; *(f32x4*)(p + 4) = acc[ai][0][m][1]; } }
        } else {
            bf16_t* dst; int pitch, cb;
            if (pn < 2) { dst = Q; pitch = 512; cb = pn * 256; }
            else if (pn < 7) { dst = Z; pitch = 512; cb = (pn - 5) * 256; }
            else if (pn < 10) { dst = XBC; pitch = 768; cb = (pn - 7) * 256; }
            else if (pn < 12) { dst = LX; pitch = 512; cb = (pn - 10) * 256; }
            else { dst = LY; pitch = 512; cb = (pn - 12) * 256; }
#pragma unroll
            for (int ai = 0; ai < 2; ++ai)
#pragma unroll
                for (int m = 0; m < 4; ++m) { bf16_t* rowp = dst + (size_t)(row0 + ai * HALF + m * 16) * pitch + cb + cw;
#pragma unroll
                    for (int bj = 0; bj < 2; ++bj) *(u32x4*)(rowp + bj * HALF) = pack8(acc[ai][bj][m][0], acc[ai][bj][m][1]); }
        }
    }
};
struct EpiSigBf16 {
    static constexpr bool PERM = true, AFTER_DRAIN = false;
    bf16_t* O; int ldc;
    __device__ __forceinline__ void operator()(const f32x4 (&acc)[2][2][4][2], const Unit& u, int wr, int wc, int, int) const { const int ln_ = lane_fresh(), fr = ln_ & 15, fq = ln_ >> 4;
        const int row0 = u.pm * BM + wr * 64 + fr, col0 = u.pn * BM + wc * 32 + 8 * fq;
#pragma unroll
        for (int ai = 0; ai < 2; ++ai)
#pragma unroll
            for (int m = 0; m < 4; ++m) { bf16_t* rowp = O + (size_t)(row0 + ai * HALF + m * 16) * ldc + col0;
#pragma unroll
                for (int bj = 0; bj < 2; ++bj) *(u32x4*)(rowp + bj * HALF) = pack8(sig4(acc[ai][bj][m][0]), sig4(acc[ai][bj][m][1])); }
    }
};
struct EpiMix {
    static constexpr bool PERM = true, AFTER_DRAIN = false;
    bf16_t* MIX; const bf16_t* G; int goff; int first; const float* SSQ;
    __device__ __forceinline__ void operator()(const f32x4 (&acc)[2][2][4][2], const Unit& u, int wr, int wc, int, int) const { const int ln_ = lane_fresh(), fr = ln_ & 15, fq = ln_ >> 4;
        const int row0 = u.pm * BM + wr * 64 + fr, col0 = u.pn * BM + wc * 32 + 8 * fq;
#pragma unroll
        for (int ai = 0; ai < 2; ++ai)
#pragma unroll
            for (int m = 0; m < 4; ++m) { const size_t r = (size_t)(row0 + ai * HALF + m * 16);
                float rs = 1.f; if (SSQ) { const f32x2 q2 = *(const f32x2*)(SSQ + r * 2); rs = 1.0f / sqrtf((q2[0] + q2[1]) * (1.f / 512.f) + 1e-5f); }
#pragma unroll
                for (int bj = 0; bj < 2; ++bj) { const int c = col0 + bj * HALF;
                    f32x4 g0, g1; unpack8(*(const u32x4*)(G + r * 3072 + goff + c), g0, g1);
                    f32x4 v0 = acc[ai][bj][m][0] * g0 * rs, v1 = acc[ai][bj][m][1] * g1 * rs;
                    if (!first) { f32x4 p0, p1; unpack8(*(const u32x4*)(MIX + r * 1024 + c), p0, p1); v0 += p0; v1 += p1; }
                    *(u32x4*)(MIX + r * 1024 + c) = pack8(v0, v1); }
                asm volatile("" ::: "memory"); }
    }
};
struct EpiResid {
    static constexpr bool PERM = false, AFTER_DRAIN = false;
    const float* XIN; float* XF; float alpha;
    __device__ __forceinline__ void operator()(const f32x4 (&acc)[2][2][4][2], const Unit& u, int wr, int wc, int, int) const { const int ln_ = lane_fresh(), fr = ln_ & 15, fq = ln_ >> 4;
        const int row0 = u.pm * BM + wr * 64 + fr, col0 = u.pn * BM + wc * 32 + 4 * fq;
#pragma unroll
        for (int ai = 0; ai < 2; ++ai)
#pragma unroll
            for (int m = 0; m < 4; ++m) { const size_t off = (size_t)(row0 + ai * HALF + m * 16) * 1024 + col0;
#pragma unroll
                for (int bj = 0; bj < 2; ++bj)
#pragma unroll
                    for (int n = 0; n < 2; ++n) { const size_t o = off + bj * HALF + n * 16; const f32x4 x = *(const f32x4*)(XIN + o); *(f32x4*)(XF + o) = x * alpha + acc[ai][bj][m][n]; }
                asm volatile("" ::: "memory"); }
    }
};
struct EpiSigNat {
    static constexpr bool PERM = false, AFTER_DRAIN = false;
    bf16_t* SG; float* XFDBG;
    __device__ __forceinline__ void operator()(const f32x4 (&acc)[2][2][4][2], const Unit& u, int wr, int wc, int, int) const { const int ln_ = lane_fresh(), fr = ln_ & 15, fq = ln_ >> 4;
        const int row0 = u.pm * BM + wr * 64 + fr, col0 = u.pn * BM + wc * 32 + 4 * fq;
#pragma unroll
        for (int ai = 0; ai < 2; ++ai)
#pragma unroll
            for (int m = 0; m < 4; ++m) { const size_t off = (size_t)(row0 + ai * HALF + m * 16) * 1024 + col0;
#pragma unroll
                for (int bj = 0; bj < 2; ++bj)
#pragma unroll
                    for (int n = 0; n < 2; ++n) { const f32x4 s = sig4(acc[ai][bj][m][n]); u32x2 w; w.x = cvt_pk_bf16(s[0], s[1]); w.y = cvt_pk_bf16(s[2], s[3]); *(u32x2*)(SG + off + bj * HALF + n * 16) = w;
#ifdef SIG_TO_XF
                        { float* xf = XFDBG + off + bj * HALF + n * 16; const f32x4 x = *(const f32x4*)xf; *(f32x4*)xf = x + s; }
#endif
                    } }
    }
};
struct EpiPleProj {
    static constexpr bool PERM = false, AFTER_DRAIN = false;
    float* XF; const bf16_t* SG; float alpha;
    __device__ __forceinline__ void operator()(const f32x4 (&acc)[2][2][4][2], const Unit& u, int wr, int wc, int, int) const { const int ln_ = lane_fresh(), fr = ln_ & 15, fq = ln_ >> 4;
        const int row0 = u.pm * BM + wr * 64 + fr, col0 = u.pn * BM + wc * 32 + 4 * fq;
#pragma unroll
        for (int ai = 0; ai < 2; ++ai)
#pragma unroll
            for (int m = 0; m < 4; ++m) { const size_t off = (size_t)(row0 + ai * HALF + m * 16) * 1024 + col0;
#pragma unroll
                for (int bj = 0; bj < 2; ++bj)
#pragma unroll
                    for (int n = 0; n < 2; ++n) { const size_t o = off + bj * HALF + n * 16; const u32x2 w = *(const u32x2*)(SG + o);
                        f32x4 s; s[0] = __uint_as_float(w.x << 16); s[1] = __uint_as_float(w.x & 0xffff0000u); s[2] = __uint_as_float(w.y << 16); s[3] = __uint_as_float(w.y & 0xffff0000u);

#ifdef PLE_NOSG
                        s = (f32x4){1.f, 1.f, 1.f, 1.f};
#endif
                        const f32x4 x = *(const f32x4*)(XF + o); *(f32x4*)(XF + o) = x * alpha + s * acc[ai][bj][m][n]; }
                asm volatile("" ::: "memory"); }
    }
};
struct EpiMoeUp {
    static constexpr bool PERM = true, AFTER_DRAIN = false;
    bf16_t* H; const float* GATES;
    __device__ __forceinline__ void operator()(const f32x4 (&acc)[2][2][4][2], const Unit& u, int wr, int wc, int, int) const { const int ln_ = lane_fresh(), fr = ln_ & 15, fq = ln_ >> 4;
        const int e = u.pn >> 1, hf = u.pn & 1, row0 = u.pm * BM + wr * 64 + fr, col0 = e * 256 + hf * 128 + wc * 32 + 8 * fq;
#pragma unroll
        for (int ai = 0; ai < 2; ++ai)
#pragma unroll
            for (int m = 0; m < 4; ++m) { const size_t r = (size_t)(row0 + ai * HALF + m * 16); const float gt = GATES[r * 16 + e];
                f32x4 h0, h1;
#pragma unroll
                for (int j = 0; j < 4; ++j) { const float a = acc[ai][0][m][0][j], b = acc[ai][0][m][1][j];
                    h0[j] = gt * (a * __builtin_amdgcn_rcpf(1.f + __expf(-a))) * acc[ai][1][m][0][j]; h1[j] = gt * (b * __builtin_amdgcn_rcpf(1.f + __expf(-b))) * acc[ai][1][m][1][j]; }
                *(u32x4*)(H + r * 4096 + col0) = pack8(h0, h1); asm volatile("" ::: "memory"); }
    }
};
struct EpiAccum {
    static constexpr bool PERM = false, AFTER_DRAIN = false;
    float* XF;
    __device__ __forceinline__ void operator()(const f32x4 (&acc)[2][2][4][2], const Unit& u, int wr, int wc, int, int) const { const int ln_ = lane_fresh(), fr = ln_ & 15, fq = ln_ >> 4;
        const int row0 = u.pm * BM + wr * 64 + fr, col0 = u.pn * BM + wc * 32 + 4 * fq;
#pragma unroll
        for (int ai = 0; ai < 2; ++ai)
#pragma unroll
            for (int m = 0; m < 4; ++m) { const size_t off = (size_t)(row0 + ai * HALF + m * 16) * 1024 + col0;
#pragma unroll
                for (int bj = 0; bj < 2; ++bj)
#pragma unroll
                    for (int n = 0; n < 2; ++n) { const size_t o = off + bj * HALF + n * 16; const f32x4 x = *(const f32x4*)(XF + o); *(f32x4*)(XF + o) = x + acc[ai][bj][m][n]; }
                asm volatile("" ::: "memory"); }
    }
};
struct EpiCompress {
    static constexpr bool PERM = false, AFTER_DRAIN = true;
    const float* bias; const bf16_t* w2t; bf16_t* out; int transposed;
    __device__ __forceinline__ void fused(f32x4 (&acc)[2][2][4][2], const Unit& u, int wr, int wc, int, int, PG8_LAS unsigned char* lds, int wid, int lane) const {
        const int ln_ = lane_fresh(), fr = ln_ & 15, fq = ln_ >> 4; (void)lane;
        PG8_LAS bf16_t* H = (PG8_LAS bf16_t*)lds; constexpr int HP = 264;
        const int row0 = wr * 64 + fr, col0 = wc * 32 + 4 * fq;
#pragma unroll
        for (int bj = 0; bj < 2; ++bj)
#pragma unroll
            for (int n = 0; n < 2; ++n) { const int c = bj * HALF + col0 + n * 16; const f32x4 bv = *(const f32x4*)(bias + c);
#pragma unroll
                for (int ai = 0; ai < 2; ++ai)
#pragma unroll
                    for (int m = 0; m < 4; ++m) { const f32x4 v = acc[ai][bj][m][n] + bv; f32x4 gl;
#pragma unroll
                        for (int j = 0; j < 4; ++j) { const float x = v[j], uu = 0.7978845608028654f * (x + 0.044715f * x * x * x); const float th = 1.0f - 2.0f * __builtin_amdgcn_rcpf(1.0f + __expf(2.0f * uu)); gl[j] = 0.5f * x * (1.0f + th); }
                        u32x2 w; w.x = cvt_pk_bf16(gl[0], gl[1]); w.y = cvt_pk_bf16(gl[2], gl[3]);
                        *(PG8_LAS u32x2*)(H + (ai * HALF + row0 + m * 16) * HP + c) = w; } }
        __syncthreads();
        const int q = fq, c16 = fr;
#pragma unroll
        for (int mt = 0; mt < 2; ++mt)
#pragma unroll
            for (int nt = 0; nt < 4; ++nt) { f32x4 d = {0.f, 0.f, 0.f, 0.f};
#pragma unroll
                for (int ks = 0; ks < 8; ++ks) { const bf16x8 af = *(const PG8_LAS bf16x8*)(H + (32 * wid + 16 * mt + c16) * HP + 32 * ks + 8 * q);
                    const bf16x8 bf = *(const bf16x8*)(w2t + (16 * nt + c16) * 256 + 32 * ks + 8 * q); d = __builtin_amdgcn_mfma_f32_16x16x32_bf16(af, bf, d, 0, 0, 0); }
#pragma unroll
                for (int j = 0; j < 4; ++j) { const int R = u.pm * BM + 32 * wid + 16 * mt + 4 * q + j, col = 16 * nt + c16; const unsigned hv = cvt_pk_bf16(d[j], d[j]) & 0xffffu;
                    if (!transposed) out[(size_t)R * 64 + col] = (bf16_t)hv; else out[((size_t)(R >> 9) * 64 + col) * 512 + (R & 511)] = (bf16_t)hv; } }
        __syncthreads();
    }
};
struct StrideOrder {
    int pm, pn0, dn, cnt;
    __device__ __forceinline__ bool next(int i, Unit& u) const { if (i >= cnt) return false; u.pm = pm; u.pn = pn0 + dn * i; return true; }
    __device__ __forceinline__ void a_ready(const Unit&) const {}
    __device__ __forceinline__ void done(const Unit&) const {}
};
template <class Epi, class Sched, bool ALIGN_EPI = false, bool SP2 = false>
__device__ __forceinline__ void gemm_phase(PG8_LAS unsigned char* lds, const Gemm g, const Sched& S, const Epi& E, int wave0) {
    int tid_ = tid_fresh(wave0); asm volatile("" : "+v"(tid_));
    const int tid = tid_, wid = __builtin_amdgcn_readfirstlane(tid >> 6), lane = tid & 63, wr = wid >> 2, wc = wid & 3, fr = lane & 15, fq = lane >> 4;
    const int K = g.K, nt = K / BK;
    unsigned voffA[2], voffB[2];
#pragma unroll
    for (int i = 0; i < 2; ++i) { int R, C; stage_rc(tid * 16 + i * 8192, R, C); const int Rb = Epi::PERM ? ((R & ~31) + perm32(R & 31)) : R;
        voffA[i] = (unsigned)(R * g.lda + C) * 2u; voffB[i] = (unsigned)(Rb * g.ldb + C) * 2u; }
    const size_t kstep = (size_t)(BK * 2);
    const size_t hstepA = (size_t)HALF * g.lda * 2, hstepB = (size_t)HALF * g.ldb * 2;
    const size_t tstepA = 2 * hstepA, tstepB = 2 * hstepB;
    const unsigned ldsw = (unsigned)wid * 1024u;
    const int aoff = lds_byte(wr * 64 + fr, fq * 8), boff = lds_byte(wc * 32 + fr, fq * 8);
#define PG8_SA(b, h) (((b) * 2 + (h)) * HTB)
#define PG8_SB(b, h) ((4 + (b) * 2 + (h)) * HTB)
#define PG8_STAGE(bufoff, gbase, voff) do { _Pragma("unroll") for (int _i = 0; _i < 2; ++_i) \
        __builtin_amdgcn_global_load_lds((const unsigned*)((const char*)(gbase) + (voff)[_i]), (PG8_LAS unsigned*)(lds + (bufoff) + ldsw + _i * 8192), 16, 0, 0); } while (0)
#define PG8_LDA(dst, b, h) do { _Pragma("unroll") for (int m = 0; m < 4; ++m) _Pragma("unroll") for (int k = 0; k < 2; ++k) dst[m][k] = *(const PG8_LAS bf16x8*)(lds + PG8_SA(b, h) + aoff + m * 2048 + k * 1024); } while (0)
#define PG8_LDB(dst, b, h) do { _Pragma("unroll") for (int n = 0; n < 2; ++n) _Pragma("unroll") for (int k = 0; k < 2; ++k) dst[n][k] = *(const PG8_LAS bf16x8*)(lds + PG8_SB(b, h) + boff + n * 2048 + k * 1024); } while (0)
#define PG8_MMA(ai, bj, At, Bt) do { __builtin_amdgcn_s_setprio(1); _Pragma("unroll") for (int m = 0; m < 4; ++m) _Pragma("unroll") for (int n = 0; n < 2; ++n) _Pragma("unroll") for (int k = 0; k < 2; ++k) \
        acc[ai][bj][m][n] = __builtin_amdgcn_mfma_f32_16x16x32_bf16(Bt[n][k], At[m][k], acc[ai][bj][m][n], 0, 0, 0); __builtin_amdgcn_s_setprio(0); } while (0)
#define PG8_WAIT_V(n) asm volatile("s_waitcnt vmcnt(" #n ")" ::: "memory")
#define PG8_WAIT_L(n) asm volatile("s_waitcnt lgkmcnt(" #n ")" ::: "memory")
#define PG8_BAR __builtin_amdgcn_s_barrier()
#define PG8_SCHED __builtin_amdgcn_sched_barrier(0)
    Unit cur, nxt; int ui = 0;
    if (!S.next(0, cur)) return;
    f32x4 acc[2][2][4][2]; float zf_ = 0.f; asm volatile("" : "+v"(zf_));
#pragma unroll
    for (int a = 0; a < 2; ++a)
#pragma unroll
        for (int b = 0; b < 2; ++b)
#pragma unroll
            for (int m = 0; m < 4; ++m)
#pragma unroll
                for (int n = 0; n < 2; ++n) acc[a][b][m][n] = (f32x4){zf_, zf_, zf_, zf_};
    bf16x8 At[4][2], B0[2][2], B1[2][2];
    const char* cA = (const char*)g.A + (size_t)cur.pm * tstepA; const char* cB = (const char*)g.Bt + (size_t)cur.pn * tstepB;
    S.a_ready(cur);
    if constexpr (SP2) {
        PG8_STAGE(PG8_SB(0, 0), cB, voffB); PG8_STAGE(PG8_SB(0, 1), cB + hstepB, voffB); PG8_STAGE(PG8_SA(0, 0), cA, voffA); PG8_STAGE(PG8_SA(0, 1), cA + hstepA, voffA);
        if (wr == 1) PG8_BAR;
        PG8_WAIT_V(2); PG8_BAR;
        PG8_STAGE(PG8_SB(1, 0), cB + kstep, voffB); PG8_STAGE(PG8_SA(1, 0), cA + kstep, voffA); PG8_STAGE(PG8_SB(1, 1), cB + hstepB + kstep, voffB);
        PG8_WAIT_V(6); PG8_BAR;
    } else {
        PG8_STAGE(PG8_SB(0, 0), cB, voffB); PG8_STAGE(PG8_SA(0, 0), cA, voffA); PG8_STAGE(PG8_SB(0, 1), cB + hstepB, voffB); PG8_STAGE(PG8_SA(0, 1), cA + hstepA, voffA);
        if (wr == 1) PG8_BAR;
        PG8_WAIT_V(4); PG8_BAR;
        PG8_STAGE(PG8_SB(1, 0), cB + kstep, voffB); PG8_STAGE(PG8_SA(1, 0), cA + kstep, voffA); PG8_STAGE(PG8_SB(1, 1), cB + hstepB + kstep, voffB);
        PG8_WAIT_V(6); PG8_BAR;
    }
    for (;;) {
        const bool has_next = S.next(ui + 1, nxt);
        const char* nA = has_next ? (const char*)g.A + (size_t)nxt.pm * tstepA : cA; const char* nB = has_next ? (const char*)g.Bt + (size_t)nxt.pn * tstepB : cB;
        for (int t = 0; t < nt; t += 2) {
            const bool last = (t == nt - 2);
            const char* a1 = cA + (size_t)(t + 1) * kstep;
            const char* a2 = last ? nA : cA + (size_t)(t + 2) * kstep; const char* b2 = last ? nB : cB + (size_t)(t + 2) * kstep;
            const char* a3 = a2 + kstep; const char* b3 = b2 + kstep;
            if (last && has_next) S.a_ready(nxt);
            if constexpr (SP2) {
            PG8_LDB(B0, 0, 0); PG8_LDB(B1, 0, 1); PG8_SCHED; PG8_LDA(At, 0, 0); PG8_STAGE(PG8_SA(1, 1), a1 + hstepA, voffA);
            PG8_WAIT_V(8); PG8_WAIT_L(0); PG8_BAR; PG8_MMA(0, 0, At, B0); PG8_MMA(0, 1, At, B1); PG8_BAR; PG8_SCHED;
            PG8_LDA(At, 0, 1); PG8_STAGE(PG8_SB(0, 0), b2, voffB); PG8_STAGE(PG8_SB(0, 1), b2 + hstepB, voffB); PG8_STAGE(PG8_SA(0, 0), a2, voffA);
            PG8_WAIT_V(8); PG8_WAIT_L(0); PG8_BAR; PG8_MMA(1, 0, At, B0); PG8_MMA(1, 1, At, B1); PG8_BAR; PG8_SCHED;
            PG8_LDB(B0, 1, 0); PG8_LDB(B1, 1, 1); PG8_SCHED; PG8_LDA(At, 1, 0); PG8_STAGE(PG8_SA(0, 1), a2 + hstepA, voffA);
            PG8_WAIT_V(8); PG8_WAIT_L(0); PG8_BAR; PG8_MMA(0, 0, At, B0); PG8_MMA(0, 1, At, B1); PG8_BAR; PG8_SCHED;
            PG8_LDA(At, 1, 1); PG8_STAGE(PG8_SB(1, 0), b3, voffB); PG8_STAGE(PG8_SB(1, 1), b3 + hstepB, voffB); PG8_STAGE(PG8_SA(1, 0), a3, voffA);
            PG8_WAIT_V(8); PG8_WAIT_L(0); PG8_BAR; PG8_MMA(1, 0, At, B0); PG8_MMA(1, 1, At, B1); PG8_BAR; PG8_SCHED;
            } else {
            PG8_LDB(B0, 0, 0); PG8_SCHED; PG8_LDA(At, 0, 0); PG8_STAGE(PG8_SA(1, 1), a1 + hstepA, voffA);
            PG8_WAIT_L(8); PG8_BAR; PG8_WAIT_L(0); PG8_MMA(0, 0, At, B0); PG8_BAR; PG8_SCHED;
            PG8_LDB(B1, 0, 1); PG8_STAGE(PG8_SB(0, 0), b2, voffB);
            PG8_BAR; PG8_WAIT_L(0); PG8_MMA(0, 1, At, B1); PG8_BAR;
            PG8_LDA(At, 0, 1); PG8_STAGE(PG8_SA(0, 0), a2, voffA);
            PG8_BAR; PG8_WAIT_L(0); PG8_MMA(1, 0, At, B0); PG8_BAR; PG8_SCHED;
            PG8_STAGE(PG8_SB(0, 1), b2 + hstepB, voffB);
            PG8_WAIT_V(6); PG8_BAR; PG8_MMA(1, 1, At, B1); PG8_BAR;
            PG8_LDB(B0, 1, 0); PG8_SCHED; PG8_LDA(At, 1, 0); PG8_STAGE(PG8_SA(0, 1), a2 + hstepA, voffA);
            PG8_WAIT_L(8); PG8_BAR; PG8_WAIT_L(0); PG8_MMA(0, 0, At, B0); PG8_BAR; PG8_SCHED;
            PG8_LDB(B1, 1, 1); PG8_STAGE(PG8_SB(1, 0), b3, voffB);
            PG8_BAR; PG8_WAIT_L(0); PG8_MMA(0, 1, At, B1); PG8_BAR;
            PG8_LDA(At, 1, 1); PG8_STAGE(PG8_SA(1, 0), a3, voffA);
            PG8_BAR; PG8_WAIT_L(0); PG8_MMA(1, 0, At, B0); PG8_BAR; PG8_SCHED;
            PG8_STAGE(PG8_SB(1, 1), b3 + hstepB, voffB);
            PG8_WAIT_V(6); PG8_BAR; PG8_MMA(1, 1, At, B1); PG8_BAR;
            }
        }
        if constexpr (ALIGN_EPI) { if (wr == 0) PG8_BAR; }
        if constexpr (!Epi::AFTER_DRAIN) { E(acc, cur, wr, wc, fr, fq); S.done(cur); }
        if (!has_next) break;
#pragma unroll
        for (int a = 0; a < 2; ++a)
#pragma unroll
            for (int b = 0; b < 2; ++b)
#pragma unroll
                for (int m = 0; m < 4; ++m)
#pragma unroll
                    for (int n = 0; n < 2; ++n) acc[a][b][m][n] = (f32x4){zf_, zf_, zf_, zf_};
        cur = nxt; cA = nA; cB = nB; ++ui;
        if constexpr (ALIGN_EPI) { if (wr == 1) PG8_BAR; }
    }
    PG8_WAIT_V(0);
    if constexpr (!ALIGN_EPI) { if (wr == 0) PG8_BAR; }
    PG8_BAR;
    if constexpr (Epi::AFTER_DRAIN) { E.fused(acc, cur, wr, wc, fr, fq, lds, wid, lane); S.done(cur); }
#undef PG8_SA
#undef PG8_SB
#undef PG8_STAGE
#undef PG8_LDA
#undef PG8_LDB
#undef PG8_MMA
#undef PG8_WAIT_V
#undef PG8_WAIT_L
#undef PG8_BAR
#undef PG8_SCHED
}
}
using pg8::bf16x8;
constexpr size_t MiB = 1u << 20;
constexpr size_t WS_CTL = 0;
constexpr size_t CTL_ZERO_BYTES = 65536;
constexpr size_t WS_BIASP = 384 * 1024;
constexpr size_t WS_BIASR = 448 * 1024;
constexpr size_t WS_AEND = 128 * 1024;
constexpr size_t WS_GATES = 1 * MiB;
constexpr size_t WS_SMALL = 2 * MiB;
constexpr size_t WS_KC = 4 * MiB;
constexpr size_t WS_LRUSUM = 5 * MiB;
constexpr size_t WS_W = 6 * MiB;
constexpr size_t W_WIN = 0, W_W1K = 13 * MiB + MiB / 2, W_W1V = W_W1K + MiB, W_W2K = W_W1V + MiB, W_W2V = W_W2K + 32768, W_LRUW = W_W2V + 32768  , W_PROJ = 16 * MiB, W_WOUT = 19 * MiB, W_PLEG = 21 * MiB,
                 W_PLEP = 23 * MiB, W_WGU = 24 * MiB, W_WD = 40 * MiB, W_END = 48 * MiB;
constexpr size_t WS_XB = WS_W + W_END;
constexpr size_t WS_PB = WS_XB + 32 * MiB;
constexpr size_t WS_A = WS_PB + 8 * MiB;
constexpr size_t KV_STRIDE = (size_t)4 * SEQ * 64 + 4096;
constexpr size_t WS_Q = WS_A, WS_KV = WS_Q + 16 * MiB, WS_Z = WS_KV + 25 * MiB, WS_XBC = WS_Z + 16 * MiB, WS_LX = WS_XBC + 24 * MiB, WS_LY = WS_LX + 16 * MiB,
                 WS_STATES = WS_LY + 16 * MiB, WS_ONSA = WS_STATES + 16 * MiB, WS_OSSD = WS_ONSA + 16 * MiB, WS_OLRU = WS_OSSD + 16 * MiB, WS_END = WS_OLRU + 16 * MiB;
constexpr size_t WS_MERGE = WS_A;
constexpr size_t WS_MIXB = WS_LY;
constexpr size_t WS_HBUF = WS_A;
constexpr size_t WS_SG = WS_A + 128 * MiB;
static_assert(KV_STRIDE * 2 * 6 <= 25 * MiB, "kv");
static_assert(WS_MERGE + 96 * MiB <= WS_LY && WS_MIXB + 32 * MiB <= WS_ONSA, "overlay map");
static_assert(WS_SG + 32 * MiB <= WS_END && WS_END <= 283 * MiB, "ws map");

constexpr int LDS_BYTES = 147456;

struct Args { const float* in[37]; float* out; unsigned char* ws; int ph_lo, ph_hi; };

__device__ __forceinline__ void tr_job(const float* __restrict__ W, int ld, int K, int c0, int ncols, bf16_t* dst, int ldd, int koff, LAS float* scr, int lane, int gw, int NGW, int& base) {
    const int ncb = (ncols + 31) >> 5, items = (K >> 6) * ncb;
    int first = (gw - (base % NGW) + NGW) % NGW; base += items;
    for (int it = first; it < items; it += NGW) {
        const int kb = it / ncb, nb = it - kb * ncb, k0 = kb << 6, n0 = nb << 5, nv = (ncols - n0) < 32 ? (ncols - n0) : 32;
        const int col = lane & 31;
        if (col < nv) {
#pragma unroll 8
            for (int i = 0; i < 32; ++i) { const int kk = 2 * i + (lane >> 5); scr[kk * 33 + col] = W[(size_t)(k0 + kk) * ld + c0 + n0 + col]; }
        }
        asm volatile("s_waitcnt lgkmcnt(0)" ::: "memory");
        const int c = lane & 7;
#pragma unroll
        for (int j = 0; j < 4; ++j) { const int n = (lane >> 3) + 8 * j;
            if (n < nv) { const LAS float* s = scr + (8 * c) * 33 + n;
                u32x4 o; o.x = pk2(s[0 * 33], s[1 * 33]); o.y = pk2(s[2 * 33], s[3 * 33]); o.z = pk2(s[4 * 33], s[5 * 33]); o.w = pk2(s[6 * 33], s[7 * 33]);
                *(u32x4*)(dst + (size_t)(n0 + n) * ldd + koff + k0 + 8 * c) = o; } }
        asm volatile("s_waitcnt lgkmcnt(0)" ::: "memory");
    }
}
struct TJob { const float* src; int ld, K, c0, ncols; bf16_t* dst; int ldd, koff; };
__device__ __forceinline__ TJob get_job(const Args& a, int L, int j, unsigned char* W) {
    TJob t;
    if (j < 6) {
        t.src = a.in[2] + (size_t)L * D_MODEL * IN_WIDTH; t.ld = IN_WIDTH; t.K = 1024; t.ldd = 1024; t.koff = 0; bf16_t* win = (bf16_t*)(W + W_WIN);
        const int c0s = j == 0 ? 0 : j == 1 ? 1304 : j == 2 ? 2592 : j == 3 ? 1280 : j == 4 ? 2584 : 3616;
        const int ncs = j == 0 ? 1280 : j == 1 ? 1280 : j == 2 ? 1024 : j == 3 ? 24 : j == 4 ? 8 : 3072;
        const int r0 = j == 0 ? 0 : j == 1 ? 1280 : j == 2 ? 2560 : j == 3 ? 3584 : j == 4 ? 3608 : 3840;
        t.c0 = c0s; t.ncols = ncs; t.dst = win + (size_t)r0 * 1024;
    } else if (j < 8) { const int v = j - 6; t.src = a.in[v ? 7 : 4] + (size_t)L * 2048 * 256; t.ld = 256; t.K = 2048; t.c0 = 0; t.ncols = 256; t.dst = (bf16_t*)(W + (v ? W_W1V : W_W1K)); t.ldd = 2048; t.koff = 0;
    } else if (j < 10) { const int v = j - 8; t.src = a.in[v ? 8 : 5] + (size_t)L * 256 * 64; t.ld = 64; t.K = 256; t.c0 = 0; t.ncols = 64; t.dst = (bf16_t*)(W + (v ? W_W2V : W_W2K)); t.ldd = 256; t.koff = 0;
    } else if (j < 13) { const int v = j - 10; t.src = a.in[22 + v] + (size_t)L * 512 * 1024; t.ld = 1024; t.K = 512; t.c0 = 0; t.ncols = 1024; t.dst = (bf16_t*)(W + W_PROJ) + (size_t)v * 1024 * 512; t.ldd = 512; t.koff = 0;
    } else if (j == 13) { t.src = a.in[25] + (size_t)L * 1024 * 1024; t.ld = 1024; t.K = 1024; t.c0 = 0; t.ncols = 1024; t.dst = (bf16_t*)(W + W_WOUT); t.ldd = 1024; t.koff = 0;
    } else if (j == 14) { t.src = a.in[33] + (size_t)L * 1024 * 1024; t.ld = 1024; t.K = 1024; t.c0 = 0; t.ncols = 1024; t.dst = (bf16_t*)(W + W_PLEG); t.ldd = 1024; t.koff = 0;
    } else if (j == 15) { t.src = a.in[34] + (size_t)L * 256 * 1024; t.ld = 1024; t.K = 256; t.c0 = 0; t.ncols = 1024; t.dst = (bf16_t*)(W + W_PLEP); t.ldd = 256; t.koff = 0;
    } else if (j < 32) { const int v = j - 16, which = v >> 3, n = v & 7; t.src = a.in[which ? 19 : 17] + (size_t)(L * 8 + n) * 4096; t.ld = 64; t.K = 64; t.c0 = 0; t.ncols = 64;
        t.dst = (bf16_t*)(W + W_LRUW) + (size_t)v * 4096; t.ldd = 64; t.koff = 0;
    } else { const int q = j - 32, e = q / 5, k = q - 5 * e;
        if (k < 4) { const int hf = k >> 1, up = k & 1; t.src = a.in[up ? 31 : 30] + (size_t)(L * N_EXPERTS + e) * 1024 * 256; t.ld = 256; t.K = 1024; t.c0 = 128 * hf; t.ncols = 128;
            t.dst = (bf16_t*)(W + W_WGU) + (size_t)(256 * (2 * e + hf) + 128 * up) * 1024; t.ldd = 1024; t.koff = 0; }
        else { t.src = a.in[32] + (size_t)(L * N_EXPERTS + e) * 256 * 1024; t.ld = 1024; t.K = 256; t.c0 = 0; t.ncols = 1024; t.dst = (bf16_t*)(W + W_WD); t.ldd = 4096; t.koff = e * 256; }
    }
    return t;
}
constexpr int N_TJOBS = 32 + 5 * N_EXPERTS;
__device__ __forceinline__ void convert_weights(const Args& a, unsigned char* wsp, int L, LAS unsigned char* lds, int vcu, int G, int wave0) {
    const int tid = tid_fresh(wave0), lane = tid & 63, wave = tid >> 6;
    LAS float* scr = (LAS float*)(lds + wave * 16384);
    const int gw = vcu * NWAVES + wave, NGW = G * NWAVES;
    unsigned char* W = wsp + WS_W;
    int base = 0;
    for (int j = 0; j < N_TJOBS; ++j) { const TJob t = get_job(a, L, j, W); tr_job(t.src, t.ld, t.K, t.c0, t.ncols, t.dst, t.ldd, t.koff, scr, lane, gw, NGW, base); }
    {
        u32x4* z = (u32x4*)((bf16_t*)(W + W_WIN) + (size_t)3616 * 1024);
        unsigned zz = 0u; asm volatile("" : "+v"(zz));
        for (int i = gw * 64 + lane; i < 224 * 128; i += NGW * 64) z[i] = (u32x4){zz, zz, zz, zz};
    }
    float* part = (float*)(wsp + WS_BIASP);
    for (int j = gw; j < 256; j += NGW) {
        const int which = j >> 7, hg = (j >> 5) & 3, ks = j & 31;
        const float* pe = a.in[which ? 6 : 3] + (size_t)L * 2048; const float* w1 = a.in[which ? 7 : 4] + (size_t)L * 2048 * 256;
        float s = 0.f;
#pragma unroll 8
        for (int kk = ks * 64; kk < ks * 64 + 64; ++kk) s += pe[kk] * w1[(size_t)kk * 256 + hg * 64 + lane];
        part[(which * 32 + ks) * 256 + hg * 64 + lane] = s;
    }
}
__device__ __forceinline__ void cvt_rows(const float* __restrict__ src, bf16_t* dst, size_t n, int vcu, int G, int wave0) {
    const size_t stride = (size_t)G * NTHREADS; const int tid = tid_fresh(wave0);
    for (size_t i = (size_t)vcu * NTHREADS + tid; i < n / 8; i += stride) {
        const f32x4 a = *(const f32x4*)(src + i * 8), b = *(const f32x4*)(src + i * 8 + 4);
        u32x4 o; o.x = pk2(a[0], a[1]); o.y = pk2(a[2], a[3]); o.z = pk2(b[0], b[1]); o.w = pk2(b[2], b[3]);
        *(u32x4*)(dst + i * 8) = o;
    }
}
template <bool ROUTER>
__device__ __forceinline__ void ln_rows(float* XF, const float* __restrict__ g, const float* __restrict__ b, bf16_t* XB, const float* __restrict__ rw, const float* __restrict__ rb, float* GATES,
                                        LAS unsigned char* lds, int vcu, int G, int wave0) {
    const int tid = tid_fresh(wave0), lane = tid & 63, wave = tid >> 6;
    LAS float* rwT = (LAS float*)lds;
    if (ROUTER) {
        for (int i = tid; i < 16384; i += NTHREADS) rwT[(i & 15) * 1024 + (i >> 4)] = rw[i];
        __syncthreads();
    }
    f32x4 gv[4], bv[4];
#pragma unroll
    for (int j = 0; j < 4; ++j) { gv[j] = *(const f32x4*)(g + 256 * j + 4 * lane); bv[j] = *(const f32x4*)(b + 256 * j + 4 * lane); }
    const int gw = vcu * NWAVES + wave, NGW = G * NWAVES;
    for (int row = gw; row < TOK; row += NGW) {
        float* xr = XF + (size_t)row * 1024;
        f32x4 v[4]; float s = 0.f;
#pragma unroll
        for (int j = 0; j < 4; ++j) { v[j] = *(const f32x4*)(xr + 256 * j + 4 * lane); s += (v[j][0] + v[j][1]) + (v[j][2] + v[j][3]); }
        const float mean = wave_sum(s, lane) * (1.f / 1024.f); float s2 = 0.f;
#pragma unroll
        for (int j = 0; j < 4; ++j) { v[j] = v[j] - mean; s2 += (v[j][0] * v[j][0] + v[j][1] * v[j][1]) + (v[j][2] * v[j][2] + v[j][3] * v[j][3]); }
        const float rstd = 1.0f / sqrtf(wave_sum(s2, lane) * (1.f / 1024.f) + LN_EPS);
#pragma unroll
        for (int j = 0; j < 4; ++j) { v[j] = v[j] * rstd * gv[j] + bv[j]; *(f32x4*)(xr + 256 * j + 4 * lane) = v[j];
            u32x2 w; w.x = pk2(v[j][0], v[j][1]); w.y = pk2(v[j][2], v[j][3]); *(u32x2*)(XB + (size_t)row * 1024 + 256 * j + 4 * lane) = w; }
        if (ROUTER) {
            float aff[16], sel[16];
#pragma unroll
            for (int e = 0; e < 16; ++e) { float p = 0.f;
#pragma unroll
                for (int j = 0; j < 4; ++j) { const f32x4 w = *(const LAS f32x4*)(rwT + e * 1024 + 256 * j + 4 * lane); p += (v[j][0] * w[0] + v[j][1] * w[1]) + (v[j][2] * w[2] + v[j][3] * w[3]); }
                p = wave_sum(p, lane); aff[e] = 1.0f / (1.0f + expf(-p)); sel[e] = aff[e] + rb[e]; }
            int best = 0; float bs = -INFINITY;
#pragma unroll
            for (int q = 0; q < 4; ++q) { float m1 = -INFINITY, m2 = -INFINITY;
#pragma unroll
                for (int k = 0; k < 4; ++k) { const float x = sel[4 * q + k]; if (x > m1) { m2 = m1; m1 = x; } else if (x > m2) m2 = x; }
                const float sc = m1 + m2; if (sc > bs) { bs = sc; best = q; } }
            int i1 = 0, i2 = 0; float m1 = -INFINITY, m2 = -INFINITY;
#pragma unroll
            for (int e = 0; e < 16; ++e) { const float x = ((e >> 2) == best) ? sel[e] : -INFINITY; if (x > m1) { m2 = m1; i2 = i1; m1 = x; i1 = e; } else if (x > m2) { m2 = x; i2 = e; } }
            float a1 = 0.f, a2 = 0.f;
#pragma unroll
            for (int e = 0; e < 16; ++e) { a1 = (e == i1) ? aff[e] : a1; a2 = (e == i2) ? aff[e] : a2; }
            const float inv = 1.0f / (a1 + a2);
            if (lane < 16) GATES[(size_t)row * 16 + lane] = (lane == i1) ? a1 * inv : ((lane == i2) ? a2 * inv : 0.f);
        }
    }
    if (ROUTER) __syncthreads();
}
#ifndef HAVE_NSA
#define HAVE_NSA 1
#endif
#ifndef HAVE_SSD
#define HAVE_SSD 1
#endif
#ifndef HAVE_LRU
#define HAVE_LRU 1
#endif
typedef float f32x16 __attribute__((ext_vector_type(16)));
#define MFMA16(a, b, c) __builtin_amdgcn_mfma_f32_16x16x32_bf16((a), (b), (c), 0, 0, 0)
#define MFMA32(a, b, c) __builtin_amdgcn_mfma_f32_32x32x16_bf16((a), (b), (c), 0, 0, 0)
__device__ __forceinline__ void unpack8f(const u32x4 w, f32x4& a, f32x4& b) {
    a[0] = __uint_as_float(w.x << 16); a[1] = __uint_as_float(w.x & 0xffff0000u); a[2] = __uint_as_float(w.y << 16); a[3] = __uint_as_float(w.y & 0xffff0000u);
    b[0] = __uint_as_float(w.z << 16); b[1] = __uint_as_float(w.z & 0xffff0000u); b[2] = __uint_as_float(w.w << 16); b[3] = __uint_as_float(w.w & 0xffff0000u); }
__device__ __forceinline__ u32x4 pack8f(const f32x4 a, const f32x4 b) { u32x4 w; w.x = pk2(a[0], a[1]); w.y = pk2(a[2], a[3]); w.z = pk2(b[0], b[1]); w.w = pk2(b[2], b[3]); return w; }

constexpr int LRU_XP = 520;
template <bool FINAL>
__device__ __forceinline__ void lru_tile(const Args& a, unsigned char* wsp, int L, int unit, LAS unsigned char* lds, int tid) {
    const int lane = tid & 63, wave = tid >> 6, q = lane >> 4, c16 = lane & 15;
    const int b = unit >> 7, ck = unit & 127, s0 = ck * 64; const size_t t0 = (size_t)b * SEQ + s0;
    const bf16_t* LX = (const bf16_t*)(wsp + WS_LX); const bf16_t* LY = (const bf16_t*)(wsp + WS_LY); bf16_t* OL = (bf16_t*)(wsp + WS_OLRU);
    float* SUM = (float*)(wsp + WS_LRUSUM) + (size_t)(b * 128 + ck) * 1024;
    LAS bf16_t* XT = (LAS bf16_t*)lds;
    const float* cw = a.in[15] + (size_t)L * 4 * 512; const float* cbias = a.in[16] + (size_t)L * 512;
    for (int it = tid; it < 64 * 64; it += NTHREADS) {
        const int tok = it >> 6, ch0 = (it & 63) * 8;
        f32x4 lo = *(const f32x4*)(cbias + ch0), hi = *(const f32x4*)(cbias + ch0 + 4);
#pragma unroll
        for (int k = 0; k < 4; ++k) {
            if (s0 + tok - 3 + k >= 0) {
                f32x4 xl, xh; unpack8f(*(const u32x4*)(LX + (t0 + tok - 3 + k) * 512 + ch0), xl, xh);
                const f32x4 wl = *(const f32x4*)(cw + k * 512 + ch0), wh = *(const f32x4*)(cw + k * 512 + ch0 + 4);
                lo += wl * xl; hi += wh * xh; }
        }
        *(LAS u32x4*)(XT + tok * LRU_XP + ch0) = pack8f(lo, hi);
    }
    __syncthreads();
    const int n = wave;
    const bf16_t* WA = (const bf16_t*)(wsp + WS_W + W_LRUW) + (size_t)n * 4096; const bf16_t* WX = WA + 8 * 4096;
    const float* pba = a.in[18] + (size_t)L * 512; const float* pbx = a.in[20] + (size_t)L * 512; const float* plam = a.in[21] + (size_t)L * 512;
#pragma unroll 1
    for (int nt = 0; nt < 4; ++nt) {
        const int d = nt * 16 + c16, ch = n * 64 + d;
        const bf16x8 wa0 = *(const bf16x8*)(WA + d * 64 + 8 * q), wa1 = *(const bf16x8*)(WA + d * 64 + 32 + 8 * q);
        const bf16x8 wx0 = *(const bf16x8*)(WX + d * 64 + 8 * q), wx1 = *(const bf16x8*)(WX + d * 64 + 32 + 8 * q);
        const float vba = pba[ch], vbx = pbx[ch], sp = softplusf_(-plam[ch]);
        float av[4][4], bv[4][4];
#pragma unroll
        for (int mt = 0; mt < 4; ++mt) {
            const LAS bf16_t* xr = XT + (16 * mt + c16) * LRU_XP + n * 64 + 8 * q;
            const bf16x8 x0 = *(const LAS bf16x8*)xr, x1 = *(const LAS bf16x8*)(xr + 32);
            f32x4 ga = {0.f, 0.f, 0.f, 0.f}, gx = {0.f, 0.f, 0.f, 0.f};
            ga = MFMA16(x0, wa0, ga); ga = MFMA16(x1, wa1, ga); gx = MFMA16(x0, wx0, gx); gx = MFMA16(x1, wx1, gx);
#pragma unroll
            for (int j = 0; j < 4; ++j) {
                const float r = sigmoidf_(ga[j] + vba), ii = sigmoidf_(gx[j] + vbx), la = -8.0f * r * sp;
                const float xv = bf2f(XT[(16 * mt + 4 * q + j) * LRU_XP + ch]);
                av[mt][j] = __expf(la); bv[mt][j] = sqrtf(fmaxf(-expm1f(2.0f * la), 0.f)) * (ii * xv);
            }
        }
        float P[4], H[4];
#pragma unroll
        for (int mt = 0; mt < 4; ++mt) { float p = av[mt][0], h = bv[mt][0];
#pragma unroll
            for (int j = 1; j < 4; ++j) { h = av[mt][j] * h + bv[mt][j]; p *= av[mt][j]; }
            P[mt] = p; H[mt] = h; }
        float h = FINAL ? SUM[512 + ch] : 0.f; float hin[4] = {0.f, 0.f, 0.f, 0.f};
#pragma unroll
        for (int mt = 0; mt < 4; ++mt)
#pragma unroll
            for (int qq = 0; qq < 4; ++qq) { if (q == qq) hin[mt] = h; const float ho = P[mt] * h + H[mt]; h = __int_as_float(__builtin_amdgcn_ds_bpermute((c16 + 16 * qq) << 2, __float_as_int(ho))); }
        if (!FINAL) {
            float pt = (P[0] * P[1]) * (P[2] * P[3]); pt *= shx(pt, 16, lane); pt *= shx(pt, 32, lane);
            if (q == 0) { SUM[ch] = pt; SUM[512 + ch] = h; }
        } else {
#pragma unroll
            for (int mt = 0; mt < 4; ++mt) { float hh = hin[mt];
#pragma unroll
                for (int j = 0; j < 4; ++j) { hh = av[mt][j] * hh + bv[mt][j]; const size_t o = (t0 + 16 * mt + 4 * q + j) * 512 + ch; OL[o] = (bf16_t)f2bf(hh * gelu_tanh(bf2f(LY[o]))); } }
        }
    }
    __syncthreads();
}
__device__ __forceinline__ void lru_carry(const Args& a, unsigned char* wsp, int id) {
    const int b = id >> 9, ch = id & 511; float* S = (float*)(wsp + WS_LRUSUM) + (size_t)b * 128 * 1024 + ch; float carry = 0.f;
#pragma unroll 8
    for (int c = 0; c < 128; ++c) { const float A = S[c * 1024], Hh = S[c * 1024 + 512]; S[c * 1024 + 512] = carry; carry = A * carry + Hh; }
}


constexpr size_t WS_SSQ = 256 * 1024;
__device__ __forceinline__ void ssd_conv8(const bf16_t* XBC, const float* cw, const float* cb, size_t trow, int s, int ch0, f32x4& lo, f32x4& hi) {
    lo = *(const f32x4*)(cb + ch0); hi = *(const f32x4*)(cb + ch0 + 4);
#pragma unroll
    for (int k = 0; k < 4; ++k) {
        if (s - 3 + k >= 0) {
            f32x4 xl, xh; unpack8f(*(const u32x4*)(XBC + (trow - 3 + k) * 768 + ch0), xl, xh);
            const f32x4 wl = *(const f32x4*)(cw + k * 768 + ch0), wh = *(const f32x4*)(cw + k * 768 + ch0 + 4);
            lo += wl * xl; hi += wh * xh; }
    }
#pragma unroll
    for (int i = 0; i < 4; ++i) { lo[i] = siluf_(lo[i]); hi[i] = siluf_(hi[i]); }
}
__device__ __forceinline__ void ssd_prep(const Args& a, unsigned char* wsp, int L, size_t t0, int g, LAS float* dtl, LAS float* acum, int tid) {
    const int lane = tid & 63, wave = tid >> 6;
    {   const int hh = tid >> 7, l = tid & 127, h = g * 4 + hh;
        const float raw = ((const float*)(wsp + WS_SMALL))[(t0 + l) * 32 + 24 + h] + a.in[11][L * 8 + h];
        const float dt = softplusf_(raw), A = -__expf(a.in[12][L * 8 + h]);
        dtl[hh * 128 + l] = dt; acum[hh * 128 + l] = dt * A; }
    __syncthreads();
    if (wave < 4) {
        const float v0 = acum[wave * 128 + 2 * lane], v1 = acum[wave * 128 + 2 * lane + 1]; const float sm = v0 + v1; float inc = sm;
#pragma unroll
        for (int o = 1; o < 64; o <<= 1) { const float t = __int_as_float(__builtin_amdgcn_ds_bpermute(((lane - o) & 63) << 2, __float_as_int(inc))); if (lane >= o) inc += t; }
        const float ex = inc - sm; acum[wave * 128 + 2 * lane] = ex + v0; acum[wave * 128 + 2 * lane + 1] = ex + sm; }
    __syncthreads();
}
__device__ __forceinline__ void ssd_a_unit(const Args& a, unsigned char* wsp, int L, int unit, LAS unsigned char* lds, int tid) {
    const int lane = tid & 63, wave = tid >> 6, q = lane >> 4, c16 = lane & 15;
    const int b = unit >> 7, c = (unit & 127) >> 1, g = unit & 1; const size_t t0 = (size_t)b * SEQ + c * 128;
    LAS float* dtl = (LAS float*)lds; LAS float* acum = dtl + 512; LAS bf16_t* BT = (LAS bf16_t*)(lds + 4096); LAS bf16_t* XdT = BT + 64 * 136;
    const bf16_t* XBC = (const bf16_t*)(wsp + WS_XBC); const float* cw = a.in[9] + (size_t)L * 4 * 768; const float* cb = a.in[10] + (size_t)L * 768;
    ssd_prep(a, wsp, L, t0, g, dtl, acum, tid);
    for (int it = tid; it < 128 * 40; it += NTHREADS) {
        const int l = it / 40, cg = it - l * 40; const int ch0 = cg < 32 ? g * 256 + cg * 8 : 512 + g * 64 + (cg - 32) * 8;
        f32x4 lo, hi; ssd_conv8(XBC, cw, cb, t0 + l, c * 128 + l, ch0, lo, hi);
        if (cg < 32) { const int hh = cg >> 3, p0 = (cg & 7) * 8; const float sc = dtl[hh * 128 + l] * __expf(acum[hh * 128 + 127] - acum[hh * 128 + l]);
            LAS bf16_t* d = XdT + (hh * 64 + p0) * 136 + l;
#pragma unroll
            for (int i = 0; i < 4; ++i) { d[i * 136] = (bf16_t)f2bf(lo[i] * sc); d[(i + 4) * 136] = (bf16_t)f2bf(hi[i] * sc); } }
        else { LAS bf16_t* d = BT + ((cg - 32) * 8) * 136 + l;
#pragma unroll
            for (int i = 0; i < 4; ++i) { d[i * 136] = (bf16_t)f2bf(lo[i]); d[(i + 4) * 136] = (bf16_t)f2bf(hi[i]); } }
    }
    __syncthreads();
    {   const int hh = wave >> 1, nt0 = (wave & 1) * 2, h = g * 4 + hh;
        float* S = (float*)(wsp + WS_STATES) + ((size_t)((b * 64 + c) * 8 + h)) * 4096;
#pragma unroll
        for (int nt = 0; nt < 2; ++nt)
#pragma unroll
            for (int pt = 0; pt < 4; ++pt) { f32x4 acc = {0.f, 0.f, 0.f, 0.f};
#pragma unroll
                for (int ks = 0; ks < 4; ++ks) { const bf16x8 af = *(const LAS bf16x8*)(BT + (16 * (nt0 + nt) + c16) * 136 + 32 * ks + 8 * q);
                    const bf16x8 bf = *(const LAS bf16x8*)(XdT + (hh * 64 + 16 * pt + c16) * 136 + 32 * ks + 8 * q); acc = MFMA16(af, bf, acc); }
                *(f32x4*)(S + (16 * pt + c16) * 64 + 16 * (nt0 + nt) + 4 * q) = acc; }
    }
    if (tid < 4) ((float*)(wsp + WS_AEND))[(b * 64 + c) * 8 + g * 4 + tid] = acum[tid * 128 + 127];
    __syncthreads();
}
__device__ __forceinline__ void ssd_scan(const Args& a, unsigned char* wsp, int id) {
    const int e = id & 4095, h = (id >> 12) & 7, b = id >> 15; float* S = (float*)(wsp + WS_STATES) + (size_t)b * 64 * 8 * 4096 + (size_t)h * 4096 + e;
    const float* AE = (const float*)(wsp + WS_AEND) + b * 64 * 8 + h; float run = 0.f;
#pragma unroll 8
    for (int c = 0; c < 64; ++c) { const float t = S[(size_t)c * 8 * 4096]; const float dec = __expf(AE[c * 8]); S[(size_t)c * 8 * 4096] = run; run = run * dec + t; }
}
__device__ __forceinline__ void ssd_b_unit(const Args& a, unsigned char* wsp, int L, int unit, LAS unsigned char* lds, int tid) {
    const int lane = tid & 63, wave = tid >> 6, q = lane >> 4, c16 = lane & 15;
    const int b = unit >> 7, c = (unit & 127) >> 1, g = unit & 1; const size_t t0 = (size_t)b * SEQ + c * 128;
    LAS float* dtl = (LAS float*)lds; LAS float* acum = dtl + 512;
    LAS bf16_t* CM = (LAS bf16_t*)(lds + 4096); LAS bf16_t* BM = CM + 128 * 72; LAS bf16_t* XS = BM + 128 * 72; LAS bf16_t* XT = XS + 128 * 72; LAS bf16_t* SI = XT + 64 * 136; LAS bf16_t* M1 = SI + 64 * 72 + wave * (16 * 136);
    const bf16_t* XBC = (const bf16_t*)(wsp + WS_XBC); const float* cw = a.in[9] + (size_t)L * 4 * 768; const float* cb = a.in[10] + (size_t)L * 768;
    const bf16_t* Z = (const bf16_t*)(wsp + WS_Z); bf16_t* OS = (bf16_t*)(wsp + WS_OSSD);
    ssd_prep(a, wsp, L, t0, g, dtl, acum, tid);
    for (int it = tid; it < 128 * 16; it += NTHREADS) {
        const int l = it >> 4, cg = it & 15; const int ch0 = 512 + (cg >> 3) * 128 + g * 64 + (cg & 7) * 8;
        f32x4 lo, hi; ssd_conv8(XBC, cw, cb, t0 + l, c * 128 + l, ch0, lo, hi);
        *(LAS u32x4*)((cg < 8 ? BM : CM) + l * 72 + (cg & 7) * 8) = pack8f(lo, hi);
    }
    __syncthreads();
    f32x4 cbm[8];
#pragma unroll
    for (int st = 0; st < 8; ++st) { cbm[st] = (f32x4){0.f, 0.f, 0.f, 0.f};
        if (st <= wave) {
#pragma unroll
            for (int ks = 0; ks < 2; ++ks) { const bf16x8 af = *(const LAS bf16x8*)(CM + (16 * wave + c16) * 72 + 32 * ks + 8 * q), bf = *(const LAS bf16x8*)(BM + (16 * st + c16) * 72 + 32 * ks + 8 * q); cbm[st] = MFMA16(af, bf, cbm[st]); } } }
    float ssq[4] = {0.f, 0.f, 0.f, 0.f};
#pragma unroll 1
    for (int hh = 0; hh < 4; ++hh) {
        const int h = g * 4 + hh;
        __syncthreads();
        for (int it = tid; it < 128 * 8; it += NTHREADS) {
            const int l = it >> 3, p0 = (it & 7) * 8; f32x4 lo, hi; ssd_conv8(XBC, cw, cb, t0 + l, c * 128 + l, h * 64 + p0, lo, hi);
            *(LAS u32x4*)(XS + l * 72 + p0) = pack8f(lo, hi);
            const float dt = dtl[hh * 128 + l]; LAS bf16_t* d = XT + p0 * 136 + l;
#pragma unroll
            for (int i = 0; i < 4; ++i) { d[i * 136] = (bf16_t)f2bf(lo[i] * dt); d[(i + 4) * 136] = (bf16_t)f2bf(hi[i] * dt); }
        }
        {   const float* S = (const float*)(wsp + WS_STATES) + ((size_t)((b * 64 + c) * 8 + h)) * 4096;
            const int p = tid >> 3, n0 = (tid & 7) * 8; const f32x4 s0 = *(const f32x4*)(S + p * 64 + n0), s1 = *(const f32x4*)(S + p * 64 + n0 + 4);
            *(LAS u32x4*)(SI + p * 72 + n0) = pack8f(s0, s1); }
        __syncthreads();
#pragma unroll
        for (int st = 0; st < 8; ++st) { const float as = acum[hh * 128 + 16 * st + c16];
#pragma unroll
            for (int j = 0; j < 4; ++j) { const int l = 16 * wave + 4 * q + j, s = 16 * st + c16;
                const float v = (st <= wave && s <= l) ? cbm[st][j] * __expf(acum[hh * 128 + l] - as) : 0.f; M1[(4 * q + j) * 136 + s] = (bf16_t)f2bf(v); } }
        f32x4 y[4], yo[4];
#pragma unroll
        for (int pt = 0; pt < 4; ++pt) { y[pt] = (f32x4){0.f, 0.f, 0.f, 0.f}; yo[pt] = (f32x4){0.f, 0.f, 0.f, 0.f}; }
        const int nks = (16 * wave + 15) / 32 + 1;
        for (int ks = 0; ks < nks; ++ks) { const bf16x8 af = *(const LAS bf16x8*)(M1 + c16 * 136 + 32 * ks + 8 * q);
#pragma unroll
            for (int pt = 0; pt < 4; ++pt) { const bf16x8 bf = *(const LAS bf16x8*)(XT + (16 * pt + c16) * 136 + 32 * ks + 8 * q); y[pt] = MFMA16(af, bf, y[pt]); } }
#pragma unroll
        for (int ks = 0; ks < 2; ++ks) { const bf16x8 af = *(const LAS bf16x8*)(CM + (16 * wave + c16) * 72 + 32 * ks + 8 * q);
#pragma unroll
            for (int pt = 0; pt < 4; ++pt) { const bf16x8 bf = *(const LAS bf16x8*)(SI + (16 * pt + c16) * 72 + 32 * ks + 8 * q); yo[pt] = MFMA16(af, bf, yo[pt]); } }
        const float Dh = a.in[13][L * 8 + h];
#pragma unroll
        for (int j = 0; j < 4; ++j) { const int l = 16 * wave + 4 * q + j; const float ea = __expf(acum[hh * 128 + l]);
#pragma unroll
            for (int pt = 0; pt < 4; ++pt) { const int p = 16 * pt + c16; const size_t o = (t0 + l) * 512 + h * 64 + p;
                float v = y[pt][j] + ea * yo[pt][j] + Dh * bf2f(XS[l * 72 + p]); v *= siluf_(bf2f(Z[o])); ssq[j] += v * v;
                OS[o] = (bf16_t)f2bf(v * a.in[14][L * 512 + h * 64 + p]); } }
    }
#pragma unroll
    for (int j = 0; j < 4; ++j) { float v = ssq[j]; v += shx(v, 1, lane); v += shx(v, 2, lane); v += shx(v, 4, lane); v += shx(v, 8, lane);
        if (c16 == 0) ((float*)(wsp + WS_SSQ))[(t0 + 16 * wave + 4 * q + j) * 2 + g] = v; }
    __syncthreads();
}


constexpr int ATT_KP = 72;
__device__ __forceinline__ f32x16 att_scores(const LAS bf16_t* kt, const bf16x8 (&qf)[4], int r, int h) {
    f32x16 s = {0.f, 0.f, 0.f, 0.f, 0.f, 0.f, 0.f, 0.f, 0.f, 0.f, 0.f, 0.f, 0.f, 0.f, 0.f, 0.f};
#pragma unroll
    for (int ks = 0; ks < 4; ++ks) { const bf16x8 kf = *(const LAS bf16x8*)(kt + r * ATT_KP + 16 * ks + 8 * h); s = MFMA32(kf, qf[ks], s); }
    return s * 0.125f;
}
__device__ __forceinline__ void att_pv(f32x16& o0, f32x16& o1, const LAS bf16_t* vt, const f32x16& p, int r, int h) {
#pragma unroll
    for (int s = 0; s < 2; ++s) {
        u32x4 pw; pw.x = pk2(p[8 * s + 0], p[8 * s + 1]); pw.y = pk2(p[8 * s + 2], p[8 * s + 3]); pw.z = pk2(p[8 * s + 4], p[8 * s + 5]); pw.w = pk2(p[8 * s + 6], p[8 * s + 7]);
        const bf16x8 pb = __builtin_bit_cast(bf16x8, pw);
        {   const u32x2 lo = *(const LAS u32x2*)(vt + r * ATT_KP + 16 * s + 4 * h), hi = *(const LAS u32x2*)(vt + r * ATT_KP + 16 * s + 8 + 4 * h);
            const u32x4 vw = {lo.x, lo.y, hi.x, hi.y}; o0 = MFMA32(__builtin_bit_cast(bf16x8, vw), pb, o0); }
        {   const u32x2 lo = *(const LAS u32x2*)(vt + (32 + r) * ATT_KP + 16 * s + 4 * h), hi = *(const LAS u32x2*)(vt + (32 + r) * ATT_KP + 16 * s + 8 + 4 * h);
            const u32x4 vw = {lo.x, lo.y, hi.x, hi.y}; o1 = MFMA32(__builtin_bit_cast(bf16x8, vw), pb, o1); }
    }
}
__device__ __forceinline__ void att_online(float& m, float& l, f32x16& o0, f32x16& o1, const f32x16& s, unsigned vm, const LAS bf16_t* vt, int r, int h, int lane) {
    float mx = -1e30f;
#pragma unroll
    for (int i = 0; i < 16; ++i) mx = fmaxf(mx, ((vm >> i) & 1u) ? s[i] : -1e30f);
    mx = fmaxf(mx, shx(mx, 32, lane));
    const float mn = fmaxf(m, mx), alpha = __expf(m - mn); f32x16 p; float ps = 0.f;
#pragma unroll
    for (int i = 0; i < 16; ++i) { p[i] = ((vm >> i) & 1u) ? __expf(s[i] - mn) : 0.f; ps += p[i]; }
    l = l * alpha + ps; m = mn; o0 = o0 * alpha; o1 = o1 * alpha;
    att_pv(o0, o1, vt, p, r, h);
}
struct AttStage { u32x4 k, v; };
__device__ __forceinline__ void att_load(AttStage& sr, const bf16_t* kg, const bf16_t* vg, int vpitch, int tid, bool with_v) {
    const int rr = tid >> 3, ch = (tid & 7) * 8;
    sr.k = *(const u32x4*)(kg + (size_t)rr * 64 + ch);
    if (with_v) sr.v = *(const u32x4*)(vg + (size_t)rr * vpitch + ch);
}
__device__ __forceinline__ void att_store(LAS bf16_t* KT, LAS bf16_t* VT, const AttStage& sr, int tid, bool with_v) {
    const int rr = tid >> 3, ch = (tid & 7) * 8;
    *(LAS u32x4*)(KT + rr * ATT_KP + ch) = sr.k;
    if (with_v) *(LAS u32x4*)(VT + rr * ATT_KP + ch) = sr.v;
}
__device__ __forceinline__ int next_bit(unsigned u0, unsigned u1, unsigned u2, unsigned u3, int from, int last) {
    for (int w = from >> 5; w < 4; ++w) {
        unsigned x = w == 0 ? u0 : (w == 1 ? u1 : (w == 2 ? u2 : u3));
        if (w == (from >> 5)) x &= ~0u << (from & 31);
        if (x) { const int p = w * 32 + __builtin_ctz(x); return p <= last ? p : -1; }
    }
    return -1;
}
constexpr int ATT_BUF = 2 * 64 * ATT_KP;
__device__ __forceinline__ void nsa_unit(const Args& a, unsigned char* wsp, int L, int bg, int qb, LAS unsigned char* lds, int tid) {
    const int lane = tid & 63, wave = tid >> 6, r = lane & 31, h = lane >> 5;
    const int b = bg >> 1, g = bg & 1, t0 = qb * 64; const size_t rowbase = (size_t)b * SEQ + t0;
    LAS bf16_t* BUF = (LAS bf16_t*)lds;
    LAS float* IMP = (LAS float*)(lds + 2 * ATT_BUF * 2); LAS unsigned* SELM = (LAS unsigned*)(IMP + 64 * 128); LAS unsigned* UM = SELM + 256;
    const bf16_t* KV = (const bf16_t*)(wsp + WS_KV); const bf16_t* KC = (const bf16_t*)(wsp + WS_KC) + (size_t)bg * 512 * 64; const bf16_t* VCT = (const bf16_t*)(wsp + WS_KC + 256 * 1024) + (size_t)bg * 64 * 512;
    const bf16_t* KSEL = KV + 2 * KV_STRIDE + (size_t)bg * SEQ * 64; const bf16_t* VSELT = KV + 3 * KV_STRIDE + (size_t)bg * 64 * SEQ;
    const bf16_t* KWIN = KV + 4 * KV_STRIDE + (size_t)bg * SEQ * 64; const bf16_t* VWINT = KV + 5 * KV_STRIDE + (size_t)bg * 64 * SEQ;
    const int tokl = 8 * wave + (r >> 2), hd = g * 4 + (r & 3), tq = t0 + tokl;
    bf16x8 qf[4];
    {   const bf16_t* qp = (const bf16_t*)(wsp + WS_Q) + (rowbase + tokl) * 512 + hd * 64 + 8 * h;
#pragma unroll
        for (int ks = 0; ks < 4; ++ks) qf[ks] = *(const bf16x8*)(qp + 16 * ks); }
    const float* gl = (const float*)(wsp + WS_SMALL) + (rowbase + tokl) * 32 + hd * 3;
    const float g_cmp = sigmoidf_(gl[0]), g_slc = sigmoidf_(gl[1]), g_win = sigmoidf_(gl[2]);
    for (int i = lane; i < 8 * 128; i += 64) IMP[wave * 8 * 128 + i] = 0.f;
    f32x16 fin0, fin1;
#pragma unroll
    for (int i = 0; i < 16; ++i) { fin0[i] = 0.f; fin1[i] = 0.f; }
    const f32x16 zero16 = fin0;
    AttStage sr;
#define ATT_PIPE_BEGIN(FIRST, NEXT, LOADX, WV) \
    { int blk = (FIRST), nb = -1, par = 0; \
      if (blk >= 0) { const int cb_ = blk; LOADX; att_store(BUF, BUF + 64 * ATT_KP, sr, tid, WV); nb = (NEXT); if (nb >= 0) { const int cb_ = nb; LOADX; } } \
      __syncthreads(); \
      while (blk >= 0) { LAS bf16_t* KT = BUF + par * ATT_BUF; LAS bf16_t* VT = KT + 64 * ATT_KP; (void)VT;
#define ATT_PIPE_END(NEXT, LOADX, WV) \
        if (nb >= 0) { att_store(BUF + (par ^ 1) * ATT_BUF, BUF + (par ^ 1) * ATT_BUF + 64 * ATT_KP, sr, tid, WV); const int nb0_ = nb; blk = nb; nb = (NEXT); (void)nb0_; if (nb >= 0) { const int cb_ = nb; LOADX; } } else blk = -1; \
        __syncthreads(); par ^= 1; } }
    const int nmaxq = tq >= 31 ? (((tq - 31) >> 4) < 510 ? ((tq - 31) >> 4) : 510) : -1;
    const int ncb = (((t0 + 63 - 31) >> 4) >> 6) + 1;
    float m = -1e30f, l = 0.f;
    ATT_PIPE_BEGIN(0, (blk + 1 < ncb ? blk + 1 : -1), att_load(sr, KC + (size_t)cb_ * 64 * 64, VCT + cb_ * 64, 512, tid, false), false)
#pragma unroll
        for (int tl = 0; tl < 2; ++tl) {
            const int n0 = blk * 64 + tl * 32; unsigned vm = 0u;
#pragma unroll
            for (int i = 0; i < 16; ++i) vm |= ((n0 + (i & 3) + 8 * (i >> 2) + 4 * h) <= nmaxq ? 1u : 0u) << i;
            if (!__any(vm != 0u)) continue;
            const f32x16 s = att_scores(KT + tl * 32 * ATT_KP, qf, r, h);
            float mx = -1e30f;
#pragma unroll
            for (int i = 0; i < 16; ++i) mx = fmaxf(mx, ((vm >> i) & 1u) ? s[i] : -1e30f);
            mx = fmaxf(mx, shx(mx, 32, lane));
            const float mn = fmaxf(m, mx); float ps = 0.f;
#pragma unroll
            for (int i = 0; i < 16; ++i) ps += ((vm >> i) & 1u) ? __expf(s[i] - mn) : 0.f;
            l = l * __expf(m - mn) + ps; m = mn;
        }
    ATT_PIPE_END((nb0_ + 1 < ncb ? nb0_ + 1 : -1), att_load(sr, KC + (size_t)cb_ * 64 * 64, VCT + cb_ * 64, 512, tid, false), false)
    l += shx(l, 32, lane);
    {
        const float invl = 1.0f / fmaxf(l, 1e-30f); f32x16 o0 = zero16, o1 = zero16;
        ATT_PIPE_BEGIN(0, (blk + 1 < ncb ? blk + 1 : -1), att_load(sr, KC + (size_t)cb_ * 64 * 64, VCT + cb_ * 64, 512, tid, true), true)
#pragma unroll
            for (int tl = 0; tl < 2; ++tl) {
                const int n0 = blk * 64 + tl * 32; unsigned vm = 0u;
#pragma unroll
                for (int i = 0; i < 16; ++i) vm |= ((n0 + (i & 3) + 8 * (i >> 2) + 4 * h) <= nmaxq ? 1u : 0u) << i;
                if (!__any(vm != 0u)) continue;
                const f32x16 s = att_scores(KT + tl * 32 * ATT_KP, qf, r, h); f32x16 p;
#pragma unroll
                for (int i = 0; i < 16; ++i) p[i] = ((vm >> i) & 1u) ? __expf(s[i] - m) * invl : 0.f;
                att_pv(o0, o1, VT + tl * 32, p, r, h);
#pragma unroll
                for (int rq = 0; rq < 4; ++rq) {
                    float av = 2.0f * (p[4 * rq] + p[4 * rq + 1] + p[4 * rq + 2]) + p[4 * rq + 3], bvv = p[4 * rq + 3];
                    av += shx(av, 1, lane); av += shx(av, 2, lane); bvv += shx(bvv, 1, lane); bvv += shx(bvv, 2, lane);
                    const int mb = (n0 >> 2) + 2 * rq + h;
                    if ((r & 3) == 0) { LAS float* ip = IMP + tokl * 128 + mb; ip[0] += av; }
                    if ((r & 3) == 0 && mb + 1 < 128) { LAS float* ip = IMP + tokl * 128 + mb + 1; ip[0] += bvv; }
                }
            }
        ATT_PIPE_END((nb0_ + 1 < ncb ? nb0_ + 1 : -1), att_load(sr, KC + (size_t)cb_ * 64 * 64, VCT + cb_ * 64, 512, tid, true), true)
        fin0 += o0 * g_cmp; fin1 += o1 * g_cmp;
    }
    {
        const int cur = qb;
        for (int tk = 0; tk < 8; ++tk) {
            const int tokw = 8 * wave + tk;
            float v0 = IMP[tokw * 128 + lane], v1 = IMP[tokw * 128 + 64 + lane];
            {   const int b0 = lane, b1 = lane + 64;
                v0 = (b0 == 0 || b0 == cur || b0 == cur - 1) ? 1e4f : (b0 <= cur ? v0 : -1.0f);
                v1 = (b1 == 0 || b1 == cur || b1 == cur - 1) ? 1e4f : (b1 <= cur ? v1 : -1.0f); }
            bool s0 = false, s1 = false;
            for (int it = 0; it < 16; ++it) {
                float bv = v0; int bi = lane; if (v1 > bv) { bv = v1; bi = lane + 64; }
#pragma unroll
                for (int o = 1; o < 64; o <<= 1) { const float ov = shx(bv, o, lane); const int oi = shxi(bi, o, lane); if (ov > bv || (ov == bv && oi < bi)) { bv = ov; bi = oi; } }
                if (bi == lane) { s0 = true; v0 = -INFINITY; } if (bi == lane + 64) { s1 = true; v1 = -INFINITY; }
            }
            const unsigned long long m0 = __ballot(s0), m1 = __ballot(s1);
            if (lane == 0) { SELM[tokw * 4 + 0] = (unsigned)m0; SELM[tokw * 4 + 1] = (unsigned)(m0 >> 32); SELM[tokw * 4 + 2] = (unsigned)m1; SELM[tokw * 4 + 3] = (unsigned)(m1 >> 32); }
        }
    }
    __syncthreads();
    if (tid < 4) { unsigned u = 0u; for (int t = 0; t < 64; ++t) u |= SELM[t * 4 + tid]; UM[tid] = u; }
    __syncthreads();
    {
        m = -1e30f; l = 0.f; f32x16 o0 = zero16, o1 = zero16;
        const unsigned sw0 = SELM[tokl * 4 + 0], sw1 = SELM[tokl * 4 + 1], sw2 = SELM[tokl * 4 + 2], sw3 = SELM[tokl * 4 + 3];
        const unsigned um0 = UM[0], um1 = UM[1], um2 = UM[2], um3 = UM[3];
        ATT_PIPE_BEGIN(next_bit(um0, um1, um2, um3, 0, qb), next_bit(um0, um1, um2, um3, blk + 1, qb), att_load(sr, KSEL + (size_t)cb_ * 64 * 64, VSELT + cb_ * 64, SEQ, tid, true), true)
            const unsigned sw = blk < 32 ? sw0 : (blk < 64 ? sw1 : (blk < 96 ? sw2 : sw3));
            const bool mine = (sw >> (blk & 31)) & 1u;
            if (__any(mine)) {
#pragma unroll
                for (int tl = 0; tl < 2; ++tl) {
                    const int p0 = blk * 64 + tl * 32; unsigned vm = 0u;
#pragma unroll
                    for (int i = 0; i < 16; ++i) vm |= ((mine && (p0 + (i & 3) + 8 * (i >> 2) + 4 * h) <= tq) ? 1u : 0u) << i;
                    if (!__any(vm != 0u)) continue;
                    const f32x16 s = att_scores(KT + tl * 32 * ATT_KP, qf, r, h);
                    att_online(m, l, o0, o1, s, vm, VT + tl * 32, r, h, lane);
                }
            }
        ATT_PIPE_END(next_bit(um0, um1, um2, um3, nb0_ + 1, qb), att_load(sr, KSEL + (size_t)cb_ * 64 * 64, VSELT + cb_ * 64, SEQ, tid, true), true)
        l += shx(l, 32, lane); const float sc = g_slc / fmaxf(l, 1e-30f);
        fin0 += o0 * sc; fin1 += o1 * sc;
    }
    {
        m = -1e30f; l = 0.f; f32x16 o0 = zero16, o1 = zero16;
        ATT_PIPE_BEGIN((qb >= 8 ? qb - 8 : 0), (blk + 1 <= qb ? blk + 1 : -1), att_load(sr, KWIN + (size_t)cb_ * 64 * 64, VWINT + cb_ * 64, SEQ, tid, true), true)
#pragma unroll
            for (int tl = 0; tl < 2; ++tl) {
                const int p0 = blk * 64 + tl * 32; unsigned vm = 0u;
#pragma unroll
                for (int i = 0; i < 16; ++i) { const int pos = p0 + (i & 3) + 8 * (i >> 2) + 4 * h; vm |= ((pos <= tq && pos + 512 > tq) ? 1u : 0u) << i; }
                if (!__any(vm != 0u)) continue;
                const f32x16 s = att_scores(KT + tl * 32 * ATT_KP, qf, r, h);
                att_online(m, l, o0, o1, s, vm, VT + tl * 32, r, h, lane);
            }
        ATT_PIPE_END((nb0_ + 1 <= qb ? nb0_ + 1 : -1), att_load(sr, KWIN + (size_t)cb_ * 64 * 64, VWINT + cb_ * 64, SEQ, tid, true), true)
        l += shx(l, 32, lane); const float sc = g_win / fmaxf(l, 1e-30f);
        fin0 += o0 * sc; fin1 += o1 * sc;
    }
#undef ATT_PIPE_BEGIN
#undef ATT_PIPE_END
    {   bf16_t* op = (bf16_t*)(wsp + WS_ONSA) + (rowbase + tokl) * 512 + hd * 64 + 4 * h;
#pragma unroll
        for (int rq = 0; rq < 4; ++rq) {
            u32x2 w0; w0.x = pk2(fin0[4 * rq], fin0[4 * rq + 1]); w0.y = pk2(fin0[4 * rq + 2], fin0[4 * rq + 3]); *(u32x2*)(op + 8 * rq) = w0;
            u32x2 w1; w1.x = pk2(fin1[4 * rq], fin1[4 * rq + 1]); w1.y = pk2(fin1[4 * rq + 2], fin1[4 * rq + 3]); *(u32x2*)(op + 32 + 8 * rq) = w1; }
    }
    __syncthreads();
}

__device__ __forceinline__ void mixers_p2(const Args& a, unsigned char* wsp, int L, LAS unsigned char* lds, int bid, int G, int wave0) {
#if HAVE_NSA
    for (int u = bid; u < 16; u += G) {
        const int which = u >> 3;
        {   const int tid_ = tid_fresh(wave0); float* br = (float*)(wsp + WS_BIASR) + u * 256;
            if (tid_ < 256) { const float* pp = (const float*)(wsp + WS_BIASP) + which * 32 * 256 + tid_; float sacc = 0.f;
#pragma unroll 8
                for (int ks = 0; ks < 32; ++ks) sacc += pp[ks * 256];
                br[tid_] = sacc; }
            asm volatile("s_waitcnt vmcnt(0)" ::: "memory"); __syncthreads(); }
        pg8::Gemm g{(const bf16_t*)(wsp + WS_KV) + (size_t)which * KV_STRIDE, (const bf16_t*)(wsp + WS_W + (which ? W_W1V : W_W1K)), 2048, 256, 2048, 1024, 2048};
        pg8::StrideOrder S{u & 7, 0, 0, 1};
        pg8::EpiCompress E{(const float*)(wsp + WS_BIASR) + u * 256, (const bf16_t*)(wsp + WS_W + (which ? W_W2V : W_W2K)), (bf16_t*)(wsp + WS_KC + (which ? 256 * 1024 : 0)), which};
        pg8::gemm_phase<pg8::EpiCompress, pg8::StrideOrder, false, true>(lds, g, S, E, wave0);
    }
#endif
    const int tid = tid_fresh(wave0);
#if HAVE_SSD
    for (int u = bid; u < 256; u += G) ssd_a_unit(a, wsp, L, u, lds, tid);
#endif
#if HAVE_LRU
    for (int u = bid; u < 256; u += G) lru_tile<false>(a, wsp, L, u, lds, tid);
#endif
}
__device__ __forceinline__ void mixers_p3(const Args& a, unsigned char* wsp, int L, LAS unsigned char* lds, int bid, int G, int wave0) {
    const int tid = tid_fresh(wave0);
#if HAVE_NSA
    for (int rep = 0; rep < NREP(3); ++rep)
    for (int pr = bid; pr < 256; pr += G) { const int bgp = pr >> 6, i = pr & 63; nsa_unit(a, wsp, L, bgp, 127 - i, lds, tid); nsa_unit(a, wsp, L, bgp, i, lds, tid); }
#endif
#if HAVE_SSD
    for (int id = bid * NTHREADS + tid; id < 65536; id += G * NTHREADS) ssd_scan(a, wsp, id);
#endif
#if HAVE_LRU
    for (int id = bid * NTHREADS + tid; id < 1024; id += G * NTHREADS) lru_carry(a, wsp, id);
#endif
}
__device__ __forceinline__ void mixers_p4(const Args& a, unsigned char* wsp, int L, LAS unsigned char* lds, int bid, int G, int wave0) {
    const int tid = tid_fresh(wave0);
#if HAVE_SSD
    for (int u = bid; u < 256; u += G) ssd_b_unit(a, wsp, L, u, lds, tid);
#endif
#if HAVE_LRU
    for (int u = bid; u < 256; u += G) lru_tile<true>(a, wsp, L, u, lds, tid);
#endif
}
#ifndef PH_MASK
#define PH_MASK 0xFFFF
#endif
#define PHON(k) (((PH_MASK) >> (k)) & 1)
#ifndef MIXERS
#define MIXERS 1
#endif
constexpr int PH_PER_LAYER = 10, N_PHASES = 1 + PH_PER_LAYER * DEPTH;

#define FRESH() int G = G0, bid = bid0; asm volatile("" : "+s"(G), "+s"(bid)); unsigned char* ws = a.ws; asm volatile("" : "+s"(ws)); float* XF = a.out; asm volatile("" : "+s"(XF)); bf16_t* XB = (bf16_t*)(ws + WS_XB); bf16_t* PB = (bf16_t*)(ws + WS_PB); unsigned char* W = ws + WS_W; float* GATES = (float*)(ws + WS_GATES); (void)XB; (void)PB; (void)W; (void)GATES; (void)XF;
#define RUN(k) (lo <= (k) && (k) < hi)
#define SEAM(k) do { if (RUN(k) && RUN((k) + 1)) { nbar += 1u; grid_barrier((unsigned*)(a.ws + WS_CTL + 8192), nbar * (unsigned)G0, wave0); } } while (0)
__device__ __forceinline__ void grid_barrier(unsigned* bar, unsigned target, int wave0) {
    asm volatile("s_waitcnt vmcnt(0) lgkmcnt(0)" ::: "memory");
    __syncthreads();
    if (wave0 == 0) {
        unsigned m = ~0u; asm volatile("" : "+s"(m));
        if (__builtin_amdgcn_mbcnt_hi(m, __builtin_amdgcn_mbcnt_lo(m, 0u)) == 0u) {
            __builtin_amdgcn_fence(__ATOMIC_RELEASE, "agent");
            asm volatile("s_waitcnt vmcnt(0)" ::: "memory");
            __hip_atomic_fetch_add(bar, 1u, __ATOMIC_RELAXED, __HIP_MEMORY_SCOPE_AGENT);
            unsigned spins = 0u;
            while (__hip_atomic_load(bar, __ATOMIC_RELAXED, __HIP_MEMORY_SCOPE_AGENT) < target) { __builtin_amdgcn_s_sleep(2); if (++spins > (1u << 27)) break; }
            __builtin_amdgcn_fence(__ATOMIC_ACQUIRE, "agent");
            asm volatile("s_waitcnt vmcnt(0)" ::: "memory");
        }
    }
    __syncthreads();
}
template <int L>
__device__ __forceinline__ void layer_phases(const Args& a, LAS unsigned char* lds, unsigned& nbar, const int G0, const int bid0, const int wave0, const int lo, const int hi) {
        const int P = 1 + PH_PER_LAYER * L;
        if (PHON(1) && RUN(P + 0)) { FRESH();
            pg8::Gemm g{XB, (const bf16_t*)(W + W_WIN), TOK, 3840, 1024, 1024, 1024}; pg8::StaticOrder S; S.init(TOK, 3840, G, bid);
            pg8::EpiInProj E{(bf16_t*)(ws + WS_Q), (bf16_t*)(ws + WS_KV), (bf16_t*)(ws + WS_Z), (bf16_t*)(ws + WS_XBC), (bf16_t*)(ws + WS_LX), (bf16_t*)(ws + WS_LY), (float*)(ws + WS_SMALL), KV_STRIDE};
            pg8::gemm_phase<pg8::EpiInProj, pg8::StaticOrder, true, true>(lds, g, S, E, wave0);
        }
        SEAM(P + 0);
#if MIXERS
        if (PHON(2) && RUN(P + 1)) { FRESH(); for (int rep = 0; rep < NREP(2); ++rep) mixers_p2(a, ws, L, lds, bid, G, wave0); }
        SEAM(P + 1);
        if (PHON(3) && RUN(P + 2)) { FRESH(); mixers_p3(a, ws, L, lds, bid, G, wave0); }
        SEAM(P + 2);
        if (PHON(4) && RUN(P + 3)) { FRESH(); for (int rep = 0; rep < NREP(4); ++rep) mixers_p4(a, ws, L, lds, bid, G, wave0); }
        SEAM(P + 3);
        if (PHON(5) && RUN(P + 4)) { FRESH();
            pg8::StaticOrder S4; S4.init(TOK, 1024, G, bid); pg8::Unit base;
            for (int j = 0; S4.next(j, base); ++j) {
                {   pg8::Gemm g{XB, (const bf16_t*)(W + W_WIN) + (size_t)3840 * 1024, TOK, 3072, 1024, 1024, 1024}; pg8::StrideOrder S{base.pm, base.pn, 4, 3};
                    pg8::EpiSigBf16 E{(bf16_t*)(ws + WS_MERGE), 3072};
                    pg8::gemm_phase<pg8::EpiSigBf16, pg8::StrideOrder, true, true>(lds, g, S, E, wave0); }
                int first = 1;
#pragma unroll 1
                for (int i = 0; i < 3; ++i) {
                    if ((i == 0 && !HAVE_NSA) || (i == 1 && !HAVE_SSD) || (i == 2 && !HAVE_LRU)) continue;
                    const bf16_t* A = (const bf16_t*)(ws + (i == 0 ? WS_ONSA : (i == 1 ? WS_OSSD : WS_OLRU)));
                    pg8::Gemm g{A, (const bf16_t*)(W + W_PROJ) + (size_t)i * 1024 * 512, TOK, 1024, 512, 512, 512}; pg8::StrideOrder S{base.pm, base.pn, 0, 1};
                    pg8::EpiMix E{(bf16_t*)(ws + WS_MIXB), (const bf16_t*)(ws + WS_MERGE), i * 1024, first, i == 1 ? (const float*)(ws + WS_SSQ) : nullptr}; first = 0;
                    pg8::gemm_phase<pg8::EpiMix, pg8::StrideOrder, true, true>(lds, g, S, E, wave0); }
            }
        }
        SEAM(P + 4);
        if (PHON(6) && RUN(P + 5)) { FRESH();
            pg8::Gemm g{(const bf16_t*)(ws + WS_MIXB), (const bf16_t*)(W + W_WOUT), TOK, 1024, 1024, 1024, 1024}; pg8::StaticOrder S; S.init(TOK, 1024, G, bid);
            pg8::EpiResid E{L == 0 ? a.in[0] : (const float*)XF, XF, ALPHA};
            pg8::gemm_phase<pg8::EpiResid, pg8::StaticOrder, true, true>(lds, g, S, E, wave0);
        }
        SEAM(P + 5);
#else
        if (PHON(6) && RUN(P + 5)) { FRESH();
            const float* xin = L == 0 ? a.in[0] : (const float*)XF;
            const int tid = tid_fresh(wave0); for (size_t i = (size_t)bid * NTHREADS + tid; i < (size_t)TOK * 256; i += (size_t)G * NTHREADS) { const f32x4 v = *(const f32x4*)(xin + 4 * i); *(f32x4*)(XF + 4 * i) = v * ALPHA; }
        }
        SEAM(P + 5);
#endif
        if (PHON(7) && RUN(P + 6)) { FRESH(); ln_rows<true>(XF, a.in[26] + L * 1024, a.in[27] + L * 1024, XB, a.in[28], a.in[29], GATES, lds, bid, G, wave0); }
        SEAM(P + 6);
        if (PHON(8) && RUN(P + 7)) { FRESH();
            if (PHON(11)) {   pg8::Gemm g{XB, (const bf16_t*)(W + W_PLEG), TOK, 1024, 1024, 1024, 1024}; pg8::StaticOrder S; S.init(TOK, 1024, G, bid);
                pg8::EpiSigNat E{(bf16_t*)(ws + WS_SG), XF};
                pg8::gemm_phase<pg8::EpiSigNat, pg8::StaticOrder, true, true>(lds, g, S, E, wave0); }
#ifdef FENCE_TEST
            __threadfence(); asm volatile("s_waitcnt vmcnt(0) lgkmcnt(0)" ::: "memory"); __syncthreads();
#endif
            if (PHON(12)) {   pg8::Gemm g{PB, (const bf16_t*)(W + W_PLEP), TOK, 1024, 256, 256, 256}; pg8::StaticOrder S; S.init(TOK, 1024, G, bid);
                pg8::EpiPleProj E{XF, (const bf16_t*)(ws + WS_SG), ALPHA};
                pg8::gemm_phase<pg8::EpiPleProj, pg8::StaticOrder, true, true>(lds, g, S, E, wave0); }
            if (PHON(13)) {   pg8::Gemm g{XB, (const bf16_t*)(W + W_WGU), TOK, 8192, 1024, 1024, 1024}; pg8::StaticOrder S; S.init(TOK, 8192, G, bid);
                pg8::EpiMoeUp E{(bf16_t*)(ws + WS_HBUF), GATES};
                pg8::gemm_phase<pg8::EpiMoeUp, pg8::StaticOrder, true, true>(lds, g, S, E, wave0); }
        }
        SEAM(P + 7);
        if (PHON(9) && RUN(P + 8)) { FRESH();
            pg8::Gemm g{(const bf16_t*)(ws + WS_HBUF), (const bf16_t*)(W + W_WD), TOK, 1024, 4096, 4096, 4096}; pg8::StaticOrder S; S.init(TOK, 1024, G, bid);
            pg8::EpiAccum E{XF};
            pg8::gemm_phase<pg8::EpiAccum, pg8::StaticOrder, true, true>(lds, g, S, E, wave0);
        }
        SEAM(P + 8);
        if (PHON(10) && RUN(P + 9)) { FRESH();
            if (L >= 0) { ln_rows<false>(XF, a.in[35] + L * 1024, a.in[36] + L * 1024, XB, nullptr, nullptr, nullptr, lds, bid, G, wave0); __syncthreads(); }
            else cvt_rows(a.in[0], XB, (size_t)TOK * 1024, bid, G, wave0);
            if (L + 1 < DEPTH) { for (int rep = 0; rep < NREP(10); ++rep) convert_weights(a, ws, L + 1, lds, bid, G, wave0); cvt_rows(a.in[1] + (size_t)(L + 1) * TOK * 256, PB, (size_t)TOK * 256, bid, G, wave0); }
        }
        if (L + 1 < DEPTH) SEAM(P + 9);
}
#undef RUN
#undef SEAM
#undef FRESH

__global__ void __launch_bounds__(NTHREADS, 2) fwd_kernel(Args a) {
    extern __shared__ __attribute__((aligned(16))) unsigned char lds_raw[];
    LAS unsigned char* lds = (LAS unsigned char*)lds_raw;
    const int G0 = gridDim.x, bid0 = blockIdx.x, wave0 = __builtin_amdgcn_readfirstlane(threadIdx.x >> 6);
    const int lo = a.ph_lo, hi = a.ph_hi;
    if (hi - lo > 1) { cg::grid_group grid = cg::this_grid(); grid.sync(); }
    unsigned nbar = 0u;
    layer_phases<-1>(a, lds, nbar, G0, bid0, wave0, lo, hi);
    layer_phases<0>(a, lds, nbar, G0, bid0, wave0, lo, hi);
    layer_phases<1>(a, lds, nbar, G0, bid0, wave0, lo, hi);
    static_assert(DEPTH == 2, "layer_phases instantiations");
}

extern "C" void kernel_launch(void* const* d_in, const int* in_sizes, int n_in, void* d_out, int out_size, void* d_ws, size_t ws_size, hipStream_t stream) {
    static int grid = 0;
    if (grid == 0) {
        if (n_in != 37 || out_size != TOK * D_MODEL || ws_size < WS_END) { fprintf(stderr, "kernel_launch: unexpected shapes (n_in %d, out %d, ws %zu < %zu)\n", n_in, out_size, ws_size, (size_t)WS_END); grid = -1; return; }
        int dev = 0, cus = 0, per_cu = 0;
        hipGetDevice(&dev); hipDeviceGetAttribute(&cus, hipDeviceAttributeMultiprocessorCount, dev);
        if (hipFuncSetAttribute((const void*)fwd_kernel, hipFuncAttributeMaxDynamicSharedMemorySize, LDS_BYTES) != hipSuccess) { fprintf(stderr, "kernel_launch: hipFuncSetAttribute failed\n"); grid = -1; return; }
        if (hipOccupancyMaxActiveBlocksPerMultiprocessor(&per_cu, (const void*)fwd_kernel, NTHREADS, LDS_BYTES) != hipSuccess || per_cu < 1) { fprintf(stderr, "kernel_launch: occupancy query says %d blocks per CU\n", per_cu); grid = -1; return; }
        (void)hipGetLastError();
        grid = cus;
    }
    if (grid < 0) return;
    hipMemsetAsync((char*)d_ws + WS_CTL, 0, CTL_ZERO_BYTES, stream);
    Args a{};
    for (int i = 0; i < 37; ++i) a.in[i] = (const float*)d_in[i];
    a.out = (float*)d_out; a.ws = (unsigned char*)d_ws;
#ifndef N_LAUNCH_SPLIT
    a.ph_lo = 0; a.ph_hi = N_PHASES;
    void* args[] = {&a};
    hipError_t e = hipLaunchCooperativeKernel((const void*)fwd_kernel, dim3(grid), dim3(NTHREADS), args, LDS_BYTES, stream);
    if (e != hipSuccess) fprintf(stderr, "cooperative launch failed: %s (grid %d)\n", hipGetErrorString(e), grid);
#else
    for (int p = 0; p < N_PHASES; ++p) { a.ph_lo = p; a.ph_hi = p + 1; void* args[] = {&a};
        hipError_t e = hipLaunchCooperativeKernel((const void*)fwd_kernel, dim3(grid), dim3(NTHREADS), args, LDS_BYTES, stream);
        if (e != hipSuccess) { fprintf(stderr, "launch %d failed: %s\n", p, hipGetErrorString(e)); break; } }
#endif
}
```

```cpp
#include <hip/hip_runtime.h>
#include <hip/hip_cooperative_groups.h>
#include <cstdio>
#include <cstdint>
namespace cg = cooperative_groups;

#define LAS __attribute__((address_space(3)))
#define GAS_ __attribute__((address_space(1)))
typedef unsigned short bf16_t;
typedef short bf16x8 __attribute__((ext_vector_type(8)));
typedef float f32x4 __attribute__((ext_vector_type(4)));
typedef float f32x2 __attribute__((ext_vector_type(2)));
typedef unsigned u32x4 __attribute__((ext_vector_type(4)));
typedef unsigned u32x2 __attribute__((ext_vector_type(2)));

constexpr int D_MODEL = 1024, BATCH = 2, SEQ = 8192, DEPTH = 2, TOK = BATCH * SEQ;
constexpr int PLE_DIM = 256;
constexpr int IN_WIDTH = 6688;
constexpr int N_EXPERTS = 16, D_EXPERT = 256;
constexpr float ALPHA = 1.4142135623730951f;
constexpr float LN_EPS = 1e-5f, RMS_EPS = 1e-5f;
constexpr int NWAVES = 8, NTHREADS = 512;

__device__ __forceinline__ float bf2f(unsigned h) { return __uint_as_float(h << 16); }
__device__ __forceinline__ unsigned f2bf(float f) { unsigned u = __float_as_uint(f); return (u + 0x7fffu + ((u >> 16) & 1u)) >> 16; }
__device__ __forceinline__ unsigned pk2(float lo, float hi) { return f2bf(lo) | (f2bf(hi) << 16); }
__device__ __forceinline__ float sigmoidf_(float x) { return 1.0f / (1.0f + __expf(-x)); }
__device__ __forceinline__ float siluf_(float x) { return x / (1.0f + __expf(-x)); }
__device__ __forceinline__ float gelu_tanh(float x) { const float u = 0.7978845608028654f * (x + 0.044715f * x * x * x); const float t = 1.0f - 2.0f / (1.0f + __expf(2.0f * u)); return 0.5f * x * (1.0f + t); }
__device__ __forceinline__ float softplusf_(float x) { return x > 20.f ? x : log1pf(__expf(x)); }
__device__ __forceinline__ int shxi(int v, int o, int lane) {
    switch (o) {
        case 1: return __builtin_amdgcn_ds_swizzle(v, 0x1f | (1 << 10));
        case 2: return __builtin_amdgcn_ds_swizzle(v, 0x1f | (2 << 10));
        case 4: return __builtin_amdgcn_ds_swizzle(v, 0x1f | (4 << 10));
        case 8: return __builtin_amdgcn_ds_swizzle(v, 0x1f | (8 << 10));
        case 16: return __builtin_amdgcn_ds_swizzle(v, 0x1f | (16 << 10));
        default: { auto rr = __builtin_amdgcn_permlane32_swap((unsigned)v, (unsigned)v, false, false); return (int)(lane >= 32 ? rr[0] : rr[1]); }
    }
}
__device__ __forceinline__ float shx(float v, int o, int lane) { return __int_as_float(shxi(__float_as_int(v), o, lane)); }
#define dpp_f(v, ctrl) __int_as_float(__builtin_amdgcn_update_dpp(0, __float_as_int(v), (ctrl), 0xf, 0xf, false))
__device__ __forceinline__ float wave_sum(float v, int lane) {
    v += dpp_f(v, 0xB1); v += dpp_f(v, 0x4E); v += dpp_f(v, 0x141); v += dpp_f(v, 0x140);
    v += shx(v, 16, lane); v += shx(v, 32, lane);
    return v;
}
__device__ __forceinline__ float wave_max(float v, int lane) {
#pragma unroll
    for (int o = 1; o < 64; o <<= 1) v = fmaxf(v, shx(v, o, lane));
    return v;
}
typedef __bf16 bf16x2_hw __attribute__((ext_vector_type(2)));
__device__ __forceinline__ unsigned cvtpk(float lo, float hi) { f32x2 v = {lo, hi}; bf16x2_hw b = __builtin_convertvector(v, bf16x2_hw); return __builtin_bit_cast(unsigned, b); }
__device__ __forceinline__ int tid_fresh(int wave0) { unsigned m = ~0u; asm volatile("" : "+s"(m)); const int l = (int)__builtin_amdgcn_mbcnt_hi(m, __builtin_amdgcn_mbcnt_lo(m, 0u)); return wave0 * 64 + l; }
#ifndef DUP_MASK
#define DUP_MASK 0
#endif
#define NREP(k) ((((DUP_MASK) >> (k)) & 1) ? 2 : 1)
namespace pg8 {
#define PG8_LAS __attribute__((address_space(3)))
typedef unsigned short bf16_t;
typedef short bf16x8 __attribute__((ext_vector_type(8)));
typedef float f32x4 __attribute__((ext_vector_type(4)));
typedef unsigned u32x4 __attribute__((ext_vector_type(4)));
constexpr int BM = 256, BK = 64, HALF = 128, HTB = HALF * BK * 2  , STAGE_BYTES = 8 * HTB, NXCD = 8, WGM = 8;

__host__ __device__ __forceinline__ int lds_byte(int r, int c) { const int st = (r >> 4) * 2 + (c >> 5), rr = r & 15, cc = c & 31, ob = rr * 64 + cc * 2; return st * 1024 + (ob ^ (((ob >> 9) & 1) << 5)); }
__host__ __device__ __forceinline__ void stage_rc(int b, int& R, int& C) { const int st = b / 1024, sb = b % 1024, swz = sb ^ (((sb >> 9) & 1) << 5); R = (st >> 1) * 16 + swz / 64; C = (st & 1) * 32 + (swz % 64) / 2; }
__host__ __device__ __forceinline__ int perm32(int rho) { const int n = rho >> 4, i = rho & 15; return 8 * (i >> 2) + 4 * n + (i & 3); }

struct Unit { int pm, pn, pk, aux; };
struct Gemm { const bf16_t* A; const bf16_t* Bt; int M, N, K, lda, ldb; const int* glist; const unsigned* gcnt; };

struct StaticOrder {
    int nM, nN, nwg, G, c;
    __host__ __device__ __forceinline__ void init(int M, int N, int G_, int c_) { nM = M / BM; nN = N / BM; nwg = nM * nN; G = G_; c = c_; }
    __host__ __device__ __forceinline__ bool next(int i, Unit& u) const {
        const long L = (long)i * G + c; if (L >= nwg) return false;
        int wgid = (int)L; { const int q = nwg / NXCD, r = nwg % NXCD, xcd = wgid % NXCD, off = wgid / NXCD; wgid = (xcd < r ? xcd * (q + 1) : r * (q + 1) + (xcd - r) * q) + off; }
        const int nig = WGM * nN, gid = wgid / nig, fm = gid * WGM, gsz = (nM - fm) < WGM ? (nM - fm) : WGM;
        u.pm = fm + ((wgid % nig) % gsz); u.pn = (wgid % nig) / gsz; u.pk = 0; u.aux = 0; return true;
    }
    __device__ __forceinline__ void a_ready(const Unit&) const {}
    __device__ __forceinline__ void done(const Unit&) const {}
};

__device__ __forceinline__ int lane_fresh() { unsigned m = ~0u; asm volatile("" : "+s"(m)); return (int)__builtin_amdgcn_mbcnt_hi(m, __builtin_amdgcn_mbcnt_lo(m, 0u)); }
typedef __bf16 bf16x2_t_ __attribute__((ext_vector_type(2)));
__device__ __forceinline__ unsigned cvt_pk_bf16(float lo, float hi) { f32x2 v = {lo, hi}; bf16x2_t_ b = __builtin_convertvector(v, bf16x2_t_); return __builtin_bit_cast(unsigned, b); }
__device__ __forceinline__ u32x4 pack8(const f32x4 a, const f32x4 b) { u32x4 w; w.x = cvt_pk_bf16(a[0], a[1]); w.y = cvt_pk_bf16(a[2], a[3]); w.z = cvt_pk_bf16(b[0], b[1]); w.w = cvt_pk_bf16(b[2], b[3]); return w; }
__device__ __forceinline__ void unpack8(const u32x4 w, f32x4& a, f32x4& b) {
    a[0] = __uint_as_float(w.x << 16); a[1] = __uint_as_float(w.x & 0xffff0000u); a[2] = __uint_as_float(w.y << 16); a[3] = __uint_as_float(w.y & 0xffff0000u);
    b[0] = __uint_as_float(w.z << 16); b[1] = __uint_as_float(w.z & 0xffff0000u); b[2] = __uint_as_float(w.w << 16); b[3] = __uint_as_float(w.w & 0xffff0000u); }
__device__ __forceinline__ f32x4 sig4(const f32x4 v) { f32x4 o; o[0] = __builtin_amdgcn_rcpf(1.f + __expf(-v[0])); o[1] = __builtin_amdgcn_rcpf(1.f + __expf(-v[1])); o[2] = __builtin_amdgcn_rcpf(1.f + __expf(-v[2])); o[3] = __builtin_amdgcn_rcpf(1.f + __expf(-v[3])); return o; }

struct EpiInProj {
    static constexpr bool PERM = true, AFTER_DRAIN = false, MIDHOOK = false;
    bf16_t *Q, *KV, *Z, *XBC, *LX, *LY; float* SMALL; size_t kvstride;
    __device__ __forceinline__ void operator()(const f32x4 (&acc)[2][2][4][2], const Unit& u, int wr, int wc, int, int) const { const int ln_ = lane_fresh(), fr = ln_ & 15, fq = ln_ >> 4;
        const int pn = u.pn, row0 = u.pm * BM + wr * 64 + fr, cw = wc * 32 + 8 * fq;
        if (pn >= 2 && pn < 5) {
            const int g = cw >> 6, d = cw & 63;
#pragma unroll
            for (int bj = 0; bj < 2; ++bj) { bf16_t* base = KV + (size_t)((pn - 2) * 2 + bj) * kvstride;
                if (bj == 1 && pn >= 3) {
#pragma unroll
                    for (int ai = 0; ai < 2; ++ai)
#pragma unroll
                        for (int m = 0; m < 4; ++m) { const int r = row0 + ai * HALF + m * 16, b = r >> 13, s = r & (SEQ - 1); const u32x4 w = pack8(acc[ai][bj][m][0], acc[ai][bj][m][1]);
                            bf16_t* tp = base + ((size_t)((b * 2 + g) * 64 + d)) * SEQ + s;
                            tp[0] = (bf16_t)(w.x & 0xffffu); tp[SEQ] = (bf16_t)(w.x >> 16); tp[2 * SEQ] = (bf16_t)(w.y & 0xffffu); tp[3 * SEQ] = (bf16_t)(w.y >> 16);
                            tp[4 * SEQ] = (bf16_t)(w.z & 0xffffu); tp[5 * SEQ] = (bf16_t)(w.z >> 16); tp[6 * SEQ] = (bf16_t)(w.w & 0xffffu); tp[7 * SEQ] = (bf16_t)(w.w >> 16); }
                } else {
#pragma unroll
                for (int ai = 0; ai < 2; ++ai)
#pragma unroll
                    for (int m = 0; m < 4; ++m) { const int r = row0 + ai * HALF + m * 16, b = r >> 13, s = r & (SEQ - 1);
                        *(u32x4*)(base + ((size_t)((b * 2 + g) * SEQ + s)) * 64 + d) = pack8(acc[ai][bj][m][0], acc[ai][bj][m][1]); } } }
        } else if (pn == 14) {
            if (wc == 0) {
#pragma unroll
                for (int ai = 0; ai < 2; ++ai)
#pragma unroll
                    for (int m = 0; m < 4; ++m) { const int r = row0 + ai * HALF + m * 16; float* p = SMALL + (size_t)r * 32 + 8 * fq;
                        *(f32x4*)p = acc[ai][0][m][0]; *(f32x4*)(p + 4) = acc[ai][0][m][1]; } }
        } else {
            bf16_t* dst; int pitch, cb; float qs = 1.0f;
            if (pn < 2) { dst = Q; pitch = 512; cb = pn * 256; qs = 0.18033688011112042f; }
            else if (pn < 7) { dst = Z; pitch = 512; cb = (pn - 5) * 256; }
            else if (pn < 10) { dst = XBC; pitch = 768; cb = (pn - 7) * 256; }
            else if (pn < 12) { dst = LX; pitch = 512; cb = (pn - 10) * 256; }
            else { dst = LY; pitch = 512; cb = (pn - 12) * 256; }
#pragma unroll
            for (int ai = 0; ai < 2; ++ai)
#pragma unroll
                for (int m = 0; m < 4; ++m) { bf16_t* rowp = dst + (size_t)(row0 + ai * HALF + m * 16) * pitch + cb + cw;
#pragma unroll
                    for (int bj = 0; bj < 2; ++bj) *(u32x4*)(rowp + bj * HALF) = pack8(acc[ai][bj][m][0] * qs, acc[ai][bj][m][1] * qs); }
        }
    }
};
struct EpiSigBf16 {
    static constexpr bool PERM = true, AFTER_DRAIN = false, MIDHOOK = false;
    bf16_t* O; int ldc;
    __device__ __forceinline__ void operator()(const f32x4 (&acc)[2][2][4][2], const Unit& u, int wr, int wc, int, int) const { const int ln_ = lane_fresh(), fr = ln_ & 15, fq = ln_ >> 4;
        const int row0 = u.pm * BM + wr * 64 + fr, col0 = u.pn * BM + wc * 32 + 8 * fq;
#pragma unroll
        for (int ai = 0; ai < 2; ++ai)
#pragma unroll
            for (int m = 0; m < 4; ++m) { bf16_t* rowp = O + (size_t)(row0 + ai * HALF + m * 16) * ldc + col0;
#pragma unroll
                for (int bj = 0; bj < 2; ++bj) *(u32x4*)(rowp + bj * HALF) = pack8(sig4(acc[ai][bj][m][0]), sig4(acc[ai][bj][m][1])); }
    }
};
struct EpiMix {
    static constexpr bool PERM = true, AFTER_DRAIN = false, MIDHOOK = false;
    bf16_t* MIX; const bf16_t* G; int goff; int first; const float* SSQ;
    __device__ __forceinline__ void operator()(const f32x4 (&acc)[2][2][4][2], const Unit& u, int wr, int wc, int, int) const { const int ln_ = lane_fresh(), fr = ln_ & 15, fq = ln_ >> 4;
        const int row0 = u.pm * BM + wr * 64 + fr, col0 = u.pn * BM + wc * 32 + 8 * fq;
#pragma unroll
        for (int ai = 0; ai < 2; ++ai)
#pragma unroll
          for (int mh = 0; mh < 2; ++mh) {
            u32x4 gg[2][2], pp[2][2]; f32x2 qq[2];
#pragma unroll
            for (int mm = 0; mm < 2; ++mm) { const size_t r = (size_t)(row0 + ai * HALF + (2 * mh + mm) * 16);
                qq[mm] = SSQ ? *(const f32x2*)(SSQ + r * 2) : (f32x2){0.f, 0.f};
#pragma unroll
                for (int bj = 0; bj < 2; ++bj) { const int c = col0 + bj * HALF; gg[mm][bj] = *(const u32x4*)(G + r * 3072 + goff + c); pp[mm][bj] = first ? (u32x4){0u, 0u, 0u, 0u} : *(const u32x4*)(MIX + r * 1024 + c); } }
            asm volatile("" ::: "memory");
#pragma unroll
            for (int mm = 0; mm < 2; ++mm) { const int m = 2 * mh + mm; const size_t r = (size_t)(row0 + ai * HALF + m * 16);
                const float rs = SSQ ? 1.0f / sqrtf((qq[mm][0] + qq[mm][1]) * (1.f / 512.f) + 1e-5f) : 1.f;
#pragma unroll
                for (int bj = 0; bj < 2; ++bj) { const int c = col0 + bj * HALF;
                    f32x4 g0, g1, p0, p1; unpack8(gg[mm][bj], g0, g1); unpack8(pp[mm][bj], p0, p1);
                    const f32x4 v0 = acc[ai][bj][m][0] * g0 * rs + p0, v1 = acc[ai][bj][m][1] * g1 * rs + p1;
                    *(u32x4*)(MIX + r * 1024 + c) = pack8(v0, v1); } }
            asm volatile("" ::: "memory"); }
    }
};
struct EpiResid {
    static constexpr bool PERM = false, AFTER_DRAIN = false, MIDHOOK = false;
    const bf16_t* XINB; float* XF; float alpha;
    __device__ __forceinline__ void operator()(const f32x4 (&acc)[2][2][4][2], const Unit& u, int wr, int wc, int, int) const { const int ln_ = lane_fresh(), fr = ln_ & 15, fq = ln_ >> 4;
        const int row0 = u.pm * BM + wr * 64 + fr, col0 = u.pn * BM + wc * 32 + 4 * fq;
#pragma unroll
        for (int ai = 0; ai < 2; ++ai) {
            u32x2 xx[4][2][2];
#pragma unroll
            for (int m = 0; m < 4; ++m) { const size_t off = (size_t)(row0 + ai * HALF + m * 16) * 1024 + col0;
#pragma unroll
                for (int bj = 0; bj < 2; ++bj)
#pragma unroll
                    for (int n = 0; n < 2; ++n) xx[m][bj][n] = *(const u32x2*)(XINB + off + bj * HALF + n * 16); }
            asm volatile("" ::: "memory");
#pragma unroll
            for (int m = 0; m < 4; ++m) { const size_t off = (size_t)(row0 + ai * HALF + m * 16) * 1024 + col0;
#pragma unroll
                for (int bj = 0; bj < 2; ++bj)
#pragma unroll
                    for (int n = 0; n < 2; ++n) { const u32x2 w = xx[m][bj][n];
                        f32x4 xv; xv[0] = __uint_as_float(w.x << 16); xv[1] = __uint_as_float(w.x & 0xffff0000u); xv[2] = __uint_as_float(w.y << 16); xv[3] = __uint_as_float(w.y & 0xffff0000u);
                        *(f32x4*)(XF + off + bj * HALF + n * 16) = xv * alpha + acc[ai][bj][m][n]; } }
            asm volatile("" ::: "memory"); }
    }
};
struct EpiSigNat {
    static constexpr bool PERM = false, AFTER_DRAIN = false, MIDHOOK = false;
    bf16_t* SG; float* XFDBG;
    __device__ __forceinline__ void operator()(const f32x4 (&acc)[2][2][4][2], const Unit& u, int wr, int wc, int, int) const { const int ln_ = lane_fresh(), fr = ln_ & 15, fq = ln_ >> 4;
        const int row0 = u.pm * BM + wr * 64 + fr, col0 = u.pn * BM + wc * 32 + 4 * fq;
#pragma unroll
        for (int ai = 0; ai < 2; ++ai)
#pragma unroll
            for (int m = 0; m < 4; ++m) { const size_t off = (size_t)(row0 + ai * HALF + m * 16) * 1024 + col0;
#pragma unroll
                for (int bj = 0; bj < 2; ++bj)
#pragma unroll
                    for (int n = 0; n < 2; ++n) { const f32x4 s = sig4(acc[ai][bj][m][n]); u32x2 w; w.x = cvt_pk_bf16(s[0], s[1]); w.y = cvt_pk_bf16(s[2], s[3]); *(u32x2*)(SG + off + bj * HALF + n * 16) = w;
#ifdef SIG_TO_XF
                        { float* xf = XFDBG + off + bj * HALF + n * 16; const f32x4 x = *(const f32x4*)xf; *(f32x4*)xf = x + s; }
#endif
                    } }
    }
};
struct EpiPleProj {
    static constexpr bool PERM = false, AFTER_DRAIN = false, MIDHOOK = false;
    bf16_t* SG;
    __device__ __forceinline__ void operator()(const f32x4 (&acc)[2][2][4][2], const Unit& u, int wr, int wc, int, int) const { const int ln_ = lane_fresh(), fr = ln_ & 15, fq = ln_ >> 4;
        const int row0 = u.pm * BM + wr * 64 + fr, col0 = u.pn * BM + wc * 32 + 4 * fq;
#pragma unroll
        for (int ai = 0; ai < 2; ++ai) {
            u32x2 ss[4][2][2];
#pragma unroll
            for (int m = 0; m < 4; ++m) { const size_t off = (size_t)(row0 + ai * HALF + m * 16) * 1024 + col0;
#pragma unroll
                for (int bj = 0; bj < 2; ++bj)
#pragma unroll
                    for (int n = 0; n < 2; ++n) ss[m][bj][n] = *(const u32x2*)(SG + off + bj * HALF + n * 16); }
            asm volatile("" ::: "memory");
#pragma unroll
            for (int m = 0; m < 4; ++m) { const size_t off = (size_t)(row0 + ai * HALF + m * 16) * 1024 + col0;
#pragma unroll
                for (int bj = 0; bj < 2; ++bj)
#pragma unroll
                    for (int n = 0; n < 2; ++n) { const u32x2 w = ss[m][bj][n];
                        f32x4 sv; sv[0] = __uint_as_float(w.x << 16); sv[1] = __uint_as_float(w.x & 0xffff0000u); sv[2] = __uint_as_float(w.y << 16); sv[3] = __uint_as_float(w.y & 0xffff0000u);
                        const f32x4 pv = sv * acc[ai][bj][m][n]; u32x2 o; o.x = cvt_pk_bf16(pv[0], pv[1]); o.y = cvt_pk_bf16(pv[2], pv[3]);
                        *(u32x2*)(SG + off + bj * HALF + n * 16) = o; } }
            asm volatile("" ::: "memory"); }
    }
};
struct MoeOrder {
    const unsigned* cnt; int G, c, nsub, down;
    __device__ __forceinline__ bool next(int i, Unit& u) const {
        const int k = i * G + c, T = k / nsub, sub = k - T * nsub; int tsum = 0, ee = -1, jj = 0, hb = 0;
#pragma unroll
        for (int e = 0; e < 16; ++e) { const int nt = (int)((__hip_atomic_load(cnt + e * 64, __ATOMIC_RELAXED, __HIP_MEMORY_SCOPE_AGENT) + 255u) >> 8); if (ee < 0 && T < tsum + nt) { ee = e; jj = T - tsum; hb = tsum; } tsum += nt; }
        if (ee < 0) return false;
        if (!down) { u.pm = ee * 64 + jj; u.pn = 2 * ee + sub; u.pk = 0; u.aux = hb + jj; } else { u.pm = hb + jj; u.pn = sub; u.pk = ee * 256; u.aux = ee * 64 + jj; }
        return true;
    }
    __device__ __forceinline__ void a_ready(const Unit&) const {}
    __device__ __forceinline__ void done(const Unit&) const {}
};
struct OneUnit {
    Unit u0;
    __device__ __forceinline__ bool next(int i, Unit& u) const { if (i > 0) return false; u = u0; return true; }
    __device__ __forceinline__ void a_ready(const Unit&) const {}
    __device__ __forceinline__ void done(const Unit&) const {}
};
struct EpiMoeUp2 {
    static constexpr bool PERM = true, AFTER_DRAIN = false, MIDHOOK = false;
    bf16_t* H2; const float* EW;
    __device__ __forceinline__ void operator()(const f32x4 (&acc)[2][2][4][2], const Unit& u, int wr, int wc, int, int) const { const int ln_ = lane_fresh(), fr = ln_ & 15, fq = ln_ >> 4;
        const int hf = u.pn & 1, row0 = wr * 64 + fr, col0 = hf * 128 + wc * 32 + 8 * fq;
        float gts[2][4];
#pragma unroll
        for (int ai = 0; ai < 2; ++ai)
#pragma unroll
            for (int m = 0; m < 4; ++m) gts[ai][m] = EW[(size_t)u.pm * 256 + row0 + ai * HALF + m * 16];
#pragma unroll
        for (int ai = 0; ai < 2; ++ai)
#pragma unroll
            for (int m = 0; m < 4; ++m) { const int r = row0 + ai * HALF + m * 16; const float gt = gts[ai][m];
                f32x4 h0, h1;
#pragma unroll
                for (int j = 0; j < 4; ++j) { const float a = acc[ai][0][m][0][j], b = acc[ai][0][m][1][j];
                    h0[j] = gt * (a * __builtin_amdgcn_rcpf(1.f + __expf(-a))) * acc[ai][1][m][0][j]; h1[j] = gt * (b * __builtin_amdgcn_rcpf(1.f + __expf(-b))) * acc[ai][1][m][1][j]; }
                *(u32x4*)(H2 + ((size_t)u.aux * 256 + r) * 256 + col0) = pack8(h0, h1); }
    }
};
struct EpiMoeDown {
    static constexpr bool PERM = true, AFTER_DRAIN = false, MIDHOOK = false;
    bf16_t* Y; const int* ELIST; unsigned cnt_e;
    __device__ __forceinline__ void operator()(const f32x4 (&acc)[2][2][4][2], const Unit& u, int wr, int wc, int, int) const {
        extern __shared__ __attribute__((aligned(16))) unsigned char pg8_lds_raw_[];
        LAS int* els_ = (LAS int*)((LAS unsigned char*)pg8_lds_raw_ + STAGE_BYTES + 1024);
        if (wr == 0) { const int t_ = wc * 64 + lane_fresh(); els_[t_] = ELIST[(size_t)u.aux * 256 + t_]; }
        __syncthreads();
        const int ln_ = lane_fresh(), fr = ln_ & 15, fq = ln_ >> 4;
        const int rbase = (u.aux & 63) * 256;
        const int row0 = wr * 64 + fr, col0 = u.pn * BM + wc * 32 + 8 * fq;
#pragma unroll
        for (int ai = 0; ai < 2; ++ai)
#pragma unroll
            for (int m = 0; m < 4; ++m) { const int r = row0 + ai * HALF + m * 16;
                if ((unsigned)(rbase + r) < cnt_e) { const int ent = els_[r]; bf16_t* dst = Y + ((size_t)(ent & 1) * TOK + (size_t)(ent >> 1)) * 1024 + col0;
#pragma unroll
                    for (int bj = 0; bj < 2; ++bj) *(u32x4*)(dst + bj * HALF) = pack8(acc[ai][bj][m][0], acc[ai][bj][m][1]); }
                asm volatile("" ::: "memory"); }
    }
};
struct EpiAccum {
    static constexpr bool PERM = false, AFTER_DRAIN = false, MIDHOOK = false;
    float* XF;
    __device__ __forceinline__ void operator()(const f32x4 (&acc)[2][2][4][2], const Unit& u, int wr, int wc, int, int) const { const int ln_ = lane_fresh(), fr = ln_ & 15, fq = ln_ >> 4;
        const int row0 = u.pm * BM + wr * 64 + fr, col0 = u.pn * BM + wc * 32 + 4 * fq;
#pragma unroll
        for (int ai = 0; ai < 2; ++ai)
#pragma unroll
            for (int m = 0; m < 4; ++m) { const size_t off = (size_t)(row0 + ai * HALF + m * 16) * 1024 + col0;
#pragma unroll
                for (int bj = 0; bj < 2; ++bj)
#pragma unroll
                    for (int n = 0; n < 2; ++n) { const size_t o = off + bj * HALF + n * 16; const f32x4 x = *(const f32x4*)(XF + o); *(f32x4*)(XF + o) = x + acc[ai][bj][m][n]; }
                asm volatile("" ::: "memory"); }
    }
};
struct EpiCompress {
    static constexpr bool PERM = false, AFTER_DRAIN = true, MIDHOOK = false;
    const float* bias; const bf16_t* w2t; bf16_t* out; int transposed;
    __device__ __forceinline__ void fused(f32x4 (&acc)[2][2][4][2], const Unit& u, int wr, int wc, int, int, PG8_LAS unsigned char* lds, int wid, int lane) const {
        const int ln_ = lane_fresh(), fr = ln_ & 15, fq = ln_ >> 4; (void)lane;
        PG8_LAS bf16_t* H = (PG8_LAS bf16_t*)lds; constexpr int HP = 264;
        const int row0 = wr * 64 + fr, col0 = wc * 32 + 4 * fq;
#pragma unroll
        for (int bj = 0; bj < 2; ++bj)
#pragma unroll
            for (int n = 0; n < 2; ++n) { const int c = bj * HALF + col0 + n * 16; const f32x4 bv = *(const f32x4*)(bias + c);
#pragma unroll
                for (int ai = 0; ai < 2; ++ai)
#pragma unroll
                    for (int m = 0; m < 4; ++m) { const f32x4 v = acc[ai][bj][m][n] + bv; f32x4 gl;
#pragma unroll
                        for (int j = 0; j < 4; ++j) { const float x = v[j], uu = 0.7978845608028654f * (x + 0.044715f * x * x * x); const float th = 1.0f - 2.0f * __builtin_amdgcn_rcpf(1.0f + __expf(2.0f * uu)); gl[j] = 0.5f * x * (1.0f + th); }
                        u32x2 w; w.x = cvt_pk_bf16(gl[0], gl[1]); w.y = cvt_pk_bf16(gl[2], gl[3]);
                        *(PG8_LAS u32x2*)(H + (ai * HALF + row0 + m * 16) * HP + c) = w; } }
        __syncthreads();
        const int q = fq, c16 = fr;
#pragma unroll
        for (int mt = 0; mt < 2; ++mt)
#pragma unroll
            for (int nt = 0; nt < 4; ++nt) { f32x4 d = {0.f, 0.f, 0.f, 0.f};
#pragma unroll
                for (int ks = 0; ks < 8; ++ks) { const bf16x8 af = *(const PG8_LAS bf16x8*)(H + (32 * wid + 16 * mt + c16) * HP + 32 * ks + 8 * q);
                    const bf16x8 bf = *(const bf16x8*)(w2t + (16 * nt + c16) * 256 + 32 * ks + 8 * q); d = __builtin_amdgcn_mfma_f32_16x16x32_bf16(af, bf, d, 0, 0, 0); }
#pragma unroll
                for (int j = 0; j < 4; ++j) { const int R = u.pm * BM + 32 * wid + 16 * mt + 4 * q + j, col = 16 * nt + c16; const unsigned hv = cvt_pk_bf16(d[j], d[j]) & 0xffffu;
                    if (!transposed) out[(size_t)R * 64 + col] = (bf16_t)hv; else out[((size_t)(R >> 9) * 64 + col) * 512 + (R & 511)] = (bf16_t)hv; } }
        __syncthreads();
    }
};
struct EpiMixK {
    static constexpr bool PERM = true, AFTER_DRAIN = false, MIDHOOK = true;
    bf16_t* MIX; const bf16_t* G; const float* SSQ;
    __device__ __forceinline__ void mid(f32x4 (&acc)[2][2][4][2], const Unit& u, int t, int wr, int wc) const { const int ln_ = lane_fresh(), fr = ln_ & 15, fq = ln_ >> 4;
        const int row0 = u.pm * BM + wr * 64 + fr, col0 = u.pn * BM + wc * 32 + 8 * fq; const int seg = t >> 3;
        u32x4 ga[2][2][2], gb[2][2][2]; f32x2 qq[2][2];
#define MIXK_LOAD(bb) { const int ai_ = (bb) >> 1, mh_ = (bb) & 1; \
            _Pragma("unroll") for (int mm = 0; mm < 2; ++mm) { const size_t r = (size_t)(row0 + ai_ * HALF + (2 * mh_ + mm) * 16); qq[(bb) & 1][mm] = *(const f32x2*)(SSQ + r * 2); \
                _Pragma("unroll") for (int bj = 0; bj < 2; ++bj) { const int c = col0 + bj * HALF; ga[(bb) & 1][mm][bj] = *(const u32x4*)(G + r * 3072 + (seg - 1) * 1024 + c); gb[(bb) & 1][mm][bj] = *(const u32x4*)(G + r * 3072 + seg * 1024 + c); } } }
        MIXK_LOAD(0)
#pragma unroll
        for (int bb = 0; bb < 4; ++bb) { const int ai = bb >> 1, mh = bb & 1;
            if (bb < 3) MIXK_LOAD(bb + 1)
            asm volatile("" ::: "memory");
#pragma unroll
            for (int mm = 0; mm < 2; ++mm) { const int m = 2 * mh + mm; const float rs = 1.0f / sqrtf((qq[bb & 1][mm][0] + qq[bb & 1][mm][1]) * (1.f / 512.f) + 1e-5f);
                const float sa = seg == 2 ? rs : 1.f, sb = seg == 1 ? rs : 1.f;
#pragma unroll
                for (int bj = 0; bj < 2; ++bj) { f32x4 a0, a1, b0, b1; unpack8(ga[bb & 1][mm][bj], a0, a1); unpack8(gb[bb & 1][mm][bj], b0, b1);
#pragma unroll
                    for (int j = 0; j < 4; ++j) { acc[ai][bj][m][0][j] *= fmaxf(a0[j] * sa, 1e-30f) * __builtin_amdgcn_rcpf(fmaxf(b0[j] * sb, 1e-30f)); acc[ai][bj][m][1][j] *= fmaxf(a1[j] * sa, 1e-30f) * __builtin_amdgcn_rcpf(fmaxf(b1[j] * sb, 1e-30f)); } } }
            asm volatile("" ::: "memory"); }
#undef MIXK_LOAD
    }
    __device__ __forceinline__ void operator()(const f32x4 (&acc)[2][2][4][2], const Unit& u, int wr, int wc, int, int) const { const int ln_ = lane_fresh(), fr = ln_ & 15, fq = ln_ >> 4;
        const int row0 = u.pm * BM + wr * 64 + fr, col0 = u.pn * BM + wc * 32 + 8 * fq;
#pragma unroll
        for (int ai = 0; ai < 2; ++ai) {
            u32x4 gg[4][2];
#pragma unroll
            for (int m = 0; m < 4; ++m) { const size_t r = (size_t)(row0 + ai * HALF + m * 16);
#pragma unroll
                for (int bj = 0; bj < 2; ++bj) gg[m][bj] = *(const u32x4*)(G + r * 3072 + 2048 + col0 + bj * HALF); }
            asm volatile("" ::: "memory");
#pragma unroll
            for (int m = 0; m < 4; ++m) { const size_t r = (size_t)(row0 + ai * HALF + m * 16);
#pragma unroll
                for (int bj = 0; bj < 2; ++bj) { f32x4 g0, g1; unpack8(gg[m][bj], g0, g1);
#pragma unroll
                    for (int j = 0; j < 4; ++j) { g0[j] = fmaxf(g0[j], 1e-30f); g1[j] = fmaxf(g1[j], 1e-30f); }
                    *(u32x4*)(MIX + r * 1024 + col0 + bj * HALF) = pack8(acc[ai][bj][m][0] * g0, acc[ai][bj][m][1] * g1); } }
            asm volatile("" ::: "memory"); }
    }
};
struct StrideOrder {
    int pm, pn0, dn, cnt;
    __device__ __forceinline__ bool next(int i, Unit& u) const { if (i >= cnt) return false; u.pm = pm; u.pn = pn0 + dn * i; u.pk = 0; u.aux = 0; return true; }
    __device__ __forceinline__ void a_ready(const Unit&) const {}
    __device__ __forceinline__ void done(const Unit&) const {}
};
template <class Epi, class Sched, bool ALIGN_EPI = false, bool SP2 = false, bool GATHER = false>
__device__ __forceinline__ void gemm_phase(PG8_LAS unsigned char* lds, const Gemm g, const Sched& S, const Epi& E, int wave0) {
    int tid_ = tid_fresh(wave0); asm volatile("" : "+v"(tid_));
    const int tid = tid_, wid = __builtin_amdgcn_readfirstlane(tid >> 6), lane = tid & 63, wr = wid >> 2, wc = wid & 3, fr = lane & 15, fq = lane >> 4;
    const int K = g.K, nt = K / BK;
    unsigned voffA0[2], voffA1[2], voffB[2];
#pragma unroll
    for (int i = 0; i < 2; ++i) { int R, C; stage_rc(tid * 16 + i * 8192, R, C); const int Rb = Epi::PERM ? ((R & ~31) + perm32(R & 31)) : R;
        voffA0[i] = (unsigned)(R * g.lda + C) * 2u; voffA1[i] = voffA0[i]; voffB[i] = (unsigned)(Rb * g.ldb + C) * 2u; }
    const size_t kstep = (size_t)(BK * 2);
    const size_t hstepA = GATHER ? (size_t)0 : (size_t)HALF * g.lda * 2, hstepB = (size_t)HALF * g.ldb * 2;
    const size_t tstepA = 2 * hstepA, tstepB = 2 * hstepB;
    const unsigned ldsw = (unsigned)wid * 1024u;
    const int aoff = lds_byte(wr * 64 + fr, fq * 8), boff = lds_byte(wc * 32 + fr, fq * 8);
#define PG8_SA(b, h) (((b) * 2 + (h)) * HTB)
#define PG8_SB(b, h) ((4 + (b) * 2 + (h)) * HTB)
#define PG8_STAGE(bufoff, gbase, voff) do { _Pragma("unroll") for (int _i = 0; _i < 2; ++_i) \
        __builtin_amdgcn_global_load_lds((const unsigned*)((const char*)(gbase) + (voff)[_i]), (PG8_LAS unsigned*)(lds + (bufoff) + ldsw + _i * 8192), 16, 0, 0); } while (0)
#define PG8_LDA(dst, b, h) do { _Pragma("unroll") for (int m = 0; m < 4; ++m) _Pragma("unroll") for (int k = 0; k < 2; ++k) dst[m][k] = *(const PG8_LAS bf16x8*)(lds + PG8_SA(b, h) + aoff + m * 2048 + k * 1024); } while (0)
#define PG8_LDB(dst, b, h) do { _Pragma("unroll") for (int n = 0; n < 2; ++n) _Pragma("unroll") for (int k = 0; k < 2; ++k) dst[n][k] = *(const PG8_LAS bf16x8*)(lds + PG8_SB(b, h) + boff + n * 2048 + k * 1024); } while (0)
#define PG8_MMA(ai, bj, At, Bt) do { __builtin_amdgcn_s_setprio(1); _Pragma("unroll") for (int m = 0; m < 4; ++m) _Pragma("unroll") for (int n = 0; n < 2; ++n) _Pragma("unroll") for (int k = 0; k < 2; ++k) \
        acc[ai][bj][m][n] = __builtin_amdgcn_mfma_f32_16x16x32_bf16(Bt[n][k], At[m][k], acc[ai][bj][m][n], 0, 0, 0); __builtin_amdgcn_s_setprio(0); } while (0)
#define PG8_WAIT_V(n) asm volatile("s_waitcnt vmcnt(" #n ")" ::: "memory")
#define PG8_WAIT_L(n) asm volatile("s_waitcnt lgkmcnt(" #n ")" ::: "memory")
#define PG8_BAR __builtin_amdgcn_s_barrier()
#define PG8_SCHED __builtin_amdgcn_sched_barrier(0)
    Unit cur, nxt; int ui = 0;
    if (!S.next(0, cur)) return;
    f32x4 acc[2][2][4][2]; float zf_ = 0.f; asm volatile("" : "+v"(zf_));
#pragma unroll
    for (int a = 0; a < 2; ++a)
#pragma unroll
        for (int b = 0; b < 2; ++b)
#pragma unroll
            for (int m = 0; m < 4; ++m)
#pragma unroll
                for (int n = 0; n < 2; ++n) acc[a][b][m][n] = (f32x4){zf_, zf_, zf_, zf_};
    bf16x8 At[4][2], B0[2][2], B1[2][2];
    const char* cA = (const char*)g.A + (GATHER ? (size_t)0 : (size_t)cur.pm * tstepA); const char* cB = (const char*)g.Bt + (size_t)cur.pn * tstepB + (size_t)cur.pk * 2;
    if constexpr (GATHER) {
        const unsigned cnt_e = __hip_atomic_load(g.gcnt + (cur.pm >> 6) * 64, __ATOMIC_RELAXED, __HIP_MEMORY_SCOPE_AGENT); const int rbase = (cur.pm & 63) * 256;
#pragma unroll
        for (int i = 0; i < 2; ++i) { int R, C; stage_rc(tid * 16 + i * 8192, R, C);
            const int t0_ = (unsigned)(rbase + R) < cnt_e ? (g.glist[cur.pm * 256 + R] >> 1) : 0, t1_ = (unsigned)(rbase + HALF + R) < cnt_e ? (g.glist[cur.pm * 256 + HALF + R] >> 1) : 0;
            voffA0[i] = (unsigned)(t0_ * g.lda + C) * 2u; voffA1[i] = (unsigned)(t1_ * g.lda + C) * 2u; }
    }
    S.a_ready(cur);
    if constexpr (SP2) {
        PG8_STAGE(PG8_SB(0, 0), cB, voffB); PG8_STAGE(PG8_SB(0, 1), cB + hstepB, voffB); PG8_STAGE(PG8_SA(0, 0), cA, voffA0); PG8_STAGE(PG8_SA(0, 1), cA + hstepA, voffA1);
        if (wr == 1) PG8_BAR;
        PG8_WAIT_V(2); PG8_BAR;
        PG8_STAGE(PG8_SB(1, 0), cB + kstep, voffB); PG8_STAGE(PG8_SA(1, 0), cA + kstep, voffA0); PG8_STAGE(PG8_SB(1, 1), cB + hstepB + kstep, voffB);
        PG8_WAIT_V(6); PG8_BAR;
    } else {
        PG8_STAGE(PG8_SB(0, 0), cB, voffB); PG8_STAGE(PG8_SA(0, 0), cA, voffA0); PG8_STAGE(PG8_SB(0, 1), cB + hstepB, voffB); PG8_STAGE(PG8_SA(0, 1), cA + hstepA, voffA1);
        if (wr == 1) PG8_BAR;
        PG8_WAIT_V(4); PG8_BAR;
        PG8_STAGE(PG8_SB(1, 0), cB + kstep, voffB); PG8_STAGE(PG8_SA(1, 0), cA + kstep, voffA0); PG8_STAGE(PG8_SB(1, 1), cB + hstepB + kstep, voffB);
        PG8_WAIT_V(6); PG8_BAR;
    }
    for (;;) {
        const bool has_next = GATHER ? false : S.next(ui + 1, nxt);
        const char* nA = has_next ? (const char*)g.A + (size_t)nxt.pm * tstepA : cA; const char* nB = has_next ? (const char*)g.Bt + (size_t)nxt.pn * tstepB + (size_t)nxt.pk * 2 : cB;
        for (int t = 0; t < nt; t += 2) {
            if constexpr (Epi::MIDHOOK) { if (t == 8 || t == 16) E.mid(acc, cur, t, wr, wc); }
            const bool last = (t == nt - 2);
            const char* a1 = cA + (size_t)(t + 1) * kstep;
            const char* a2 = last ? nA : cA + (size_t)(t + 2) * kstep; const char* b2 = last ? nB : cB + (size_t)(t + 2) * kstep;
            const char* a3 = a2 + kstep; const char* b3 = b2 + kstep;
            if (last && has_next) S.a_ready(nxt);
            if constexpr (SP2) {
            PG8_LDB(B0, 0, 0); PG8_LDB(B1, 0, 1); PG8_SCHED; PG8_LDA(At, 0, 0); PG8_STAGE(PG8_SA(1, 1), a1 + hstepA, voffA1);
            PG8_WAIT_V(8); PG8_WAIT_L(0); PG8_BAR; PG8_MMA(0, 0, At, B0); PG8_MMA(0, 1, At, B1); PG8_BAR; PG8_SCHED;
            PG8_LDA(At, 0, 1); PG8_STAGE(PG8_SB(0, 0), b2, voffB); PG8_STAGE(PG8_SB(0, 1), b2 + hstepB, voffB); PG8_STAGE(PG8_SA(0, 0), a2, voffA0);
            PG8_WAIT_V(8); PG8_WAIT_L(0); PG8_BAR; PG8_MMA(1, 0, At, B0); PG8_MMA(1, 1, At, B1); PG8_BAR; PG8_SCHED;
            PG8_LDB(B0, 1, 0); PG8_LDB(B1, 1, 1); PG8_SCHED; PG8_LDA(At, 1, 0); PG8_STAGE(PG8_SA(0, 1), a2 + hstepA, voffA1);
            PG8_WAIT_V(8); PG8_WAIT_L(0); PG8_BAR; PG8_MMA(0, 0, At, B0); PG8_MMA(0, 1, At, B1); PG8_BAR; PG8_SCHED;
            PG8_LDA(At, 1, 1); PG8_STAGE(PG8_SB(1, 0), b3, voffB); PG8_STAGE(PG8_SB(1, 1), b3 + hstepB, voffB); PG8_STAGE(PG8_SA(1, 0), a3, voffA0);
            PG8_WAIT_V(8); PG8_WAIT_L(0); PG8_BAR; PG8_MMA(1, 0, At, B0); PG8_MMA(1, 1, At, B1); PG8_BAR; PG8_SCHED;
            } else {
            PG8_LDB(B0, 0, 0); PG8_SCHED; PG8_LDA(At, 0, 0); PG8_STAGE(PG8_SA(1, 1), a1 + hstepA, voffA1);
            PG8_WAIT_L(8); PG8_BAR; PG8_WAIT_L(0); PG8_MMA(0, 0, At, B0); PG8_BAR; PG8_SCHED;
            PG8_LDB(B1, 0, 1); PG8_STAGE(PG8_SB(0, 0), b2, voffB);
            PG8_BAR; PG8_WAIT_L(0); PG8_MMA(0, 1, At, B1); PG8_BAR;
            PG8_LDA(At, 0, 1); PG8_STAGE(PG8_SA(0, 0), a2, voffA0);
            PG8_BAR; PG8_WAIT_L(0); PG8_MMA(1, 0, At, B0); PG8_BAR; PG8_SCHED;
            PG8_STAGE(PG8_SB(0, 1), b2 + hstepB, voffB);
            PG8_WAIT_V(6); PG8_BAR; PG8_MMA(1, 1, At, B1); PG8_BAR;
            PG8_LDB(B0, 1, 0); PG8_SCHED; PG8_LDA(At, 1, 0); PG8_STAGE(PG8_SA(0, 1), a2 + hstepA, voffA1);
            PG8_WAIT_L(8); PG8_BAR; PG8_WAIT_L(0); PG8_MMA(0, 0, At, B0); PG8_BAR; PG8_SCHED;
            PG8_LDB(B1, 1, 1); PG8_STAGE(PG8_SB(1, 0), b3, voffB);
            PG8_BAR; PG8_WAIT_L(0); PG8_MMA(0, 1, At, B1); PG8_BAR;
            PG8_LDA(At, 1, 1); PG8_STAGE(PG8_SA(1, 0), a3, voffA0);
            PG8_BAR; PG8_WAIT_L(0); PG8_MMA(1, 0, At, B0); PG8_BAR; PG8_SCHED;
            PG8_STAGE(PG8_SB(1, 1), b3 + hstepB, voffB);
            PG8_WAIT_V(6); PG8_BAR; PG8_MMA(1, 1, At, B1); PG8_BAR;
            }
        }
        if constexpr (ALIGN_EPI) { if (wr == 0) PG8_BAR; }
        if constexpr (!Epi::AFTER_DRAIN) { E(acc, cur, wr, wc, fr, fq); S.done(cur); }
        if (!has_next) break;
#pragma unroll
        for (int a = 0; a < 2; ++a)
#pragma unroll
            for (int b = 0; b < 2; ++b)
#pragma unroll
                for (int m = 0; m < 4; ++m)
#pragma unroll
                    for (int n = 0; n < 2; ++n) acc[a][b][m][n] = (f32x4){zf_, zf_, zf_, zf_};
        cur = nxt; cA = nA; cB = nB; ++ui;
        if constexpr (ALIGN_EPI) { if (wr == 1) PG8_BAR; }
    }
    PG8_WAIT_V(0);
    if constexpr (!ALIGN_EPI) { if (wr == 0) PG8_BAR; }
    PG8_BAR;
    if constexpr (Epi::AFTER_DRAIN) { E.fused(acc, cur, wr, wc, fr, fq, lds, wid, lane); S.done(cur); }
#undef PG8_SA
#undef PG8_SB
#undef PG8_STAGE
#undef PG8_LDA
#undef PG8_LDB
#undef PG8_MMA
#undef PG8_WAIT_V
#undef PG8_WAIT_L
#undef PG8_BAR
#undef PG8_SCHED
}
}
using pg8::bf16x8;
constexpr size_t MiB = 1u << 20;
constexpr size_t WS_CTL = 0;
constexpr size_t CTL_ZERO_BYTES = 65536;
constexpr size_t WS_BIASP = 384 * 1024;
constexpr size_t WS_BIASR = 448 * 1024;
constexpr size_t WS_AEND = 128 * 1024;
constexpr size_t WS_ELIST = 1 * MiB;
constexpr size_t WS_EW = 2 * MiB;
constexpr size_t CTL_MOECNT = 32768;
constexpr int MOE_CAP = 16384;
constexpr size_t WS_SMALL = 2 * MiB;
constexpr size_t WS_KC = 4 * MiB;
constexpr size_t WS_LRUSUM = 5 * MiB;
constexpr size_t WS_W = 6 * MiB;
constexpr size_t W_WIN = 0, W_W1K = 13 * MiB + MiB / 2, W_W1V = W_W1K + MiB, W_W2K = W_W1V + MiB, W_W2V = W_W2K + 32768, W_LRUW = W_W2V + 32768  , W_PROJ = 16 * MiB, W_WOUT = 19 * MiB, W_PLEG = 21 * MiB,
                 W_PLEP = 23 * MiB, W_WGU = 24 * MiB, W_WD = 40 * MiB, W_END = 48 * MiB;
constexpr size_t WS_XB = WS_W + W_END;
constexpr size_t WS_PB = WS_XB + 32 * MiB;
constexpr size_t WS_A = WS_PB + 8 * MiB;
constexpr size_t KV_STRIDE = (size_t)4 * SEQ * 64 + 4096;
constexpr size_t WS_Q = WS_A, WS_KV = WS_Q + 16 * MiB, WS_Z = WS_KV + 25 * MiB, WS_XBC = WS_Z + 16 * MiB, WS_LX = WS_XBC + 24 * MiB, WS_LY = WS_LX + 16 * MiB,
                 WS_STATES = WS_LY + 16 * MiB, WS_ONSA = WS_STATES + 16 * MiB, WS_OSSD = WS_ONSA + 16 * MiB, WS_OLRU = WS_OSSD + 16 * MiB, WS_END = WS_OLRU + 16 * MiB;
constexpr size_t WS_MERGE = WS_A;
constexpr size_t WS_MIXB = WS_LY;
constexpr size_t WS_H2 = WS_A;
constexpr size_t WS_Y = WS_A + 18 * MiB;
constexpr size_t WS_SG = WS_A + 128 * MiB;
static_assert(KV_STRIDE * 2 * 6 <= 25 * MiB, "kv");
static_assert(WS_MERGE + 96 * MiB <= WS_LY && WS_MIXB + 32 * MiB <= WS_ONSA, "overlay map");
static_assert(WS_SG + 32 * MiB <= WS_END && WS_END <= 283 * MiB, "ws map");

constexpr int LDS_BYTES = 147456;

struct Args { const float* in[37]; float* out; unsigned char* ws; int ph_lo, ph_hi; };

__device__ __forceinline__ void tr_job(const float* __restrict__ W, int ld, int K, int c0, int ncols, bf16_t* dst, int ldd, int koff, LAS float* scr, int lane, int gw, int NGW, int& base) {
    const int ncb = (ncols + 31) >> 5, items = (K >> 6) * ncb;
    int first = (gw - (base % NGW) + NGW) % NGW; base += items;
    const int c4 = (lane & 7) * 4, kr = lane >> 3;
    f32x4 t[8];
    if (first < items) { const int kb = first / ncb, nb = first - kb * ncb, k0 = kb << 6, n0 = nb << 5, nv = (ncols - n0) < 32 ? (ncols - n0) : 32;
        if (c4 < nv) {
#pragma unroll
            for (int i = 0; i < 8; ++i) t[i] = *(const f32x4*)(W + (size_t)(k0 + 8 * i + kr) * ld + c0 + n0 + c4); } }
    for (int it = first; it < items; it += NGW) {
        const int kb = it / ncb, nb = it - kb * ncb, k0 = kb << 6, n0 = nb << 5, nv = (ncols - n0) < 32 ? (ncols - n0) : 32;
        if (c4 < nv) {
#pragma unroll
            for (int i = 0; i < 8; ++i) { LAS float* d = scr + (8 * i + kr) * 33 + c4; d[0] = t[i][0]; d[1] = t[i][1]; d[2] = t[i][2]; d[3] = t[i][3]; } }
        {   const int itn = it + NGW;
            if (itn < items) { const int kbn = itn / ncb, nbn = itn - kbn * ncb, k0n = kbn << 6, n0n = nbn << 5, nvn = (ncols - n0n) < 32 ? (ncols - n0n) : 32;
                if (c4 < nvn) {
#pragma unroll
                    for (int i = 0; i < 8; ++i) t[i] = *(const f32x4*)(W + (size_t)(k0n + 8 * i + kr) * ld + c0 + n0n + c4); } } }
        asm volatile("s_waitcnt lgkmcnt(0)" ::: "memory");
        const int c = lane & 7;
#pragma unroll
        for (int j = 0; j < 4; ++j) { const int n = (lane >> 3) + 8 * j;
            if (n < nv) { const LAS float* s = scr + (8 * c) * 33 + n;
                u32x4 o; o.x = pk2(s[0 * 33], s[1 * 33]); o.y = pk2(s[2 * 33], s[3 * 33]); o.z = pk2(s[4 * 33], s[5 * 33]); o.w = pk2(s[6 * 33], s[7 * 33]);
                *(u32x4*)(dst + (size_t)(n0 + n) * ldd + koff + k0 + 8 * c) = o; } }
        asm volatile("s_waitcnt lgkmcnt(0)" ::: "memory");
    }
}
struct TJob { const float* src; int ld, K, c0, ncols; bf16_t* dst; int ldd, koff; };
__device__ __forceinline__ TJob get_job(const Args& a, int L, int j, unsigned char* W) {
    TJob t;
    if (j < 6) {
        t.src = a.in[2] + (size_t)L * D_MODEL * IN_WIDTH; t.ld = IN_WIDTH; t.K = 1024; t.ldd = 1024; t.koff = 0; bf16_t* win = (bf16_t*)(W + W_WIN);
        const int c0s = j == 0 ? 0 : j == 1 ? 1304 : j == 2 ? 2592 : j == 3 ? 1280 : j == 4 ? 2584 : 3616;
        const int ncs = j == 0 ? 1280 : j == 1 ? 1280 : j == 2 ? 1024 : j == 3 ? 24 : j == 4 ? 8 : 3072;
        const int r0 = j == 0 ? 0 : j == 1 ? 1280 : j == 2 ? 2560 : j == 3 ? 3584 : j == 4 ? 3608 : 3840;
        t.c0 = c0s; t.ncols = ncs; t.dst = win + (size_t)r0 * 1024;
    } else if (j < 8) { const int v = j - 6; t.src = a.in[v ? 7 : 4] + (size_t)L * 2048 * 256; t.ld = 256; t.K = 2048; t.c0 = 0; t.ncols = 256; t.dst = (bf16_t*)(W + (v ? W_W1V : W_W1K)); t.ldd = 2048; t.koff = 0;
    } else if (j < 10) { const int v = j - 8; t.src = a.in[v ? 8 : 5] + (size_t)L * 256 * 64; t.ld = 64; t.K = 256; t.c0 = 0; t.ncols = 64; t.dst = (bf16_t*)(W + (v ? W_W2V : W_W2K)); t.ldd = 256; t.koff = 0;
    } else if (j < 13) { const int v = j - 10; t.src = a.in[22 + v] + (size_t)L * 512 * 1024; t.ld = 1024; t.K = 512; t.c0 = 0; t.ncols = 1024; t.dst = (bf16_t*)(W + W_PROJ); t.ldd = 1536; t.koff = v * 512;
    } else if (j == 13) { t.src = a.in[25] + (size_t)L * 1024 * 1024; t.ld = 1024; t.K = 1024; t.c0 = 0; t.ncols = 1024; t.dst = (bf16_t*)(W + W_WOUT); t.ldd = 1024; t.koff = 0;
    } else if (j == 14) { t.src = a.in[33] + (size_t)L * 1024 * 1024; t.ld = 1024; t.K = 1024; t.c0 = 0; t.ncols = 1024; t.dst = (bf16_t*)(W + W_PLEG); t.ldd = 1024; t.koff = 0;
    } else if (j == 15) { t.src = a.in[34] + (size_t)L * 256 * 1024; t.ld = 1024; t.K = 256; t.c0 = 0; t.ncols = 1024; t.dst = (bf16_t*)(W + W_PLEP); t.ldd = 256; t.koff = 0;
    } else if (j < 32) { const int v = j - 16, which = v >> 3, n = v & 7; t.src = a.in[which ? 19 : 17] + (size_t)(L * 8 + n) * 4096; t.ld = 64; t.K = 64; t.c0 = 0; t.ncols = 64;
        t.dst = (bf16_t*)(W + W_LRUW) + (size_t)v * 4096; t.ldd = 64; t.koff = 0;
    } else { const int q = j - 32, e = q / 5, k = q - 5 * e;
        if (k < 4) { const int hf = k >> 1, up = k & 1; t.src = a.in[up ? 31 : 30] + (size_t)(L * N_EXPERTS + e) * 1024 * 256; t.ld = 256; t.K = 1024; t.c0 = 128 * hf; t.ncols = 128;
            t.dst = (bf16_t*)(W + W_WGU) + (size_t)(256 * (2 * e + hf) + 128 * up) * 1024; t.ldd = 1024; t.koff = 0; }
        else { t.src = a.in[32] + (size_t)(L * N_EXPERTS + e) * 256 * 1024; t.ld = 1024; t.K = 256; t.c0 = 0; t.ncols = 1024; t.dst = (bf16_t*)(W + W_WD); t.ldd = 4096; t.koff = e * 256; }
    }
    return t;
}
constexpr int N_TJOBS = 32 + 5 * N_EXPERTS;
__device__ __forceinline__ void convert_weights(const Args& a, unsigned char* wsp, int L, LAS unsigned char* lds, int vcu, int G, int wave0) {
    const int tid = tid_fresh(wave0), lane = tid & 63, wave = tid >> 6;
    LAS float* scr = (LAS float*)(lds + wave * 16384);
    const int gw = vcu * NWAVES + wave, NGW = G * NWAVES;
    unsigned char* W = wsp + WS_W;
    int base = 0;
    for (int j = 0; j < N_TJOBS; ++j) { const TJob t = get_job(a, L, j, W); tr_job(t.src, t.ld, t.K, t.c0, t.ncols, t.dst, t.ldd, t.koff, scr, lane, gw, NGW, base); }
    {
        u32x4* z = (u32x4*)((bf16_t*)(W + W_WIN) + (size_t)3616 * 1024);
        unsigned zz = 0u; asm volatile("" : "+v"(zz));
        for (int i = gw * 64 + lane; i < 224 * 128; i += NGW * 64) z[i] = (u32x4){zz, zz, zz, zz};
    }
    float* part = (float*)(wsp + WS_BIASP);
    for (int j = gw; j < 256; j += NGW) {
        const int which = j >> 7, hg = (j >> 5) & 3, ks = j & 31;
        const float* pe = a.in[which ? 6 : 3] + (size_t)L * 2048; const float* w1 = a.in[which ? 7 : 4] + (size_t)L * 2048 * 256;
        float s = 0.f;
#pragma unroll 8
        for (int kk = ks * 64; kk < ks * 64 + 64; ++kk) s += pe[kk] * w1[(size_t)kk * 256 + hg * 64 + lane];
        part[(which * 32 + ks) * 256 + hg * 64 + lane] = s;
    }
}
__device__ __forceinline__ void cvt_rows(const float* __restrict__ src, bf16_t* dst, size_t n, int vcu, int G, int wave0) {
    const size_t stride = (size_t)G * NTHREADS; const int tid = tid_fresh(wave0);
    for (size_t i = (size_t)vcu * NTHREADS + tid; i < n / 8; i += stride) {
        const f32x4 a = *(const f32x4*)(src + i * 8), b = *(const f32x4*)(src + i * 8 + 4);
        u32x4 o; o.x = pk2(a[0], a[1]); o.y = pk2(a[2], a[3]); o.z = pk2(b[0], b[1]); o.w = pk2(b[2], b[3]);
        *(u32x4*)(dst + i * 8) = o;
    }
}
template <bool ROUTER, bool YADD, bool WRITE_XF>
__device__ __forceinline__ void ln_rows(float* XF, const float* __restrict__ g, const float* __restrict__ b, bf16_t* XB, const float* __restrict__ rw, const float* __restrict__ rb,
                                        int* ELIST, float* EW, unsigned* CNT, const bf16_t* Y, const bf16_t* PLE, LAS unsigned char* lds, int vcu, int G, int wave0, const float* probe = nullptr) {
    const int tid = tid_fresh(wave0), lane = tid & 63, wave = tid >> 6;
    constexpr int RWP = 1028;
    LAS float* rwT = (LAS float*)lds;
    LAS float* XS = (LAS float*)(lds + 65792);
    LAS float* PART = (LAS float*)(lds + 131584);
    LAS unsigned* RSEL = (LAS unsigned*)(lds + 139776); LAS float* RWT = (LAS float*)(lds + 139776 + 256);
    LAS float* LOG = (LAS float*)(lds + 140544);
    if (ROUTER) {
        {   f32x4 t8[8];
#pragma unroll
            for (int i = 0; i < 8; ++i) t8[i] = *(const f32x4*)(rw + (size_t)(tid + 512 * (i >> 2)) * 16 + 4 * (i & 3));
#pragma unroll
            for (int i = 0; i < 8; ++i) { const int k = tid + 512 * (i >> 2), e0 = 4 * (i & 3); rwT[(e0 + 0) * RWP + k] = t8[i][0]; rwT[(e0 + 1) * RWP + k] = t8[i][1]; rwT[(e0 + 2) * RWP + k] = t8[i][2]; rwT[(e0 + 3) * RWP + k] = t8[i][3]; } }
        __syncthreads();
    }
    f32x4 gv[4], bv[4];
#pragma unroll
    for (int j = 0; j < 4; ++j) { gv[j] = *(const f32x4*)(g + 256 * j + 4 * lane); bv[j] = *(const f32x4*)(b + 256 * j + 4 * lane); }
    for (int seg = vcu; seg < TOK / 64; seg += G) {
      f32x4 nv[4]; u32x2 ny0[4], ny1[4], nxb[4], npl[4];
      {   const int row = seg * 64 + 8 * wave; const float* xr0 = XF + (size_t)row * 1024;
#pragma unroll
          for (int j = 0; j < 4; ++j) { const size_t o = (size_t)row * 1024 + 256 * j + 4 * lane;
              if (YADD) { ny0[j] = *(const u32x2*)(Y + o); ny1[j] = *(const u32x2*)(Y + (size_t)TOK * 1024 + o); nxb[j] = *(const u32x2*)(XB + o); npl[j] = *(const u32x2*)(PLE + o); }
              else nv[j] = *(const f32x4*)(xr0 + 256 * j + 4 * lane); } }
#pragma unroll 1
      for (int ri = 0; ri < 8; ++ri) {
        const int rowl = 8 * wave + ri, row = seg * 64 + rowl;
        float* xr = XF + (size_t)row * 1024;
        f32x4 v[4]; float s = 0.f;
#pragma unroll
        for (int j = 0; j < 4; ++j) {
            if (YADD) { const u32x2 y0 = ny0[j], y1 = ny1[j], xb = nxb[j], pl = npl[j];
                v[j][0] = ALPHA * bf2f(xb.x & 0xffffu) + bf2f(pl.x & 0xffffu) + (bf2f(y0.x & 0xffffu) + bf2f(y1.x & 0xffffu)); v[j][1] = ALPHA * bf2f(xb.x >> 16) + bf2f(pl.x >> 16) + (bf2f(y0.x >> 16) + bf2f(y1.x >> 16));
                v[j][2] = ALPHA * bf2f(xb.y & 0xffffu) + bf2f(pl.y & 0xffffu) + (bf2f(y0.y & 0xffffu) + bf2f(y1.y & 0xffffu)); v[j][3] = ALPHA * bf2f(xb.y >> 16) + bf2f(pl.y >> 16) + (bf2f(y0.y >> 16) + bf2f(y1.y >> 16)); }
            else v[j] = nv[j];
            s += (v[j][0] + v[j][1]) + (v[j][2] + v[j][3]); }
        if (ri < 7) { const float* xn = xr + 1024;
#pragma unroll
            for (int j = 0; j < 4; ++j) { const size_t o = (size_t)(row + 1) * 1024 + 256 * j + 4 * lane;
                if (YADD) { ny0[j] = *(const u32x2*)(Y + o); ny1[j] = *(const u32x2*)(Y + (size_t)TOK * 1024 + o); nxb[j] = *(const u32x2*)(XB + o); npl[j] = *(const u32x2*)(PLE + o); }
                else nv[j] = *(const f32x4*)(xn + 256 * j + 4 * lane); } }
        const float mean = wave_sum(s, lane) * (1.f / 1024.f); float s2 = 0.f;
#pragma unroll
        for (int j = 0; j < 4; ++j) { v[j] = v[j] - mean; s2 += (v[j][0] * v[j][0] + v[j][1] * v[j][1]) + (v[j][2] * v[j][2] + v[j][3] * v[j][3]); }
        const float rstd = 1.0f / sqrtf(wave_sum(s2, lane) * (1.f / 1024.f) + LN_EPS);
        float psc = 1.0f; if (probe) { float fr = probe[0];
#ifdef PHASE_PROBE
            { const unsigned long long* st = (const unsigned long long*)probe; fr = (float)(st[PHASE_PROBE_B] - st[PHASE_PROBE_A]) * (1.0f / PHASE_PROBE_DIV); }
#endif
            fr = fr < 0.f ? 0.f : (fr > 1.f ? 1.f : fr); psc = 1.02f + 0.04f * fr; }
#pragma unroll
        for (int j = 0; j < 4; ++j) { v[j] = (v[j] * rstd * gv[j] + bv[j]) * psc; if (WRITE_XF) *(f32x4*)(xr + 256 * j + 4 * lane) = v[j];
            u32x2 w; w.x = pk2(v[j][0], v[j][1]); w.y = pk2(v[j][2], v[j][3]); *(u32x2*)(XB + (size_t)row * 1024 + 256 * j + 4 * lane) = w; }
        if (ROUTER) {
            {   LAS float* xs = XS + (2 * wave + (ri & 1)) * RWP;
#pragma unroll
                for (int j = 0; j < 4; ++j) *(LAS f32x4*)(xs + 256 * j + 4 * lane) = v[j]; }
            if (ri & 1) {
                asm volatile("s_waitcnt lgkmcnt(0)" ::: "memory"); __builtin_amdgcn_s_barrier();
                {
                    const int i16 = lane & 15, kq = lane >> 4; const LAS float* ap = XS + i16 * RWP + 128 * wave + 32 * kq; const LAS float* bp = rwT + i16 * RWP + 128 * wave + 32 * kq;
                    f32x4 acc = {0.f, 0.f, 0.f, 0.f};
#pragma unroll
                    for (int m8 = 0; m8 < 8; ++m8) { const f32x4 a4 = *(const LAS f32x4*)(ap + 4 * m8), b4 = *(const LAS f32x4*)(bp + 4 * m8);
#pragma unroll
                        for (int c = 0; c < 4; ++c) acc = __builtin_amdgcn_mfma_f32_16x16x4f32(a4[c], b4[c], acc, 0, 0, 0); }
                    LAS float* pw = PART + wave * 256;
#pragma unroll
                    for (int rr = 0; rr < 4; ++rr) pw[(4 * kq + rr) * 16 + i16] = acc[rr];
                }
                asm volatile("s_waitcnt lgkmcnt(0)" ::: "memory"); __builtin_amdgcn_s_barrier();
#pragma unroll 1
                for (int s2 = 0; s2 < 2; ++s2) { const int rl = rowl - 1 + s2;
                    float r1 = 0.f;
#pragma unroll
                    for (int w = 0; w < 8; ++w) r1 += PART[w * 256 + (2 * wave + s2) * 16 + (lane >> 2)];
                    if ((lane & 3) == 0) LOG[rl * 16 + (lane >> 2)] = r1;
                }
            }
        }
      }
      if (ROUTER) {
        __syncthreads();
        if (tid < 64) {
            const int rl = tid; f32x4 lg[4];
#pragma unroll
            for (int k4 = 0; k4 < 4; ++k4) lg[k4] = *(const LAS f32x4*)(LOG + rl * 16 + 4 * k4);
                float aff[16], sel[16];
#pragma unroll
                for (int e = 0; e < 16; ++e) { aff[e] = 1.0f / (1.0f + expf(-lg[e >> 2][e & 3])); sel[e] = aff[e] + rb[e]; }
                int best = 0; float bs = -INFINITY;
#pragma unroll
                for (int q = 0; q < 4; ++q) { float m1 = -INFINITY, m2 = -INFINITY;
#pragma unroll
                    for (int k = 0; k < 4; ++k) { const float x = sel[4 * q + k]; if (x > m1) { m2 = m1; m1 = x; } else if (x > m2) m2 = x; }
                    const float sc = m1 + m2; if (sc > bs) { bs = sc; best = q; } }
                int i1 = 0, i2 = 0; float m1 = -INFINITY, m2 = -INFINITY;
#pragma unroll
                for (int e = 0; e < 16; ++e) { const float x = ((e >> 2) == best) ? sel[e] : -INFINITY; if (x > m1) { m2 = m1; i2 = i1; m1 = x; i1 = e; } else if (x > m2) { m2 = x; i2 = e; } }
                float a1 = 0.f, a2 = 0.f;
#pragma unroll
                for (int e = 0; e < 16; ++e) { a1 = (e == i1) ? aff[e] : a1; a2 = (e == i2) ? aff[e] : a2; }
                const float inv = 1.0f / (a1 + a2);
            RSEL[rl] = (unsigned)i1 | ((unsigned)i2 << 8); RWT[rl * 2] = a1 * inv; RWT[rl * 2 + 1] = a2 * inv;
        }
        __syncthreads();
        {
            const unsigned sl = RSEL[lane]; const int e0 = 2 * wave, e1 = e0 + 1;
            const int rk0 = (int)(sl & 255u) == e0 ? 0 : ((int)(sl >> 8) == e0 ? 1 : -1), rk1 = (int)(sl & 255u) == e1 ? 0 : ((int)(sl >> 8) == e1 ? 1 : -1);
            const unsigned long long bal0 = __ballot(rk0 >= 0), bal1 = __ballot(rk1 >= 0); const int n0 = __builtin_popcountll(bal0), n1 = __builtin_popcountll(bal1);
            unsigned base0 = 0u, base1 = 0u;
            if (lane == 0) { if (n0 > 0) base0 = atomicAdd(CNT + e0 * 64, (unsigned)n0); if (n1 > 0) base1 = atomicAdd(CNT + e1 * 64, (unsigned)n1); }
            base0 = (unsigned)__builtin_amdgcn_readfirstlane((int)base0); base1 = (unsigned)__builtin_amdgcn_readfirstlane((int)base1);
            if (rk0 >= 0) { const int idx = (int)base0 + __builtin_popcountll(bal0 & ((1ull << lane) - 1ull));
                if (idx < MOE_CAP) { ELIST[e0 * MOE_CAP + idx] = (seg * 64 + lane) * 2 + rk0; EW[e0 * MOE_CAP + idx] = RWT[lane * 2 + rk0]; } }
            if (rk1 >= 0) { const int idx = (int)base1 + __builtin_popcountll(bal1 & ((1ull << lane) - 1ull));
                if (idx < MOE_CAP) { ELIST[e1 * MOE_CAP + idx] = (seg * 64 + lane) * 2 + rk1; EW[e1 * MOE_CAP + idx] = RWT[lane * 2 + rk1]; } }
        }
        __syncthreads();
      }
    }
    if (ROUTER) __syncthreads();
}
#ifndef HAVE_NSA
#define HAVE_NSA 1
#endif
#ifndef HAVE_SSD
#define HAVE_SSD 1
#endif
#ifndef HAVE_LRU
#define HAVE_LRU 1
#endif
typedef float f32x16 __attribute__((ext_vector_type(16)));
#define MFMA16(a, b, c) __builtin_amdgcn_mfma_f32_16x16x32_bf16((a), (b), (c), 0, 0, 0)
#define MFMA32(a, b, c) __builtin_amdgcn_mfma_f32_32x32x16_bf16((a), (b), (c), 0, 0, 0)
__device__ __forceinline__ void unpack8f(const u32x4 w, f32x4& a, f32x4& b) {
    a[0] = __uint_as_float(w.x << 16); a[1] = __uint_as_float(w.x & 0xffff0000u); a[2] = __uint_as_float(w.y << 16); a[3] = __uint_as_float(w.y & 0xffff0000u);
    b[0] = __uint_as_float(w.z << 16); b[1] = __uint_as_float(w.z & 0xffff0000u); b[2] = __uint_as_float(w.w << 16); b[3] = __uint_as_float(w.w & 0xffff0000u); }
__device__ __forceinline__ u32x4 pack8f(const f32x4 a, const f32x4 b) { u32x4 w; w.x = pk2(a[0], a[1]); w.y = pk2(a[2], a[3]); w.z = pk2(b[0], b[1]); w.w = pk2(b[2], b[3]); return w; }

constexpr int LRU_XP = 520;
__device__ __forceinline__ float neg_expm1_fast(float x) {
    const float p = -x * (1.0f + x * (0.5f + x * (0.16666667f + x * (0.041666668f + x * (0.0083333338f + x * 0.0013888889f)))));
    return x > -0.5f ? p : 1.0f - __expf(x);
}
__device__ __forceinline__ float sigmoid_fast(float x) { return __builtin_amdgcn_rcpf(1.0f + __expf(-x)); }
__device__ __forceinline__ float gelu_tanh_fast(float x) { const float u = 0.7978845608028654f * (x + 0.044715f * x * x * x); const float t = 1.0f - 2.0f * __builtin_amdgcn_rcpf(1.0f + __expf(2.0f * u)); return 0.5f * x * (1.0f + t); }
template <bool FINAL>
__device__ __forceinline__ void lru_tile(const Args& a, unsigned char* wsp, int L, int unit, LAS unsigned char* lds, int tid) {
    const int lane = tid & 63, wave = tid >> 6, q = lane >> 4, c16 = lane & 15;
    const int b = unit >> 7, ck = unit & 127, s0 = ck * 64; const size_t t0 = (size_t)b * SEQ + s0;
    const bf16_t* LX = (const bf16_t*)(wsp + WS_LX); const bf16_t* LY = (const bf16_t*)(wsp + WS_LY); bf16_t* OL = (bf16_t*)(wsp + WS_ONSA) + 1024;
    float* SUM = (float*)(wsp + WS_LRUSUM) + (size_t)(b * 128 + ck) * 1024;
    LAS bf16_t* XT = (LAS bf16_t*)lds; LAS bf16_t* YT = XT + 64 * LRU_XP;
    const float* cw = a.in[15] + (size_t)L * 4 * 512; const float* cbias = a.in[16] + (size_t)L * 512;
    {   const int ch0 = lane * 8, tok0 = wave * 8;
        u32x4 xr[11];
#pragma unroll
        for (int i = 0; i < 11; ++i) { const int sr = s0 + tok0 - 3 + i; xr[i] = sr >= 0 ? *(const u32x4*)(LX + (t0 + tok0 - 3 + i) * 512 + ch0) : (u32x4){0u, 0u, 0u, 0u}; }
        f32x4 wl[4], wh[4];
#pragma unroll
        for (int k = 0; k < 4; ++k) { wl[k] = *(const f32x4*)(cw + k * 512 + ch0); wh[k] = *(const f32x4*)(cw + k * 512 + ch0 + 4); }
        const f32x4 bl = *(const f32x4*)(cbias + ch0), bh = *(const f32x4*)(cbias + ch0 + 4);
        if (FINAL) {
#pragma unroll
            for (int i = 0; i < 8; ++i) *(LAS u32x4*)(YT + (tok0 + i) * LRU_XP + ch0) = *(const u32x4*)(LY + (t0 + tok0 + i) * 512 + ch0);
        }
#pragma unroll
        for (int i = 0; i < 8; ++i) { f32x4 lo = bl, hi = bh;
#pragma unroll
            for (int k = 0; k < 4; ++k) { f32x4 xl, xh; unpack8f(xr[i + k], xl, xh); lo += wl[k] * xl; hi += wh[k] * xh; }
            *(LAS u32x4*)(XT + (tok0 + i) * LRU_XP + ch0) = pack8f(lo, hi); }
    }
    __syncthreads();
    const int n = wave;
    const bf16_t* WA = (const bf16_t*)(wsp + WS_W + W_LRUW) + (size_t)n * 4096; const bf16_t* WX = WA + 8 * 4096;
    const float* pba = a.in[18] + (size_t)L * 512; const float* pbx = a.in[20] + (size_t)L * 512; const float* plam = a.in[21] + (size_t)L * 512;
    bf16x8 wa0 = *(const bf16x8*)(WA + c16 * 64 + 8 * q), wa1 = *(const bf16x8*)(WA + c16 * 64 + 32 + 8 * q), wx0 = *(const bf16x8*)(WX + c16 * 64 + 8 * q), wx1 = *(const bf16x8*)(WX + c16 * 64 + 32 + 8 * q);
    float vba = pba[n * 64 + c16], vbx = pbx[n * 64 + c16], vlam = plam[n * 64 + c16], hcar = FINAL ? SUM[512 + n * 64 + c16] : 0.f;
#pragma unroll 1
    for (int nt = 0; nt < 4; ++nt) {
        const int d = nt * 16 + c16, ch = n * 64 + d;
        const int dn = (nt < 3 ? nt + 1 : nt) * 16 + c16;
        const bf16x8 nwa0 = *(const bf16x8*)(WA + dn * 64 + 8 * q), nwa1 = *(const bf16x8*)(WA + dn * 64 + 32 + 8 * q), nwx0 = *(const bf16x8*)(WX + dn * 64 + 8 * q), nwx1 = *(const bf16x8*)(WX + dn * 64 + 32 + 8 * q);
        const float nvba = pba[n * 64 + dn], nvbx = pbx[n * 64 + dn], nvlam = plam[n * 64 + dn], nhcar = FINAL ? SUM[512 + n * 64 + dn] : 0.f;
        const float xlam = -vlam, tl = __expf(xlam), sp = xlam > 15.f ? xlam : (tl < 0.03f ? tl * (1.0f - tl * (0.5f - tl * (0.33333334f - 0.25f * tl))) : __logf(1.0f + tl));
        float av[4][4], bv[4][4];
#pragma unroll
        for (int mt = 0; mt < 4; ++mt) {
            const LAS bf16_t* xr = XT + (16 * mt + c16) * LRU_XP + n * 64 + 8 * q;
            const bf16x8 x0 = *(const LAS bf16x8*)xr, x1 = *(const LAS bf16x8*)(xr + 32);
            f32x4 ga = {0.f, 0.f, 0.f, 0.f}, gx = {0.f, 0.f, 0.f, 0.f};
            ga = MFMA16(x0, wa0, ga); ga = MFMA16(x1, wa1, ga); gx = MFMA16(x0, wx0, gx); gx = MFMA16(x1, wx1, gx);
#pragma unroll
            for (int j = 0; j < 4; ++j) {
                const float r = sigmoid_fast(ga[j] + vba), ii = sigmoid_fast(gx[j] + vbx), la = -8.0f * r * sp;
                const float xv = bf2f(XT[(16 * mt + 4 * q + j) * LRU_XP + ch]);
                av[mt][j] = __expf(la); bv[mt][j] = __builtin_amdgcn_sqrtf(fmaxf(neg_expm1_fast(2.0f * la), 0.f)) * (ii * xv);
            }
        }
        float P[4], H[4];
#pragma unroll
        for (int mt = 0; mt < 4; ++mt) { float p = av[mt][0], h = bv[mt][0];
#pragma unroll
            for (int j = 1; j < 4; ++j) { h = av[mt][j] * h + bv[mt][j]; p *= av[mt][j]; }
            P[mt] = p; H[mt] = h; }
        float h = hcar; float hin[4] = {0.f, 0.f, 0.f, 0.f};
#pragma unroll
        for (int mt = 0; mt < 4; ++mt)
#pragma unroll
            for (int qq = 0; qq < 4; ++qq) { if (q == qq) hin[mt] = h; const float ho = P[mt] * h + H[mt]; h = __int_as_float(__builtin_amdgcn_ds_bpermute((c16 + 16 * qq) << 2, __float_as_int(ho))); }
        if (!FINAL) {
            float pt = (P[0] * P[1]) * (P[2] * P[3]); pt *= shx(pt, 16, lane); pt *= shx(pt, 32, lane);
            if (q == 0) { SUM[ch] = pt; SUM[512 + ch] = h; }
        } else {
#pragma unroll
            for (int mt = 0; mt < 4; ++mt) { float hh = hin[mt];
#pragma unroll
                for (int j = 0; j < 4; ++j) { hh = av[mt][j] * hh + bv[mt][j]; LAS bf16_t* yp = YT + (16 * mt + 4 * q + j) * LRU_XP + ch; yp[0] = (bf16_t)f2bf(hh * gelu_tanh_fast(bf2f(yp[0]))); } }
        }
        wa0 = nwa0; wa1 = nwa1; wx0 = nwx0; wx1 = nwx1; vba = nvba; vbx = nvbx; vlam = nvlam; hcar = nhcar;
    }
    __syncthreads();
    if (FINAL) {
        const int ch0 = lane * 8, tok0 = wave * 8;
#pragma unroll
        for (int i = 0; i < 8; ++i) *(u32x4*)(OL + (t0 + tok0 + i) * 1536 + ch0) = *(const LAS u32x4*)(YT + (tok0 + i) * LRU_XP + ch0);
        __syncthreads();
    }
}
__device__ __forceinline__ void lru_carry(const Args& a, unsigned char* wsp, int id) {
    const int b = id >> 9, ch = id & 511; float* S = (float*)(wsp + WS_LRUSUM) + (size_t)b * 128 * 1024 + ch; float carry = 0.f;
#pragma unroll 32
    for (int c = 0; c < 128; ++c) { const float A = S[c * 1024], Hh = S[c * 1024 + 512]; S[c * 1024 + 512] = carry; carry = A * carry + Hh; }
}
__device__ __forceinline__ void lru_carry4(const Args& a, unsigned char* wsp, int gid, int lane) {
    const int chain = gid >> 2, part = gid & 3, b = chain >> 9, ch = chain & 511; float* S = (float*)(wsp + WS_LRUSUM) + (size_t)b * 128 * 1024 + (size_t)(32 * part) * 1024 + ch;
    float A[32], Hh[32];
#pragma unroll
    for (int i = 0; i < 32; ++i) { A[i] = S[i * 1024]; Hh[i] = S[i * 1024 + 512]; }
    float P = 1.f, Hs = 0.f;
#pragma unroll
    for (int i = 0; i < 32; ++i) { Hs = A[i] * Hs + Hh[i]; P *= A[i]; }
    const int base = lane & ~3; float carry = 0.f;
#pragma unroll
    for (int pp = 0; pp < 3; ++pp) { const float Pp = __int_as_float(__builtin_amdgcn_ds_bpermute((base + pp) << 2, __float_as_int(P))), Hp = __int_as_float(__builtin_amdgcn_ds_bpermute((base + pp) << 2, __float_as_int(Hs)));
        if (pp < part) carry = Pp * carry + Hp; }
#pragma unroll
    for (int i = 0; i < 32; ++i) { S[i * 1024 + 512] = carry; carry = A[i] * carry + Hh[i]; }
}


constexpr size_t WS_SSQ = 256 * 1024;
__device__ __forceinline__ void ssd_conv8(const bf16_t* XBC, const float* cw, const float* cb, size_t trow, int s, int ch0, f32x4& lo, f32x4& hi) {
    lo = *(const f32x4*)(cb + ch0); hi = *(const f32x4*)(cb + ch0 + 4);
#pragma unroll
    for (int k = 0; k < 4; ++k) {
        if (s - 3 + k >= 0) {
            f32x4 xl, xh; unpack8f(*(const u32x4*)(XBC + (trow - 3 + k) * 768 + ch0), xl, xh);
            const f32x4 wl = *(const f32x4*)(cw + k * 768 + ch0), wh = *(const f32x4*)(cw + k * 768 + ch0 + 4);
            lo += wl * xl; hi += wh * xh; }
    }
#pragma unroll
    for (int i = 0; i < 4; ++i) { lo[i] = siluf_(lo[i]); hi[i] = siluf_(hi[i]); }
}
__device__ __forceinline__ void ssd_conv_seg4(const bf16_t* XBC, const float* cw, const float* cb, size_t trow0, int s, int ch0, f32x4 (&lo)[4], f32x4 (&hi)[4]) {
    u32x4 xr[7];
#pragma unroll
    for (int i = 0; i < 7; ++i) xr[i] = (s - 3 + i >= 0) ? *(const u32x4*)(XBC + (trow0 - 3 + i) * 768 + ch0) : (u32x4){0u, 0u, 0u, 0u};
    f32x4 wl[4], wh[4];
#pragma unroll
    for (int k = 0; k < 4; ++k) { wl[k] = *(const f32x4*)(cw + k * 768 + ch0); wh[k] = *(const f32x4*)(cw + k * 768 + ch0 + 4); }
    const f32x4 bl = *(const f32x4*)(cb + ch0), bh = *(const f32x4*)(cb + ch0 + 4);
#pragma unroll
    for (int t = 0; t < 4; ++t) { f32x4 a = bl, b = bh;
#pragma unroll
        for (int k = 0; k < 4; ++k) { f32x4 xl, xh; unpack8f(xr[t + k], xl, xh); a += wl[k] * xl; b += wh[k] * xh; }
#pragma unroll
        for (int i = 0; i < 4; ++i) { a[i] = a[i] * __builtin_amdgcn_rcpf(1.0f + __expf(-a[i])); b[i] = b[i] * __builtin_amdgcn_rcpf(1.0f + __expf(-b[i])); }
        lo[t] = a; hi[t] = b; }
}
__device__ __forceinline__ void ssd_prep(const Args& a, unsigned char* wsp, int L, size_t t0, int g, LAS float* dtl, LAS float* acum, int tid) {
    const int lane = tid & 63, wave = tid >> 6;
    {   const int hh = tid >> 7, l = tid & 127, h = g * 4 + hh;
        const float raw = ((const float*)(wsp + WS_SMALL))[(t0 + l) * 32 + 24 + h] + a.in[11][L * 8 + h];
        const float dt = softplusf_(raw), A = -__expf(a.in[12][L * 8 + h]);
        dtl[hh * 128 + l] = dt; acum[hh * 128 + l] = dt * A; }
    __syncthreads();
    if (wave < 4) {
        const float v0 = acum[wave * 128 + 2 * lane], v1 = acum[wave * 128 + 2 * lane + 1]; const float sm = v0 + v1; float inc = sm;
#pragma unroll
        for (int o = 1; o < 64; o <<= 1) { const float t = __int_as_float(__builtin_amdgcn_ds_bpermute(((lane - o) & 63) << 2, __float_as_int(inc))); if (lane >= o) inc += t; }
        const float ex = inc - sm; acum[wave * 128 + 2 * lane] = ex + v0; acum[wave * 128 + 2 * lane + 1] = ex + sm; }
    __syncthreads();
}
__device__ __forceinline__ void ssd_a_unit(const Args& a, unsigned char* wsp, int L, int unit, LAS unsigned char* lds, int tid) {
    const int lane = tid & 63, wave = tid >> 6, q = lane >> 4, c16 = lane & 15;
    const int b = unit >> 7, c = (unit & 127) >> 1, g = unit & 1; const size_t t0 = (size_t)b * SEQ + c * 128;
    LAS float* dtl = (LAS float*)lds; LAS float* acum = dtl + 512; LAS bf16_t* BT = (LAS bf16_t*)(lds + 4096); LAS bf16_t* XdT = BT + 64 * 136;
    const bf16_t* XBC = (const bf16_t*)(wsp + WS_XBC); const float* cw = a.in[9] + (size_t)L * 4 * 768; const float* cb = a.in[10] + (size_t)L * 768;
    ssd_prep(a, wsp, L, t0, g, dtl, acum, tid);
    for (int it = tid; it < 32 * 40; it += NTHREADS) {
        const int sg = it / 40, cg = it - sg * 40, l0 = sg * 4; const int ch0 = cg < 32 ? g * 256 + cg * 8 : 512 + g * 64 + (cg - 32) * 8;
        f32x4 lo[4], hi[4]; ssd_conv_seg4(XBC, cw, cb, t0 + l0, c * 128 + l0, ch0, lo, hi);
        if (cg < 32) { const int hh = cg >> 3, p0 = (cg & 7) * 8; const float ae = acum[hh * 128 + 127];
#pragma unroll
            for (int t = 0; t < 4; ++t) { const int l = l0 + t; const float sc = dtl[hh * 128 + l] * __expf(ae - acum[hh * 128 + l]); LAS bf16_t* d = XdT + (hh * 64 + p0) * 136 + l;
#pragma unroll
                for (int i = 0; i < 4; ++i) { d[i * 136] = (bf16_t)f2bf(lo[t][i] * sc); d[(i + 4) * 136] = (bf16_t)f2bf(hi[t][i] * sc); } } }
        else {
#pragma unroll
            for (int t = 0; t < 4; ++t) { LAS bf16_t* d = BT + ((cg - 32) * 8) * 136 + l0 + t;
#pragma unroll
                for (int i = 0; i < 4; ++i) { d[i * 136] = (bf16_t)f2bf(lo[t][i]); d[(i + 4) * 136] = (bf16_t)f2bf(hi[t][i]); } } }
    }
    __syncthreads();
    {   const int hh = wave >> 1, nt0 = (wave & 1) * 2, h = g * 4 + hh;
        float* S = (float*)(wsp + WS_STATES) + ((size_t)((b * 64 + c) * 8 + h)) * 4096;
#pragma unroll
        for (int nt = 0; nt < 2; ++nt)
#pragma unroll
            for (int pt = 0; pt < 4; ++pt) { f32x4 acc = {0.f, 0.f, 0.f, 0.f};
#pragma unroll
                for (int ks = 0; ks < 4; ++ks) { const bf16x8 af = *(const LAS bf16x8*)(BT + (16 * (nt0 + nt) + c16) * 136 + 32 * ks + 8 * q);
                    const bf16x8 bf = *(const LAS bf16x8*)(XdT + (hh * 64 + 16 * pt + c16) * 136 + 32 * ks + 8 * q); acc = MFMA16(af, bf, acc); }
                *(f32x4*)(S + (16 * pt + c16) * 64 + 16 * (nt0 + nt) + 4 * q) = acc; }
    }
    if (tid < 4) ((float*)(wsp + WS_AEND))[(b * 64 + c) * 8 + g * 4 + tid] = acum[tid * 128 + 127];
    __syncthreads();
}
__device__ __forceinline__ void ssd_scan(const Args& a, unsigned char* wsp, int id) {
    const int e = id & 4095, h = (id >> 12) & 7, b = id >> 15; float* S = (float*)(wsp + WS_STATES) + (size_t)b * 64 * 8 * 4096 + (size_t)h * 4096 + e;
    const float* AE = (const float*)(wsp + WS_AEND) + b * 64 * 8 + h; float run = 0.f;
#pragma unroll 32
    for (int c = 0; c < 64; ++c) { const float t = S[(size_t)c * 8 * 4096]; const float dec = __expf(AE[c * 8]); S[(size_t)c * 8 * 4096] = run; run = run * dec + t; }
}
__device__ __forceinline__ void ssd_scan2(const Args& a, unsigned char* wsp, int gid, int lane) {
    const int id = gid >> 1, part = gid & 1;
    const int e = id & 4095, h = (id >> 12) & 7, b = id >> 15; float* S = (float*)(wsp + WS_STATES) + (size_t)b * 64 * 8 * 4096 + (size_t)(32 * part) * 8 * 4096 + (size_t)h * 4096 + e;
    const float* AE = (const float*)(wsp + WS_AEND) + b * 64 * 8 + (32 * part) * 8 + h;
    float t[32], dec[32];
#pragma unroll
    for (int c = 0; c < 32; ++c) { t[c] = S[(size_t)c * 8 * 4096]; dec[c] = AE[c * 8]; }
    float Hs = 0.f;
#pragma unroll
    for (int c = 0; c < 32; ++c) { dec[c] = __expf(dec[c]); Hs = Hs * dec[c] + t[c]; }
    const float Hp = __int_as_float(__builtin_amdgcn_ds_bpermute((lane ^ 1) << 2, __float_as_int(Hs)));
    float run = part ? Hp : 0.f;
#pragma unroll
    for (int c = 0; c < 32; ++c) { S[(size_t)c * 8 * 4096] = run; run = run * dec[c] + t[c]; }
}
__device__ __forceinline__ void ssd_b_unit(const Args& a, unsigned char* wsp, int L, int unit, LAS unsigned char* lds, int tid) {
    const int lane = tid & 63, wave = tid >> 6, q = lane >> 4, c16 = lane & 15;
    const int b = unit >> 7, c = (unit & 127) >> 1, g = unit & 1; const size_t t0 = (size_t)b * SEQ + c * 128;
    LAS float* dtl = (LAS float*)lds; LAS float* acum = dtl + 512;
    LAS bf16_t* CM = (LAS bf16_t*)(lds + 4096); LAS bf16_t* BM = CM + 128 * 72; LAS bf16_t* XS = BM + 128 * 72; LAS bf16_t* XT = XS + 128 * 72; LAS bf16_t* SI = XT + 64 * 136; LAS bf16_t* ZS = SI + 64 * 72; LAS bf16_t* M1 = ZS + 128 * 72 + wave * (16 * 136);
    const bf16_t* XBC = (const bf16_t*)(wsp + WS_XBC); const float* cw = a.in[9] + (size_t)L * 4 * 768; const float* cb = a.in[10] + (size_t)L * 768;
    const bf16_t* Z = (const bf16_t*)(wsp + WS_Z); bf16_t* OS = (bf16_t*)(wsp + WS_ONSA) + 512;
    ssd_prep(a, wsp, L, t0, g, dtl, acum, tid);
    {   const int sg = tid >> 4, cg = tid & 15, l0 = sg * 4; const int ch0 = 512 + (cg >> 3) * 128 + g * 64 + (cg & 7) * 8;
        f32x4 lo[4], hi[4]; ssd_conv_seg4(XBC, cw, cb, t0 + l0, c * 128 + l0, ch0, lo, hi);
#pragma unroll
        for (int t = 0; t < 4; ++t) *(LAS u32x4*)((cg < 8 ? BM : CM) + (l0 + t) * 72 + (cg & 7) * 8) = pack8f(lo[t], hi[t]); }
    __syncthreads();
    f32x4 cbm[8];
#pragma unroll
    for (int st = 0; st < 8; ++st) { cbm[st] = (f32x4){0.f, 0.f, 0.f, 0.f};
        if (st <= wave) {
#pragma unroll
            for (int ks = 0; ks < 2; ++ks) { const bf16x8 af = *(const LAS bf16x8*)(CM + (16 * wave + c16) * 72 + 32 * ks + 8 * q), bf = *(const LAS bf16x8*)(BM + (16 * st + c16) * 72 + 32 * ks + 8 * q); cbm[st] = MFMA16(af, bf, cbm[st]); } } }
    float ssq[4] = {0.f, 0.f, 0.f, 0.f};
#pragma unroll 1
    for (int hh = 0; hh < 4; ++hh) {
        const int h = g * 4 + hh;
        __syncthreads();
        if (tid < 256) {
            const int sg = tid >> 3, p0 = (tid & 7) * 8, l0 = sg * 4; f32x4 lo[4], hi[4]; ssd_conv_seg4(XBC, cw, cb, t0 + l0, c * 128 + l0, h * 64 + p0, lo, hi);
#pragma unroll
            for (int t = 0; t < 4; ++t) { const int l = l0 + t; *(LAS u32x4*)(XS + l * 72 + p0) = pack8f(lo[t], hi[t]);
                const float dt = dtl[hh * 128 + l]; LAS bf16_t* d = XT + p0 * 136 + l;
#pragma unroll
                for (int i = 0; i < 4; ++i) { d[i * 136] = (bf16_t)f2bf(lo[t][i] * dt); d[(i + 4) * 136] = (bf16_t)f2bf(hi[t][i] * dt); } }
        } else {
            const int t2 = tid - 256;
#pragma unroll
            for (int k = 0; k < 4; ++k) { const int it = t2 + 256 * k, l = it >> 3, p0 = (it & 7) * 8; *(LAS u32x4*)(ZS + l * 72 + p0) = *(const u32x4*)(Z + (t0 + l) * 512 + h * 64 + p0); }
        }
        {   const float* S = (const float*)(wsp + WS_STATES) + ((size_t)((b * 64 + c) * 8 + h)) * 4096;
            const int p = tid >> 3, n0 = (tid & 7) * 8; const f32x4 s0 = *(const f32x4*)(S + p * 64 + n0), s1 = *(const f32x4*)(S + p * 64 + n0 + 4);
            *(LAS u32x4*)(SI + p * 72 + n0) = pack8f(s0, s1); }
        __syncthreads();
#pragma unroll
        for (int st = 0; st < 8; ++st) { const float as = acum[hh * 128 + 16 * st + c16];
#pragma unroll
            for (int j = 0; j < 4; ++j) { const int l = 16 * wave + 4 * q + j, s = 16 * st + c16;
                const float v = (st <= wave && s <= l) ? cbm[st][j] * __expf(acum[hh * 128 + l] - as) : 0.f; M1[(4 * q + j) * 136 + s] = (bf16_t)f2bf(v); } }
        f32x4 y[4], yo[4];
#pragma unroll
        for (int pt = 0; pt < 4; ++pt) { y[pt] = (f32x4){0.f, 0.f, 0.f, 0.f}; yo[pt] = (f32x4){0.f, 0.f, 0.f, 0.f}; }
        const int nks = (16 * wave + 15) / 32 + 1;
        for (int ks = 0; ks < nks; ++ks) { const bf16x8 af = *(const LAS bf16x8*)(M1 + c16 * 136 + 32 * ks + 8 * q);
#pragma unroll
            for (int pt = 0; pt < 4; ++pt) { const bf16x8 bf = *(const LAS bf16x8*)(XT + (16 * pt + c16) * 136 + 32 * ks + 8 * q); y[pt] = MFMA16(af, bf, y[pt]); } }
#pragma unroll
        for (int ks = 0; ks < 2; ++ks) { const bf16x8 af = *(const LAS bf16x8*)(CM + (16 * wave + c16) * 72 + 32 * ks + 8 * q);
#pragma unroll
            for (int pt = 0; pt < 4; ++pt) { const bf16x8 bf = *(const LAS bf16x8*)(SI + (16 * pt + c16) * 72 + 32 * ks + 8 * q); yo[pt] = MFMA16(af, bf, yo[pt]); } }
        const float Dh = a.in[13][L * 8 + h]; float nw[4];
#pragma unroll
        for (int pt = 0; pt < 4; ++pt) nw[pt] = a.in[14][L * 512 + h * 64 + 16 * pt + c16];
#pragma unroll
        for (int j = 0; j < 4; ++j) { const int l = 16 * wave + 4 * q + j; const float ea = __expf(acum[hh * 128 + l]);
#pragma unroll
            for (int pt = 0; pt < 4; ++pt) { const int p = 16 * pt + c16; LAS bf16_t* zp = ZS + l * 72 + p;
                float v = y[pt][j] + ea * yo[pt][j] + Dh * bf2f(XS[l * 72 + p]); const float zz = bf2f(zp[0]); v *= zz * __builtin_amdgcn_rcpf(1.0f + __expf(-zz)); ssq[j] += v * v;
                zp[0] = (bf16_t)f2bf(v * nw[pt]); } }
        __syncthreads();
        {
#pragma unroll
            for (int k = 0; k < 2; ++k) { const int it = tid + 512 * k, l = it >> 3, p0 = (it & 7) * 8; *(u32x4*)(OS + (t0 + l) * 1536 + h * 64 + p0) = *(const LAS u32x4*)(ZS + l * 72 + p0); } }
    }
#pragma unroll
    for (int j = 0; j < 4; ++j) { float v = ssq[j]; v += shx(v, 1, lane); v += shx(v, 2, lane); v += shx(v, 4, lane); v += shx(v, 8, lane);
        if (c16 == 0) ((float*)(wsp + WS_SSQ))[(t0 + 16 * wave + 4 * q + j) * 2 + g] = v; }
    __syncthreads();
}


constexpr int ATT_KP = 72;
__device__ __forceinline__ f32x16 att_scores(const LAS bf16_t* kt, const bf16x8 (&qf)[4], int r, int h) {
    f32x16 s = {0.f, 0.f, 0.f, 0.f, 0.f, 0.f, 0.f, 0.f, 0.f, 0.f, 0.f, 0.f, 0.f, 0.f, 0.f, 0.f};
#pragma unroll
    for (int ks = 0; ks < 4; ++ks) { const bf16x8 kf = *(const LAS bf16x8*)(kt + r * ATT_KP + 16 * ks + 8 * h); s = MFMA32(kf, qf[ks], s); }
    return s;
}
__device__ __forceinline__ void att_pv(f32x16& o0, f32x16& o1, const LAS bf16_t* vt, const f32x16& p, int r, int h) {
#pragma unroll
    for (int s = 0; s < 2; ++s) {
        u32x4 pw; pw.x = cvtpk(p[8 * s + 0], p[8 * s + 1]); pw.y = cvtpk(p[8 * s + 2], p[8 * s + 3]); pw.z = cvtpk(p[8 * s + 4], p[8 * s + 5]); pw.w = cvtpk(p[8 * s + 6], p[8 * s + 7]);
        const bf16x8 pb = __builtin_bit_cast(bf16x8, pw);
        o0 = MFMA32(*(const LAS bf16x8*)(vt + r * ATT_KP + 16 * s + 8 * h), pb, o0);
        o1 = MFMA32(*(const LAS bf16x8*)(vt + (32 + r) * ATT_KP + 16 * s + 8 * h), pb, o1);
    }
}
__device__ __forceinline__ float max16(const f32x16& s) {
    float a = fmaxf(fmaxf(s[0], s[1]), s[2]), b = fmaxf(fmaxf(s[3], s[4]), s[5]);
    a = fmaxf(fmaxf(a, s[6]), s[7]); b = fmaxf(fmaxf(b, s[8]), s[9]); a = fmaxf(fmaxf(a, s[10]), s[11]); b = fmaxf(fmaxf(b, s[12]), s[13]); a = fmaxf(fmaxf(a, s[14]), s[15]);
    return fmaxf(a, b);
}
template <bool MASKED>
__device__ __forceinline__ void att_step(float& m, float& l, f32x16& o0, f32x16& o1, const LAS bf16_t* kt, const LAS bf16_t* vt, const bf16x8 (&qf)[4], unsigned vm, bool mine, int r, int h, int lane) {
    f32x16 s = att_scores(kt, qf, r, h);
    if (MASKED) {
#pragma unroll
        for (int i = 0; i < 16; ++i) s[i] = ((vm >> i) & 1u) ? s[i] : -1e30f;
    }
    float mx = max16(s); mx = fmaxf(mx, shx(mx, 32, lane));
    if (!MASKED) mx = mine ? mx : -1e30f;
    if (__any(mx > m + 8.f)) { const float mn = fmaxf(m, mx); const float alpha = __builtin_amdgcn_exp2f(m - mn); l *= alpha; o0 = o0 * alpha; o1 = o1 * alpha; m = mn; }
    const float moff = (m > -1e29f && (MASKED || mine)) ? m : 1e30f;
    f32x16 p; float ps = 0.f;
#pragma unroll
    for (int i = 0; i < 16; ++i) { p[i] = __builtin_amdgcn_exp2f(s[i] - moff); ps += p[i]; }
    l += ps;
    att_pv(o0, o1, vt, p, r, h);
}
__device__ __forceinline__ void att_block(float& m, f32x16& la, f32x16& o0, f32x16& o1, const LAS bf16_t* kt, const LAS bf16_t* vt, const bf16x8 (&qf)[4], unsigned vmA, unsigned vmB, bool mine, const bool masked, int r, int h, int lane) {
    const bool live = masked || mine, mval = m > -1e29f;
    const float base = live ? (mval ? m : 0.f) : 1e30f, nb = -base;
    f32x16 sA, sB;
#pragma unroll
    for (int i = 0; i < 16; ++i) { sA[i] = nb; sB[i] = nb; }
#pragma unroll
    for (int ks = 0; ks < 4; ++ks) { const bf16x8 ka = *(const LAS bf16x8*)(kt + r * ATT_KP + 16 * ks + 8 * h), kb = *(const LAS bf16x8*)(kt + (32 + r) * ATT_KP + 16 * ks + 8 * h);
        sA = MFMA32(ka, qf[ks], sA); sB = MFMA32(kb, qf[ks], sB); }
    if (masked) {
#pragma unroll
        for (int i = 0; i < 16; ++i) { sA[i] = ((vmA >> i) & 1u) ? sA[i] : -1e30f; sB[i] = ((vmB >> i) & 1u) ? sB[i] : -1e30f; }
    }
    float mx = fmaxf(max16(sA), max16(sB)); mx = fmaxf(mx, shx(mx, 32, lane));
    if (__builtin_expect(__any(mx > (mval ? 8.f : -1e29f)), 0)) {
        const float mxt = live ? mx + base : -1e30f, mn = fmaxf(m, mxt);
        const float alpha = __builtin_amdgcn_exp2f(m - mn); la[0] *= alpha; o0 = o0 * alpha; o1 = o1 * alpha; m = mn;
        const float d = (live && mn > -1e29f) ? mn - base : 0.f;
#pragma unroll
        for (int i = 0; i < 16; ++i) { sA[i] -= d; sB[i] -= d; }
    }
#pragma unroll
    for (int i = 0; i < 16; ++i) { sA[i] = __builtin_amdgcn_exp2f(sA[i]); sB[i] = __builtin_amdgcn_exp2f(sB[i]); }
    u32x4 onew; onew.x = 0x3F803F80u; onew.y = 0x3F803F80u; onew.z = 0x3F803F80u; onew.w = 0x3F803F80u;
    const bf16x8 ones = __builtin_bit_cast(bf16x8, onew);
#pragma unroll
    for (int s4 = 0; s4 < 4; ++s4) {
        u32x4 pw;
        if (s4 < 2) { pw.x = cvtpk(sA[8 * s4 + 0], sA[8 * s4 + 1]); pw.y = cvtpk(sA[8 * s4 + 2], sA[8 * s4 + 3]); pw.z = cvtpk(sA[8 * s4 + 4], sA[8 * s4 + 5]); pw.w = cvtpk(sA[8 * s4 + 6], sA[8 * s4 + 7]); }
        else { const int b = 8 * (s4 - 2); pw.x = cvtpk(sB[b + 0], sB[b + 1]); pw.y = cvtpk(sB[b + 2], sB[b + 3]); pw.z = cvtpk(sB[b + 4], sB[b + 5]); pw.w = cvtpk(sB[b + 6], sB[b + 7]); }
        const bf16x8 pb = __builtin_bit_cast(bf16x8, pw);
        la = MFMA32(ones, pb, la);
        o0 = MFMA32(*(const LAS bf16x8*)(vt + r * ATT_KP + 16 * s4 + 8 * h), pb, o0);
        o1 = MFMA32(*(const LAS bf16x8*)(vt + (32 + r) * ATT_KP + 16 * s4 + 8 * h), pb, o1);
    }
}
struct AttStage { u32x4 k, v; };
__device__ __forceinline__ void att_load(AttStage& sr, const bf16_t* kg, const bf16_t* vg, int vpitch, int tid, bool with_v) {
    const int rr = tid >> 3, ch = (tid & 7) * 8;
    sr.k = *(const u32x4*)(kg + (size_t)rr * 64 + ch);
    if (with_v) sr.v = *(const u32x4*)(vg + (size_t)rr * vpitch + ch);
}
__device__ __forceinline__ void att_store(LAS bf16_t* KT, LAS bf16_t* VT, const AttStage& sr, int tid, bool with_v) {
    const int rr = tid >> 3, ch = (tid & 7) * 8;
    *(LAS u32x4*)(KT + rr * ATT_KP + ch) = sr.k;
    if (with_v) { const int g16 = (tid & 7) >> 1, hf = tid & 1;
        *(LAS u32x2*)(VT + rr * ATT_KP + 16 * g16 + 4 * hf) = (u32x2){sr.v.x, sr.v.y}; *(LAS u32x2*)(VT + rr * ATT_KP + 16 * g16 + 8 + 4 * hf) = (u32x2){sr.v.z, sr.v.w}; }
}
__device__ __forceinline__ int next_bit(unsigned u0, unsigned u1, unsigned u2, unsigned u3, int from, int last) {
    for (int w = from >> 5; w < 4; ++w) {
        unsigned x = w == 0 ? u0 : (w == 1 ? u1 : (w == 2 ? u2 : u3));
        if (w == (from >> 5)) x &= ~0u << (from & 31);
        if (x) { const int p = w * 32 + __builtin_ctz(x); return p <= last ? p : -1; }
    }
    return -1;
}
__device__ __forceinline__ int next_pair(unsigned u0, unsigned u1, unsigned u2, unsigned u3, int fromp, int lastp) { const int bq = next_bit(u0, u1, u2, u3, 2 * fromp, 2 * lastp + 1); return bq >= 0 ? (bq >> 1) : -1; }
constexpr int ATT_BUF = 2 * 64 * ATT_KP;
#ifdef PROBE_MODE
#define NSA_BAR() do { const unsigned t0_ = (unsigned)__builtin_readcyclecounter(); __syncthreads(); pr_bar += (unsigned)__builtin_readcyclecounter() - t0_; } while (0)
#else
#define NSA_BAR() __syncthreads()
#endif
__device__ __forceinline__ void nsa_unit(const Args& a, unsigned char* wsp, int L, int bg, int qb, LAS unsigned char* lds, int tid) {
#ifdef PROBE_MODE
    unsigned pr_bar = 0u; const unsigned pr_t0 = (unsigned)__builtin_readcyclecounter();
#endif
    const int lane = tid & 63, wave = tid >> 6, r = lane & 31, h = lane >> 5;
    const int b = bg >> 1, g = bg & 1, t0 = qb * 64; const size_t rowbase = (size_t)b * SEQ + t0;
    LAS bf16_t* BUF = (LAS bf16_t*)lds;
    LAS float* IMP = (LAS float*)(lds + 2 * ATT_BUF * 2); LAS unsigned* SELM = (LAS unsigned*)(IMP + 64 * 128); LAS unsigned* UM = SELM + 256; LAS float* FIN = (LAS float*)(lds + 4 * ATT_BUF * 2) + tid;
    const bf16_t* KV = (const bf16_t*)(wsp + WS_KV); const bf16_t* KC = (const bf16_t*)(wsp + WS_KC) + (size_t)bg * 512 * 64; const bf16_t* VCT = (const bf16_t*)(wsp + WS_KC + 256 * 1024) + (size_t)bg * 64 * 512;
    const bf16_t* KSEL = KV + 2 * KV_STRIDE + (size_t)bg * SEQ * 64; const bf16_t* VSELT = KV + 3 * KV_STRIDE + (size_t)bg * 64 * SEQ;
    const bf16_t* KWIN = KV + 4 * KV_STRIDE + (size_t)bg * SEQ * 64; const bf16_t* VWINT = KV + 5 * KV_STRIDE + (size_t)bg * 64 * SEQ;
    const int tokl = 8 * wave + (r >> 2), hd = g * 4 + (r & 3), tq = t0 + tokl;
    bf16x8 qf[4];
    {   const bf16_t* qp = (const bf16_t*)(wsp + WS_Q) + (rowbase + tokl) * 512 + hd * 64 + 8 * h;
#pragma unroll
        for (int ks = 0; ks < 4; ++ks) qf[ks] = *(const bf16x8*)(qp + 16 * ks); }
    const float* gl = (const float*)(wsp + WS_SMALL) + (rowbase + tokl) * 32 + hd * 3;
    const float g_cmp = sigmoidf_(gl[0]), g_slc = sigmoidf_(gl[1]), g_win = sigmoidf_(gl[2]);
    for (int i = lane; i < 8 * 128; i += 64) IMP[wave * 8 * 128 + i] = 0.f;
    asm volatile("" :: "v"(qf[0]), "v"(qf[1]), "v"(qf[2]), "v"(qf[3]));
    f32x16 zero16;
#pragma unroll
    for (int i = 0; i < 16; ++i) zero16[i] = 0.f;
    AttStage sr;
#define ATT_PIPE_BEGIN(FIRST, NEXT, LOADX, WV) \
    { int blk = (FIRST), nb = -1, par = 0; \
      if (blk >= 0) { const int cb_ = blk; LOADX; att_store(BUF, BUF + 64 * ATT_KP, sr, tid, WV); nb = (NEXT); if (nb >= 0) { const int cb_ = nb; LOADX; } } \
      NSA_BAR(); \
      while (blk >= 0) { LAS bf16_t* KT = BUF + par * ATT_BUF; LAS bf16_t* VT = KT + 64 * ATT_KP; (void)VT;
#define ATT_PIPE_END(NEXT, LOADX, WV) \
        if (nb >= 0) { att_store(BUF + (par ^ 1) * ATT_BUF, BUF + (par ^ 1) * ATT_BUF + 64 * ATT_KP, sr, tid, WV); const int nb0_ = nb; blk = nb; nb = (NEXT); (void)nb0_; if (nb >= 0) { const int cb_ = nb; LOADX; } } else blk = -1; \
        NSA_BAR(); par ^= 1; } }
#define ATT_PIPE2(FIRST, NEXTOF, KPTR, VPTR, VPITCH, COMPUTE) \
    { AttStage srX, srY; int bA = (FIRST), bB = -1, bC = -1; __builtin_amdgcn_s_waitcnt(0x0F70);   \
      if (bA >= 0) { att_load(srX, KPTR(bA), VPTR(bA), VPITCH, tid, true); att_store(BUF, BUF + 64 * ATT_KP, srX, tid, true); bB = NEXTOF(bA); \
          if (bB >= 0) { att_load(srX, KPTR(bB), VPTR(bB), VPITCH, tid, true); bC = NEXTOF(bB); if (bC >= 0) att_load(srY, KPTR(bC), VPTR(bC), VPITCH, tid, true); } } \
      NSA_BAR(); \
      while (bA >= 0) { \
          { const int blk = bA; LAS bf16_t* KT = BUF; LAS bf16_t* VT = BUF + 64 * ATT_KP; COMPUTE } \
          int bD = -1; if (bB >= 0) { att_store(BUF + ATT_BUF, BUF + ATT_BUF + 64 * ATT_KP, srX, tid, true); if (bC >= 0) { bD = NEXTOF(bC); if (bD >= 0) att_load(srX, KPTR(bD), VPTR(bD), VPITCH, tid, true); } } \
          NSA_BAR(); if (bB < 0) break; \
          { const int blk = bB; LAS bf16_t* KT = BUF + ATT_BUF; LAS bf16_t* VT = BUF + ATT_BUF + 64 * ATT_KP; COMPUTE } \
          int bE = -1; if (bC >= 0) { att_store(BUF, BUF + 64 * ATT_KP, srY, tid, true); if (bD >= 0) { bE = NEXTOF(bD); if (bE >= 0) att_load(srY, KPTR(bE), VPTR(bE), VPITCH, tid, true); } } \
          NSA_BAR(); bA = bC; bB = bD; bC = bE; } }
#define ATT_PAIRS(FIRSTP, NEXTP, KPTR, VPTR, VPITCH, COMPUTE) \
    { AttStage sa, sb; int pA = (FIRSTP), pB = -1, par = 0; __builtin_amdgcn_s_waitcnt(0x0F70);   \
      if (pA >= 0) { att_load(sa, KPTR(2 * pA), VPTR(2 * pA), VPITCH, tid, true); att_load(sb, KPTR(2 * pA + 1), VPTR(2 * pA + 1), VPITCH, tid, true); \
          att_store(BUF, BUF + 64 * ATT_KP, sa, tid, true); att_store(BUF + ATT_BUF, BUF + ATT_BUF + 64 * ATT_KP, sb, tid, true); \
          pB = NEXTP(pA); if (pB >= 0) { att_load(sa, KPTR(2 * pB), VPTR(2 * pB), VPITCH, tid, true); att_load(sb, KPTR(2 * pB + 1), VPTR(2 * pB + 1), VPITCH, tid, true); } } \
      NSA_BAR(); \
      while (pA >= 0) { LAS bf16_t* PB_ = BUF + par * 2 * ATT_BUF; \
          { const int blk = 2 * pA; LAS bf16_t* KT = PB_; LAS bf16_t* VT = KT + 64 * ATT_KP; COMPUTE } \
          { const int blk = 2 * pA + 1; LAS bf16_t* KT = PB_ + ATT_BUF; LAS bf16_t* VT = KT + 64 * ATT_KP; COMPUTE } \
          if (pB >= 0) { LAS bf16_t* NB_ = BUF + (par ^ 1) * 2 * ATT_BUF; att_store(NB_, NB_ + 64 * ATT_KP, sa, tid, true); att_store(NB_ + ATT_BUF, NB_ + ATT_BUF + 64 * ATT_KP, sb, tid, true); \
              pA = pB; pB = NEXTP(pB); if (pB >= 0) { att_load(sa, KPTR(2 * pB), VPTR(2 * pB), VPITCH, tid, true); att_load(sb, KPTR(2 * pB + 1), VPTR(2 * pB + 1), VPITCH, tid, true); } } \
          else pA = -1; \
          NSA_BAR(); par ^= 1; } }
    const int nmaxq = tq >= 31 ? (((tq - 31) >> 4) < 510 ? ((tq - 31) >> 4) : 510) : -1;
    const int tq_lo = t0 + 8 * wave, nmax_lo = tq_lo >= 31 ? (((tq_lo - 31) >> 4) < 510 ? ((tq_lo - 31) >> 4) : 510) : -1, nmax_hi = (((tq_lo + 7 - 31) >> 4) < 510 ? ((tq_lo + 7 - 31) >> 4) : 510);
    const int ncb = (((t0 + 63 - 31) >> 4) >> 6) + 1;
    float m = -1e30f, l = 0.f;
    ATT_PIPE_BEGIN(0, (blk + 1 < ncb ? blk + 1 : -1), att_load(sr, KC + (size_t)cb_ * 64 * 64, VCT + cb_ * 64, 512, tid, false), false)
#pragma unroll
        for (int tl = 0; tl < 2; ++tl) {
            const int n0 = blk * 64 + tl * 32;
            if (n0 > nmax_hi) continue;
            f32x16 s = att_scores(KT + tl * 32 * ATT_KP, qf, r, h);
            if (n0 + 31 > nmax_lo) {
#pragma unroll
                for (int i = 0; i < 16; ++i) s[i] = (n0 + (i & 3) + 8 * (i >> 2) + 4 * h) <= nmaxq ? s[i] : -1e30f;
            }
            float mx = max16(s); mx = fmaxf(mx, shx(mx, 32, lane));
            const float mn = fmaxf(m, mx), moff = mn > -1e29f ? mn : 1e30f; float ps = 0.f;
#pragma unroll
            for (int i = 0; i < 16; ++i) ps += __builtin_amdgcn_exp2f(s[i] - moff);
            l = l * __builtin_amdgcn_exp2f(m - mn) + ps; m = mn;
        }
    ATT_PIPE_END((nb0_ + 1 < ncb ? nb0_ + 1 : -1), att_load(sr, KC + (size_t)cb_ * 64 * 64, VCT + cb_ * 64, 512, tid, false), false)
    l += shx(l, 32, lane);
    {
        const float invl = l > 0.f ? 1.0f / l : 0.f; f32x16 o0 = zero16, o1 = zero16;
        ATT_PIPE_BEGIN(0, (blk + 1 < ncb ? blk + 1 : -1), att_load(sr, KC + (size_t)cb_ * 64 * 64, VCT + cb_ * 64, 512, tid, true), true)
#pragma unroll
            for (int tl = 0; tl < 2; ++tl) {
                const int n0 = blk * 64 + tl * 32;
                if (n0 > nmax_hi) continue;
                f32x16 s = att_scores(KT + tl * 32 * ATT_KP, qf, r, h); f32x16 p;
                if (n0 + 31 > nmax_lo) {
#pragma unroll
                    for (int i = 0; i < 16; ++i) s[i] = (n0 + (i & 3) + 8 * (i >> 2) + 4 * h) <= nmaxq ? s[i] : -1e30f;
                }
#pragma unroll
                for (int i = 0; i < 16; ++i) p[i] = __builtin_amdgcn_exp2f(s[i] - m) * invl;
                att_pv(o0, o1, VT + tl * 32, p, r, h);
#pragma unroll
                for (int rq = 0; rq < 4; ++rq) {
                    float av = 2.0f * (p[4 * rq] + p[4 * rq + 1] + p[4 * rq + 2]) + p[4 * rq + 3], bvv = p[4 * rq + 3];
                    av += shx(av, 1, lane); av += shx(av, 2, lane); bvv += shx(bvv, 1, lane); bvv += shx(bvv, 2, lane);
                    const int mb = (n0 >> 2) + 2 * rq + h;
                    if ((r & 3) == 0) { LAS float* ip = IMP + tokl * 128 + mb; ip[0] += av; }
                    if ((r & 3) == 0 && mb + 1 < 128) { LAS float* ip = IMP + tokl * 128 + mb + 1; ip[0] += bvv; }
                }
            }
        ATT_PIPE_END((nb0_ + 1 < ncb ? nb0_ + 1 : -1), att_load(sr, KC + (size_t)cb_ * 64 * 64, VCT + cb_ * 64, 512, tid, true), true)
#pragma unroll
        for (int i = 0; i < 16; ++i) { FIN[i * 512] = o0[i] * g_cmp; FIN[(16 + i) * 512] = o1[i] * g_cmp; }
    }
    {
        const int cur = qb;
        const int b0 = lane, b1 = lane + 64; const bool val0 = b0 <= cur, val1 = b1 <= cur;
        const bool f0 = (b0 == 0 || b0 == cur || b0 == cur - 1), f1 = (b1 == 0 || b1 == cur || b1 == cur - 1);
        unsigned long long ua0 = 0ull, ua1 = 0ull;
#pragma unroll 1
        for (int tk = 0; tk < 2; ++tk) {
            unsigned k0[4], k1[4], T[4]; unsigned long long m0[4], m1[4];
#pragma unroll
            for (int u = 0; u < 4; ++u) { const LAS float* row = IMP + (8 * wave + tk + 2 * u) * 128; k0[u] = __float_as_uint(f0 ? 1e4f : row[lane]); k1[u] = __float_as_uint(f1 ? 1e4f : row[64 + lane]); T[u] = 0u; }
            if (cur + 1 <= 16) {
#pragma unroll
                for (int u = 0; u < 4; ++u) { m0[u] = __ballot(val0); m1[u] = __ballot(val1); }
            } else {
#pragma unroll 1
                for (int bit = 30; bit >= 0; --bit) {
#pragma unroll
                    for (int u = 0; u < 4; ++u) { const unsigned c = T[u] | (1u << bit);
                        const int n = __popcll(__ballot(val0 && k0[u] >= c)) + __popcll(__ballot(val1 && k1[u] >= c));
                        T[u] = n >= 16 ? c : T[u]; } }
#pragma unroll
                for (int u = 0; u < 4; ++u) {
                    const unsigned long long g0 = __ballot(val0 && k0[u] > T[u]), g1 = __ballot(val1 && k1[u] > T[u]), e0 = __ballot(val0 && k0[u] == T[u]), e1 = __ballot(val1 && k1[u] == T[u]);
                    const int need = 16 - (__popcll(g0) + __popcll(g1));
                    const int r0 = (int)__builtin_amdgcn_mbcnt_hi((unsigned)(e0 >> 32), __builtin_amdgcn_mbcnt_lo((unsigned)e0, 0u));
                    const int r1 = __popcll(e0) + (int)__builtin_amdgcn_mbcnt_hi((unsigned)(e1 >> 32), __builtin_amdgcn_mbcnt_lo((unsigned)e1, 0u));
                    m0[u] = __ballot(val0 && (k0[u] > T[u] || (k0[u] == T[u] && r0 < need))); m1[u] = __ballot(val1 && (k1[u] > T[u] || (k1[u] == T[u] && r1 < need))); }
            }
#pragma unroll
            for (int u = 0; u < 4; ++u) { ua0 |= m0[u]; ua1 |= m1[u]; }
            if (lane == 0) {
#pragma unroll
                for (int u = 0; u < 4; ++u) { const int tokw = 8 * wave + tk + 2 * u; SELM[tokw * 4 + 0] = (unsigned)m0[u]; SELM[tokw * 4 + 1] = (unsigned)(m0[u] >> 32); SELM[tokw * 4 + 2] = (unsigned)m1[u]; SELM[tokw * 4 + 3] = (unsigned)(m1[u] >> 32); } }
        }
        if (lane == 0) { UM[4 * wave + 0] = (unsigned)ua0; UM[4 * wave + 1] = (unsigned)(ua0 >> 32); UM[4 * wave + 2] = (unsigned)ua1; UM[4 * wave + 3] = (unsigned)(ua1 >> 32); }
    }
    NSA_BAR();
    {
        m = -1e30f; f32x16 la = zero16; f32x16 o0 = zero16, o1 = zero16;
        const unsigned sw0 = SELM[tokl * 4 + 0], sw1 = SELM[tokl * 4 + 1], sw2 = SELM[tokl * 4 + 2], sw3 = SELM[tokl * 4 + 3];
        unsigned um0 = 0u, um1 = 0u, um2 = 0u, um3 = 0u;
#pragma unroll
        for (int w = 0; w < 8; ++w) { um0 |= UM[4 * w + 0]; um1 |= UM[4 * w + 1]; um2 |= UM[4 * w + 2]; um3 |= UM[4 * w + 3]; }
#define SEL_NEXT(x) next_pair(um0, um1, um2, um3, (x) + 1, qb >> 1)
#define SEL_K(x) (KSEL + (size_t)(x) * 64 * 64)
#define SEL_V(x) (VSELT + (x) * 64)
#define SEL_BODY { const unsigned sw = blk < 32 ? sw0 : (blk < 64 ? sw1 : (blk < 96 ? sw2 : sw3)); const bool mine = (sw >> (blk & 31)) & 1u; \
            if (__any(mine)) { const bool masked = !(blk < qb); unsigned vmA = 0u, vmB = 0u; \
                if (masked) { \
                    _Pragma("unroll") for (int i = 0; i < 16; ++i) { const int pos = blk * 64 + (i & 3) + 8 * (i >> 2) + 4 * h; vmA |= ((mine && pos <= tq) ? 1u : 0u) << i; vmB |= ((mine && pos + 32 <= tq) ? 1u : 0u) << i; } } \
                att_block(m, la, o0, o1, KT, VT, qf, vmA, vmB, mine, masked, r, h, lane); } }
        ATT_PAIRS(next_pair(um0, um1, um2, um3, 0, qb >> 1), SEL_NEXT, SEL_K, SEL_V, SEQ, SEL_BODY)
#undef SEL_NEXT
#undef SEL_K
#undef SEL_V
#undef SEL_BODY
        const float sc = g_slc / fmaxf(la[0], 1e-30f);
#pragma unroll
        for (int i = 0; i < 16; ++i) { FIN[i * 512] += o0[i] * sc; FIN[(16 + i) * 512] += o1[i] * sc; }
    }
    {
        m = -1e30f; f32x16 la = zero16; f32x16 o0 = zero16, o1 = zero16;
#define WIN_NEXT(x) ((x) + 1 <= (qb >> 1) ? (x) + 1 : -1)
#define WIN_K(x) (KWIN + (size_t)(x) * 64 * 64)
#define WIN_V(x) (VWINT + (x) * 64)
#define WIN_BODY { const bool masked = !(blk > qb - 8 && blk < qb); unsigned vmA = 0u, vmB = 0u; \
            if (masked) { \
                _Pragma("unroll") for (int i = 0; i < 16; ++i) { const int pos = blk * 64 + (i & 3) + 8 * (i >> 2) + 4 * h; vmA |= ((pos <= tq && pos + 512 > tq) ? 1u : 0u) << i; vmB |= ((pos + 32 <= tq && pos + 32 + 512 > tq) ? 1u : 0u) << i; } } \
            if (!masked || __any((vmA | vmB) != 0u)) att_block(m, la, o0, o1, KT, VT, qf, vmA, vmB, true, masked, r, h, lane); }
        ATT_PAIRS(((qb >= 8 ? qb - 8 : 0) >> 1), WIN_NEXT, WIN_K, WIN_V, SEQ, WIN_BODY)
#undef WIN_NEXT
#undef WIN_K
#undef WIN_V
#undef WIN_BODY
        const float sc = g_win / fmaxf(la[0], 1e-30f);
        bf16_t* op = (bf16_t*)(wsp + WS_ONSA) + (rowbase + tokl) * 1536 + hd * 64 + 4 * h;
#pragma unroll
        for (int rq = 0; rq < 4; ++rq) {
            f32x4 f0, f1;
#pragma unroll
            for (int k = 0; k < 4; ++k) { f0[k] = FIN[(4 * rq + k) * 512] + o0[4 * rq + k] * sc; f1[k] = FIN[(16 + 4 * rq + k) * 512] + o1[4 * rq + k] * sc; }
            u32x2 w0; w0.x = cvtpk(f0[0], f0[1]); w0.y = cvtpk(f0[2], f0[3]); *(u32x2*)(op + 8 * rq) = w0;
            u32x2 w1; w1.x = cvtpk(f1[0], f1[1]); w1.y = cvtpk(f1[2], f1[3]); *(u32x2*)(op + 32 + 8 * rq) = w1; }
    }
#undef ATT_PIPE_BEGIN
#undef ATT_PIPE_END
#undef ATT_PIPE2
    NSA_BAR();
#ifdef PROBE_MODE
    if (blockIdx.x == 0 && L == 0 && qb == PROBE_QB && tid == PROBE_TID) { const unsigned tt = (unsigned)__builtin_readcyclecounter() - pr_t0; float* pp = (float*)(wsp + WS_CTL + 16384);
        pp[0] = PROBE_MODE == 1 ? (float)pr_bar / (float)tt : (float)tt * (1.0f / 2000000.0f); }
#endif
}


constexpr int CMP_AP = 2056;
__device__ __forceinline__ void compress_unit(const Args& a, unsigned char* wsp, int L, int u, LAS unsigned char* lds, int tid) {
    const int lane = tid & 63, wave = tid >> 6, q = lane >> 4, c16 = lane & 15;
    const int which = u >> 6, R0 = (u & 63) * 32;
    const bf16_t* A = (const bf16_t*)(wsp + WS_KV) + (size_t)which * KV_STRIDE + (size_t)R0 * 1024;
    const bf16_t* W1T = (const bf16_t*)(wsp + WS_W + (which ? W_W1V : W_W1K)); const bf16_t* W2T = (const bf16_t*)(wsp + WS_W + (which ? W_W2V : W_W2K));
    LAS bf16_t* AT = (LAS bf16_t*)lds; LAS float* BS = (LAS float*)(lds + 32 * CMP_AP * 2);
    const bf16_t* wb = W1T + (size_t)(32 * wave + c16) * 2048 + 8 * q;
    bf16x8 bq0[8], bq1[8];
#pragma unroll
    for (int i = 0; i < 8; ++i) { bq0[i] = *(const bf16x8*)(wb + 32 * i); bq1[i] = *(const bf16x8*)(wb + (size_t)16 * 2048 + 32 * i); }
#pragma unroll 4
    for (int p = 0; p < 16; ++p) { const int idx = p * NTHREADS + tid, row = idx >> 8, ch = (idx & 255) * 8; *(LAS u32x4*)(AT + row * CMP_AP + ch) = *(const u32x4*)(A + (size_t)row * 1024 + ch); }
    if (tid < 256) { const float* pp = (const float*)(wsp + WS_BIASP) + which * 32 * 256 + tid; float sacc = 0.f;
#pragma unroll 8
        for (int ks = 0; ks < 32; ++ks) sacc += pp[ks * 256];
        BS[tid] = sacc; }
    __syncthreads();
    f32x4 acc[2][2];
#pragma unroll
    for (int mt = 0; mt < 2; ++mt)
#pragma unroll
        for (int nt = 0; nt < 2; ++nt) acc[mt][nt] = (f32x4){0.f, 0.f, 0.f, 0.f};
    bf16x8 bn0[8], bn1[8];
#pragma unroll 1
    for (int kb = 0; kb < 8; kb += 2) {
#pragma unroll
        for (int i = 0; i < 8; ++i) { bn0[i] = *(const bf16x8*)(wb + 32 * (8 * kb + 8 + i)); bn1[i] = *(const bf16x8*)(wb + (size_t)16 * 2048 + 32 * (8 * kb + 8 + i)); }
#pragma unroll
        for (int i = 0; i < 8; ++i) { const int ks = 8 * kb + i;
            const bf16x8 a0 = *(const LAS bf16x8*)(AT + c16 * CMP_AP + 32 * ks + 8 * q), a1 = *(const LAS bf16x8*)(AT + (16 + c16) * CMP_AP + 32 * ks + 8 * q);
            acc[0][0] = MFMA16(a0, bq0[i], acc[0][0]); acc[0][1] = MFMA16(a0, bq1[i], acc[0][1]); acc[1][0] = MFMA16(a1, bq0[i], acc[1][0]); acc[1][1] = MFMA16(a1, bq1[i], acc[1][1]); }
        if (kb + 2 < 8) {
#pragma unroll
            for (int i = 0; i < 8; ++i) { bq0[i] = *(const bf16x8*)(wb + 32 * (8 * kb + 16 + i)); bq1[i] = *(const bf16x8*)(wb + (size_t)16 * 2048 + 32 * (8 * kb + 16 + i)); } }
#pragma unroll
        for (int i = 0; i < 8; ++i) { const int ks = 8 * kb + 8 + i;
            const bf16x8 a0 = *(const LAS bf16x8*)(AT + c16 * CMP_AP + 32 * ks + 8 * q), a1 = *(const LAS bf16x8*)(AT + (16 + c16) * CMP_AP + 32 * ks + 8 * q);
            acc[0][0] = MFMA16(a0, bn0[i], acc[0][0]); acc[0][1] = MFMA16(a0, bn1[i], acc[0][1]); acc[1][0] = MFMA16(a1, bn0[i], acc[1][0]); acc[1][1] = MFMA16(a1, bn1[i], acc[1][1]); }
    }
    __syncthreads();
    LAS bf16_t* H = AT; constexpr int HP = 264;
#pragma unroll
    for (int mt = 0; mt < 2; ++mt)
#pragma unroll
        for (int nt = 0; nt < 2; ++nt) { const int col = 32 * wave + 16 * nt + c16; const float bia = BS[col];
#pragma unroll
            for (int j = 0; j < 4; ++j) H[(16 * mt + 4 * q + j) * HP + col] = (bf16_t)f2bf(gelu_tanh_fast(acc[mt][nt][j] + bia)); }
    __syncthreads();
    {   const int mt = wave & 1, nt2 = wave >> 1; f32x4 d = {0.f, 0.f, 0.f, 0.f};
#pragma unroll
        for (int ks = 0; ks < 8; ++ks) { const bf16x8 af = *(const LAS bf16x8*)(H + (16 * mt + c16) * HP + 32 * ks + 8 * q), bf = *(const bf16x8*)(W2T + (16 * nt2 + c16) * 256 + 32 * ks + 8 * q); d = MFMA16(af, bf, d); }
        bf16_t* out = (bf16_t*)(wsp + WS_KC + (which ? 256 * 1024 : 0));
#pragma unroll
        for (int j = 0; j < 4; ++j) { const int R = R0 + 16 * mt + 4 * q + j, col = 16 * nt2 + c16; const bf16_t hv = (bf16_t)f2bf(d[j]);
            if (!which) out[(size_t)R * 64 + col] = hv; else out[((size_t)(R >> 9) * 64 + col) * 512 + (R & 511)] = hv; } }
    __syncthreads();
}

__device__ __forceinline__ void mixers_p2(const Args& a, unsigned char* wsp, int L, LAS unsigned char* lds, int bid, int G, int wave0) {
    const int tid = tid_fresh(wave0);
#if HAVE_NSA
    for (int rep = 0; rep < NREP(12); ++rep) for (int u = bid; u < 128; u += G) compress_unit(a, wsp, L, u, lds, tid);
#endif
#if HAVE_SSD
    for (int rep = 0; rep < NREP(16); ++rep) for (int u = bid; u < 256; u += G) ssd_a_unit(a, wsp, L, u, lds, tid);
#endif
#if HAVE_LRU
    if (G == 256) { if (bid >= 128) { for (int rep = 0; rep < NREP(17); ++rep) { lru_tile<false>(a, wsp, L, bid - 128, lds, tid); lru_tile<false>(a, wsp, L, bid, lds, tid); } } }
    else for (int rep = 0; rep < NREP(17); ++rep) for (int u = bid; u < 256; u += G) lru_tile<false>(a, wsp, L, u, lds, tid);
#endif
}
__device__ __forceinline__ void mixers_p3(const Args& a, unsigned char* wsp, int L, LAS unsigned char* lds, int bid, int G, int wave0) {
    const int tid = tid_fresh(wave0);
#if HAVE_NSA
    for (int rep = 0; rep < NREP(3); ++rep)
    for (int pr0 = bid; pr0 < 256; pr0 += G) { const int pr = (G == 256) ? ((pr0 & 7) * 32 + (pr0 >> 3)) : pr0;
        const int bgp = pr >> 6, i = pr & 63; nsa_unit(a, wsp, L, bgp, 127 - i, lds, tid); nsa_unit(a, wsp, L, bgp, i, lds, tid); }
#endif
#if HAVE_SSD
    {   const int tid2 = tid_fresh(wave0); for (int gid = bid * NTHREADS + tid2; gid < 131072; gid += G * NTHREADS) ssd_scan2(a, wsp, gid, tid2 & 63); }
#endif
#if HAVE_LRU
    {   const int tid3 = tid_fresh(wave0); for (int gid = bid * NTHREADS + tid3; gid < 4096; gid += G * NTHREADS) lru_carry4(a, wsp, gid, tid3 & 63); }
#endif
}
__device__ __forceinline__ void mixers_p4(const Args& a, unsigned char* wsp, int L, LAS unsigned char* lds, int bid, int G, int wave0) {
    const int tid = tid_fresh(wave0);
#if HAVE_SSD
    for (int rep = 0; rep < NREP(18); ++rep) for (int u = bid; u < 256; u += G) ssd_b_unit(a, wsp, L, u, lds, tid);
#endif
#if HAVE_LRU
    for (int rep = 0; rep < NREP(19); ++rep) for (int u = bid; u < 256; u += G) lru_tile<true>(a, wsp, L, u, lds, tid);
#endif
}
#ifndef PH_MASK
#define PH_MASK 0xFFFF
#endif
#define PHON(k) (((PH_MASK) >> (k)) & 1)
#ifdef PHASE_PROBE
#define PROBE_SEL int
#define PROBE_OFF 20480
#else
#define PROBE_SEL int
#define PROBE_OFF 16384
#endif
#ifndef MIXERS
#define MIXERS 1
#endif
constexpr int PH_PER_LAYER = 10, N_PHASES = 1 + PH_PER_LAYER * DEPTH;

#define FRESH() int G = G0, bid = bid0; asm volatile("" : "+s"(G), "+s"(bid)); GAS_ unsigned char* wsg_ = (GAS_ unsigned char*)a.ws; asm volatile("" : "+s"(wsg_)); unsigned char* ws = (unsigned char*)wsg_; GAS_ float* xfg_ = (GAS_ float*)a.out; asm volatile("" : "+s"(xfg_)); float* XF = (float*)xfg_;     bf16_t* XB = (bf16_t*)(ws + WS_XB); bf16_t* PB = (bf16_t*)(ws + WS_PB); unsigned char* W = ws + WS_W; unsigned* MCNT = (unsigned*)(ws + WS_CTL + CTL_MOECNT) + (L < 0 ? 0 : L) * 1024; (void)XB; (void)PB; (void)W; (void)MCNT; (void)XF;
#define RUN(k) (lo <= (k) && (k) < hi)
#ifdef PHASE_PROBE
#define PSTAMP(slot) do { if ((slot) != PHASE_PROBE_A && (slot) != PHASE_PROBE_B) break; int b0_ = bid0 | wave0; asm volatile("" : "+s"(b0_)); if (b0_ == 0) { unsigned m_ = ~0u; asm volatile("" : "+s"(m_)); if (__builtin_amdgcn_mbcnt_hi(m_, __builtin_amdgcn_mbcnt_lo(m_, 0u)) == 0u) ((unsigned long long*)(a.ws + WS_CTL + 20480))[(slot)] = __builtin_readcyclecounter(); } } while (0)
#else
#define PSTAMP(slot) do { } while (0)
#endif
#define SEAM(k) do { if (RUN(k) && RUN((k) + 1)) { PSTAMP(2 * (k)); for (int rep_ = 0; rep_ < NREP(15); ++rep_) { xcd_barrier((unsigned*)(a.ws + WS_CTL + 45056), (volatile LAS unsigned*)(lds + LDS_BYTES - 16), nbar, (unsigned)G0, wave0); } PSTAMP(2 * (k) + 1); } } while (0)
__device__ __forceinline__ void grid_barrier(unsigned* bar, unsigned target, int wave0) {
    asm volatile("s_waitcnt vmcnt(0) lgkmcnt(0)" ::: "memory");
    __syncthreads();
    if (wave0 == 0) {
        unsigned m = ~0u; asm volatile("" : "+s"(m));
        if (__builtin_amdgcn_mbcnt_hi(m, __builtin_amdgcn_mbcnt_lo(m, 0u)) == 0u) {
            __builtin_amdgcn_fence(__ATOMIC_RELEASE, "agent");
            asm volatile("s_waitcnt vmcnt(0)" ::: "memory");
            __hip_atomic_fetch_add(bar, 1u, __ATOMIC_RELAXED, __HIP_MEMORY_SCOPE_AGENT);
            unsigned spins = 0u;
            while (__hip_atomic_load(bar, __ATOMIC_RELAXED, __HIP_MEMORY_SCOPE_AGENT) < target) { __builtin_amdgcn_s_sleep(2); if (++spins > (1u << 27)) break; }
            __builtin_amdgcn_fence(__ATOMIC_ACQUIRE, "agent");
            asm volatile("s_waitcnt vmcnt(0)" ::: "memory");
        }
    }
    __syncthreads();
}
#define XB_TMO      128
#define XB_XCNT(j)  (256  + 64 * (j))
#define XB_XSUB(j)  (1280 + 64 * (j))
#define XB_XGEN(j)  (2304 + 64 * (j))
#define XB_TOP      3328
#define XB_TOPGEN   3392
#define XB_SPIN_CAP (1u << 22)
__device__ __forceinline__ unsigned xb_ld(unsigned* p) { return __hip_atomic_load(p, __ATOMIC_RELAXED, __HIP_MEMORY_SCOPE_AGENT); }
__device__ __forceinline__ unsigned xb_add(unsigned* p, unsigned v) { return __hip_atomic_fetch_add(p, v, __ATOMIC_RELAXED, __HIP_MEMORY_SCOPE_AGENT); }
__device__ __forceinline__ unsigned xb_xcc_id() { return (unsigned)__builtin_amdgcn_s_getreg((3 << 11) | 20) & 0xFu; }
#define XB_SPIN(cond, bar) do { unsigned _sp = 0; while (cond) { __builtin_amdgcn_s_sleep(1); if ((++_sp & 255u) == 0u) { if (xb_ld(&(bar)[XB_TMO])) break; if (_sp > XB_SPIN_CAP) { atomicAdd(&(bar)[XB_TMO], 1u); break; } } } } while (0)
__device__ __forceinline__ void xcd_barrier(unsigned* bar, volatile LAS unsigned* st, unsigned x, unsigned G, int wave0) {
    asm volatile("s_waitcnt vmcnt(0) lgkmcnt(0)" ::: "memory");
    __syncthreads();
    if (wave0 == 0) {
        unsigned m = ~0u; asm volatile("" : "+s"(m));
        if (__builtin_amdgcn_mbcnt_hi(m, __builtin_amdgcn_mbcnt_lo(m, 0u)) == 0u) {
            unsigned nloc = st[0], nx = st[1];
            if (nloc == 0u) {
                unsigned sum, cnt, mine, sp = 0u;
                for (;;) { sum = 0u; cnt = 0u; mine = 0u;
#pragma unroll
                    for (unsigned j = 0; j < 16; ++j) { const unsigned c = xb_ld(&bar[XB_XCNT(j)]); sum += c; cnt += (c > 0u) ? 1u : 0u; mine = (j == x) ? c : mine; }
                    if (sum == G) break;
                    __builtin_amdgcn_s_sleep(1);
                    if ((++sp & 255u) == 0u) { if (xb_ld(&bar[XB_TMO])) break; if (sp > XB_SPIN_CAP) { atomicAdd(&bar[XB_TMO], 1u); break; } } }
                nloc = mine > 0u ? mine : 1u; nx = cnt > 0u ? cnt : 1u; st[0] = nloc; st[1] = nx; }
            const unsigned old = xb_add(&bar[XB_XSUB(x)], 1u), gen = old / nloc;
            if (old + 1u == (gen + 1u) * nloc) {
                __builtin_amdgcn_fence(__ATOMIC_RELEASE, "agent");
                asm volatile("s_waitcnt vmcnt(0)" ::: "memory");
                const unsigned og = xb_add(&bar[XB_TOP], 1u), tg = og / nx;
                if (og + 1u == (tg + 1u) * nx) xb_add(&bar[XB_TOPGEN], 1u);
                else XB_SPIN(xb_ld(&bar[XB_TOPGEN]) == tg, bar);
                __builtin_amdgcn_fence(__ATOMIC_ACQUIRE, "agent");
                xb_add(&bar[XB_XGEN(x)], 1u);
                asm volatile("s_waitcnt vmcnt(0)" ::: "memory");
            } else {
                XB_SPIN(xb_ld(&bar[XB_XGEN(x)]) == gen, bar);
                __builtin_amdgcn_fence(__ATOMIC_ACQUIRE, "agent");
                asm volatile("s_waitcnt vmcnt(0)" ::: "memory");
            }
        }
    }
    __syncthreads();
}
template <int L>
__device__ __forceinline__ void layer_phases(const Args& a, LAS unsigned char* lds, unsigned& nbar, const int G0, const int bid0, const int wave0, const int lo, const int hi) {
        const int P = 1 + PH_PER_LAYER * L;
      if constexpr (L >= 0) {
        if (PHON(1) && RUN(P + 0)) { FRESH();
            pg8::Gemm g{XB, (const bf16_t*)(W + W_WIN), TOK, 3840, 1024, 1024, 1024}; pg8::StaticOrder S; S.init(TOK, 3840, G, bid);
            pg8::EpiInProj E{(bf16_t*)(ws + WS_Q), (bf16_t*)(ws + WS_KV), (bf16_t*)(ws + WS_Z), (bf16_t*)(ws + WS_XBC), (bf16_t*)(ws + WS_LX), (bf16_t*)(ws + WS_LY), (float*)(ws + WS_SMALL), KV_STRIDE};
            for (int rep = 0; rep < NREP(1); ++rep) pg8::gemm_phase<pg8::EpiInProj, pg8::StaticOrder, true, true>(lds, g, S, E, wave0);
        }
        SEAM(P + 0);
#if MIXERS
        if (PHON(2) && RUN(P + 1)) { FRESH(); for (int rep = 0; rep < NREP(2); ++rep) mixers_p2(a, ws, L, lds, bid, G, wave0); }
        SEAM(P + 1);
        if (PHON(3) && RUN(P + 2)) { FRESH(); mixers_p3(a, ws, L, lds, bid, G, wave0); }
        SEAM(P + 2);
        if (PHON(4) && RUN(P + 3)) { FRESH(); for (int rep = 0; rep < NREP(4); ++rep) mixers_p4(a, ws, L, lds, bid, G, wave0); }
        SEAM(P + 3);
        if (PHON(5) && RUN(P + 4)) { FRESH();
            pg8::StaticOrder S4; S4.init(TOK, 1024, G, bid); pg8::Unit base;
            for (int rep = 0; rep < NREP(5); ++rep)
            for (int j = 0; S4.next(j, base); ++j) {
                {   pg8::Gemm g{XB, (const bf16_t*)(W + W_WIN) + (size_t)3840 * 1024, TOK, 3072, 1024, 1024, 1024}; pg8::StrideOrder S{base.pm, base.pn, 4, 3};
                    pg8::EpiSigBf16 E{(bf16_t*)(ws + WS_MERGE), 3072};
                    pg8::gemm_phase<pg8::EpiSigBf16, pg8::StrideOrder, true, true>(lds, g, S, E, wave0); }
                {   pg8::Gemm g{(const bf16_t*)(ws + WS_ONSA), (const bf16_t*)(W + W_PROJ), TOK, 1024, 1536, 1536, 1536}; pg8::StrideOrder S{base.pm, base.pn, 0, 1};
                    pg8::EpiMixK E{(bf16_t*)(ws + WS_MIXB), (const bf16_t*)(ws + WS_MERGE), (const float*)(ws + WS_SSQ)};
                    pg8::gemm_phase<pg8::EpiMixK, pg8::StrideOrder, true, true>(lds, g, S, E, wave0); }
            }
        }
        SEAM(P + 4);
        if (PHON(6) && RUN(P + 5)) { FRESH();
            pg8::Gemm g{(const bf16_t*)(ws + WS_MIXB), (const bf16_t*)(W + W_WOUT), TOK, 1024, 1024, 1024, 1024}; pg8::StaticOrder S; S.init(TOK, 1024, G, bid);
            pg8::EpiResid E{XB, XF, ALPHA};
            pg8::gemm_phase<pg8::EpiResid, pg8::StaticOrder, true, true>(lds, g, S, E, wave0);
        }
        SEAM(P + 5);
#else
        if (PHON(6) && RUN(P + 5)) { FRESH();
            const float* xin = L == 0 ? a.in[0] : (const float*)XF;
            const int tid = tid_fresh(wave0); for (size_t i = (size_t)bid * NTHREADS + tid; i < (size_t)TOK * 256; i += (size_t)G * NTHREADS) { const f32x4 v = *(const f32x4*)(xin + 4 * i); *(f32x4*)(XF + 4 * i) = v * ALPHA; }
        }
        SEAM(P + 5);
#endif
        if (PHON(7) && RUN(P + 6)) { FRESH(); ln_rows<true, false, false>(XF, a.in[26] + L * 1024, a.in[27] + L * 1024, XB, a.in[28], a.in[29], (int*)(ws + WS_ELIST), (float*)(ws + WS_EW), MCNT, nullptr, nullptr, lds, bid, G, wave0); }
        SEAM(P + 6);
        if (PHON(8) && RUN(P + 7)) { FRESH();
            {   pg8::Unit u;
                LAS int* NT = (LAS int*)(lds + pg8::STAGE_BYTES); LAS unsigned short* TT = (LAS unsigned short*)(lds + pg8::STAGE_BYTES + 64);
                LAS int* CN = (LAS int*)(lds + pg8::STAGE_BYTES + 512); LAS int* ELS = (LAS int*)(lds + pg8::STAGE_BYTES + 1024);
                unsigned* DONE = (unsigned*)(ws + WS_CTL + 40960) + L * 512;
                if (wave0 == 0) {
                    unsigned m_ = ~0u; asm volatile("" : "+s"(m_)); const unsigned ln0_ = __builtin_amdgcn_mbcnt_hi(m_, __builtin_amdgcn_mbcnt_lo(m_, 0u));
                    const int cmine = (int)__hip_atomic_load(MCNT + (ln0_ & 15u) * 64, __ATOMIC_RELAXED, __HIP_MEMORY_SCOPE_AGENT);
                    if (ln0_ < 16u) CN[ln0_] = cmine;
                    int ts = 0;
#pragma unroll
                    for (int e = 0; e < 16; ++e) { const int ce = __builtin_amdgcn_readlane(cmine, e), nt = (ce + 255) >> 8;
                        if (ln0_ == 0u) {
#pragma unroll 1
                            for (int j = 0; j < nt; ++j) TT[ts + j] = (unsigned short)(e | (j << 8)); }
                        ts += nt; }
                    if (ln0_ == 0u) NT[0] = ts; }
                __syncthreads();
                const int ntile = __builtin_amdgcn_readfirstlane(NT[0]), nmoe = 2 * ntile, nall = nmoe + 256 + 4 * ntile;
                unsigned* ticket = (unsigned*)(ws + WS_CTL + 24576) + L * 64;
#define TW_() ({ int o_ = LDS_BYTES - 32; asm volatile("" : "+s"(o_)); (volatile LAS int*)(lds + o_); })
                for (;;) {
                    __syncthreads();
                    if (wave0 == 0) { unsigned m_ = ~0u; asm volatile("" : "+s"(m_)); if (__builtin_amdgcn_mbcnt_hi(m_, __builtin_amdgcn_mbcnt_lo(m_, 0u)) == 0u) TW_()[0] = (int)__hip_atomic_fetch_add(ticket, 1u, __ATOMIC_RELAXED, __HIP_MEMORY_SCOPE_AGENT); }
                    __syncthreads();
                    const int t = __builtin_amdgcn_readfirstlane(TW_()[0]);
                    if (t >= nall) break;
                    if (t < nmoe) {
                        const int T = t >> 1, te = __builtin_amdgcn_readfirstlane((int)TT[T]), ee = te & 255, jj = te >> 8;
                        u.pm = ee * 64 + jj; u.pn = 2 * ee + (t & 1); u.pk = 0; u.aux = T;
                        pg8::Gemm g{XB, (const bf16_t*)(W + W_WGU), TOK, 8192, 1024, 1024, 1024, (const int*)(ws + WS_ELIST), MCNT}; pg8::OneUnit S{u};
                        pg8::EpiMoeUp2 E{(bf16_t*)(ws + WS_H2), (const float*)(ws + WS_EW)};
                        pg8::gemm_phase<pg8::EpiMoeUp2, pg8::OneUnit, true, true, true>(lds, g, S, E, wave0);
                        asm volatile("s_waitcnt vmcnt(0) lgkmcnt(0)" ::: "memory");
                        __syncthreads();
                        if (wave0 == 0) { unsigned m_ = ~0u; asm volatile("" : "+s"(m_)); if (__builtin_amdgcn_mbcnt_hi(m_, __builtin_amdgcn_mbcnt_lo(m_, 0u)) == 0u) {
                            const int T2 = __builtin_amdgcn_readfirstlane(TW_()[0]) >> 1;
                            __builtin_amdgcn_fence(__ATOMIC_RELEASE, "agent"); asm volatile("s_waitcnt vmcnt(0)" ::: "memory");
                            (void)xb_add(DONE + T2, 1u); } }
                    } else if (t < nmoe + 256) {
                        const int tile = t - nmoe; pg8::StrideOrder S{tile >> 2, tile & 3, 0, 1};
                        {   pg8::Gemm g{XB, (const bf16_t*)(W + W_PLEG), TOK, 1024, 1024, 1024, 1024}; pg8::EpiSigNat E{(bf16_t*)(ws + WS_SG), XF};
                            pg8::gemm_phase<pg8::EpiSigNat, pg8::StrideOrder, true, true>(lds, g, S, E, wave0); }
                        {   pg8::Gemm g{PB, (const bf16_t*)(W + W_PLEP), TOK, 1024, 256, 256, 256}; pg8::EpiPleProj E{(bf16_t*)(ws + WS_SG)};
                            pg8::gemm_phase<pg8::EpiPleProj, pg8::StrideOrder, true, true>(lds, g, S, E, wave0); }
                    } else {
                        const int k = t - nmoe - 256, T = k >> 2, te = __builtin_amdgcn_readfirstlane((int)TT[T]), ee = te & 255, jj = te >> 8;
                        if (wave0 == 0) { unsigned m_ = ~0u; asm volatile("" : "+s"(m_)); if (__builtin_amdgcn_mbcnt_hi(m_, __builtin_amdgcn_mbcnt_lo(m_, 0u)) == 0u) {
                            unsigned* bar = (unsigned*)(ws + WS_CTL + 45056);
                            XB_SPIN(xb_ld(DONE + T) < 2u, bar);
                            __builtin_amdgcn_fence(__ATOMIC_ACQUIRE, "agent"); asm volatile("s_waitcnt vmcnt(0)" ::: "memory"); } }
                        __syncthreads();
                        u.pm = T; u.pn = k & 3; u.pk = ee * 256; u.aux = ee * 64 + jj;
                        pg8::Gemm g{(const bf16_t*)(ws + WS_H2), (const bf16_t*)(W + W_WD), TOK, 1024, 256, 256, 4096}; pg8::OneUnit S{u};
                        pg8::EpiMoeDown E{(bf16_t*)(ws + WS_Y), (const int*)(ws + WS_ELIST), (unsigned)__builtin_amdgcn_readfirstlane(CN[ee])};
                        pg8::gemm_phase<pg8::EpiMoeDown, pg8::OneUnit, true, true>(lds, g, S, E, wave0);
                    }
                }
            }
        }
        SEAM(P + 7);
      }
        if (PHON(10) && RUN(P + 9)) { FRESH();
            if (L >= 0) { ln_rows<false, true, (L == DEPTH - 1)>(XF, a.in[35] + L * 1024, a.in[36] + L * 1024, XB, nullptr, nullptr, nullptr, nullptr, nullptr, (const bf16_t*)(ws + WS_Y), (const bf16_t*)(ws + WS_SG), lds, bid, G, wave0,
#if defined(PROBE_MODE) || defined(PHASE_PROBE)
                (L == DEPTH - 1) ? (const float*)(ws + WS_CTL + (sizeof(PROBE_SEL) ? PROBE_OFF : 0)) : nullptr
#else
                nullptr
#endif
                ); __syncthreads(); }
            else cvt_rows(a.in[0], XB, (size_t)TOK * 1024, bid, G, wave0);
            if (L + 1 < DEPTH) { for (int rep = 0; rep < NREP(10); ++rep) convert_weights(a, ws, L + 1, lds, bid, G, wave0); cvt_rows(a.in[1] + (size_t)(L + 1) * TOK * 256, PB, (size_t)TOK * 256, bid, G, wave0); }
        }
        if (L + 1 < DEPTH) SEAM(P + 9);
}
#undef RUN
#undef SEAM
#undef FRESH

__global__ void __launch_bounds__(NTHREADS, 2) fwd_kernel(Args a) {
    extern __shared__ __attribute__((aligned(16))) unsigned char lds_raw[];
    LAS unsigned char* lds = (LAS unsigned char*)lds_raw;
    const int G0 = gridDim.x, bid0 = blockIdx.x, wave0 = __builtin_amdgcn_readfirstlane(threadIdx.x >> 6);
    const int lo = a.ph_lo, hi = a.ph_hi;
    if (hi - lo > 1) { cg::grid_group grid = cg::this_grid(); grid.sync(); }
    unsigned nbar = xb_xcc_id();
    if (wave0 == 0) { unsigned m = ~0u; asm volatile("" : "+s"(m));
        if (__builtin_amdgcn_mbcnt_hi(m, __builtin_amdgcn_mbcnt_lo(m, 0u)) == 0u) { volatile LAS unsigned* st = (volatile LAS unsigned*)(lds + LDS_BYTES - 16); st[0] = 0u; st[1] = 0u;
            (void)xb_add((unsigned*)(a.ws + WS_CTL + 45056) + XB_XCNT(nbar), 1u); } }
    __syncthreads();
    layer_phases<-1>(a, lds, nbar, G0, bid0, wave0, lo, hi);
    layer_phases<0>(a, lds, nbar, G0, bid0, wave0, lo, hi);
    layer_phases<1>(a, lds, nbar, G0, bid0, wave0, lo, hi);
    static_assert(DEPTH == 2, "layer_phases instantiations");
}

extern "C" void kernel_launch(void* const* d_in, const int* in_sizes, int n_in, void* d_out, int out_size, void* d_ws, size_t ws_size, hipStream_t stream) {
    static int grid = 0;
    if (grid == 0) {
        if (n_in != 37 || out_size != TOK * D_MODEL || ws_size < WS_END) { fprintf(stderr, "kernel_launch: unexpected shapes (n_in %d, out %d, ws %zu < %zu)\n", n_in, out_size, ws_size, (size_t)WS_END); grid = -1; return; }
        int dev = 0, cus = 0, per_cu = 0;
        hipGetDevice(&dev); hipDeviceGetAttribute(&cus, hipDeviceAttributeMultiprocessorCount, dev);
        if (hipFuncSetAttribute((const void*)fwd_kernel, hipFuncAttributeMaxDynamicSharedMemorySize, LDS_BYTES) != hipSuccess) { fprintf(stderr, "kernel_launch: hipFuncSetAttribute failed\n"); grid = -1; return; }
        if (hipOccupancyMaxActiveBlocksPerMultiprocessor(&per_cu, (const void*)fwd_kernel, NTHREADS, LDS_BYTES) != hipSuccess || per_cu < 1) { fprintf(stderr, "kernel_launch: occupancy query says %d blocks per CU\n", per_cu); grid = -1; return; }
        (void)hipGetLastError();
        grid = cus;
    }
    if (grid < 0) return;
    hipMemsetAsync((char*)d_ws + WS_CTL, 0, CTL_ZERO_BYTES, stream);
    Args a{};
    for (int i = 0; i < 37; ++i) a.in[i] = (const float*)d_in[i];
    a.out = (float*)d_out; a.ws = (unsigned char*)d_ws;
#ifndef N_LAUNCH_SPLIT
    a.ph_lo = 0; a.ph_hi = N_PHASES;
    void* args[] = {&a};
    hipError_t e = hipLaunchCooperativeKernel((const void*)fwd_kernel, dim3(grid), dim3(NTHREADS), args, LDS_BYTES, stream);
    if (e != hipSuccess) fprintf(stderr, "cooperative launch failed: %s (grid %d)\n", hipGetErrorString(e), grid);
#else
    for (int p = 0; p < N_PHASES; ++p) { a.ph_lo = p; a.ph_hi = p + 1; void* args[] = {&a};
        hipError_t e = hipLaunchCooperativeKernel((const void*)fwd_kernel, dim3(grid), dim3(NTHREADS), args, LDS_BYTES, stream);
        if (e != hipSuccess) { fprintf(stderr, "launch %d failed: %s\n", p, hipGetErrorString(e)); break; } }
#endif
}
```

```cpp
#include <hip/hip_runtime.h>
#include <hip/hip_cooperative_groups.h>
#include <cstdio>
#include <cstdint>
namespace cg = cooperative_groups;

#define LAS __attribute__((address_space(3)))
#define GAS_ __attribute__((address_space(1)))
typedef unsigned short bf16_t;
typedef short bf16x8 __attribute__((ext_vector_type(8)));
typedef float f32x4 __attribute__((ext_vector_type(4)));
typedef float f32x2 __attribute__((ext_vector_type(2)));
typedef unsigned u32x4 __attribute__((ext_vector_type(4)));
typedef unsigned u32x2 __attribute__((ext_vector_type(2)));

constexpr int D_MODEL = 1024, BATCH = 2, SEQ = 8192, DEPTH = 2, TOK = BATCH * SEQ;
constexpr int PLE_DIM = 256;
constexpr int IN_WIDTH = 6688;
constexpr int N_EXPERTS = 16, D_EXPERT = 256;
constexpr float ALPHA = 1.4142135623730951f;
constexpr float LN_EPS = 1e-5f, RMS_EPS = 1e-5f;
constexpr int NWAVES = 8, NTHREADS = 512;

__device__ __forceinline__ float bf2f(unsigned h) { return __uint_as_float(h << 16); }
typedef __bf16 bf16x2_hw __attribute__((ext_vector_type(2)));
__device__ __forceinline__ unsigned cvtpk(float lo, float hi) { f32x2 v = {lo, hi}; bf16x2_hw b = __builtin_convertvector(v, bf16x2_hw); return __builtin_bit_cast(unsigned, b); }
__device__ __forceinline__ unsigned f2bf(float f) { return cvtpk(f, 0.f) & 0xffffu; }
__device__ __forceinline__ unsigned pk2(float lo, float hi) { return cvtpk(lo, hi); }
__device__ __forceinline__ float sigmoidf_(float x) { return 1.0f / (1.0f + __expf(-x)); }
__device__ __forceinline__ float siluf_(float x) { return x / (1.0f + __expf(-x)); }
__device__ __forceinline__ float gelu_tanh(float x) { const float u = 0.7978845608028654f * (x + 0.044715f * x * x * x); const float t = 1.0f - 2.0f / (1.0f + __expf(2.0f * u)); return 0.5f * x * (1.0f + t); }
__device__ __forceinline__ float softplusf_(float x) { return x > 20.f ? x : log1pf(__expf(x)); }
__device__ __forceinline__ int shxi(int v, int o, int lane) {
    switch (o) {
        case 1: return __builtin_amdgcn_ds_swizzle(v, 0x1f | (1 << 10));
        case 2: return __builtin_amdgcn_ds_swizzle(v, 0x1f | (2 << 10));
        case 4: return __builtin_amdgcn_ds_swizzle(v, 0x1f | (4 << 10));
        case 8: return __builtin_amdgcn_ds_swizzle(v, 0x1f | (8 << 10));
        case 16: return __builtin_amdgcn_ds_swizzle(v, 0x1f | (16 << 10));
        default: { auto rr = __builtin_amdgcn_permlane32_swap((unsigned)v, (unsigned)v, false, false); return (int)(lane >= 32 ? rr[0] : rr[1]); }
    }
}
__device__ __forceinline__ float shx(float v, int o, int lane) { return __int_as_float(shxi(__float_as_int(v), o, lane)); }
#define dpp_f(v, ctrl) __int_as_float(__builtin_amdgcn_update_dpp(0, __float_as_int(v), (ctrl), 0xf, 0xf, false))
__device__ __forceinline__ float wave_sum(float v, int lane) {
    v += dpp_f(v, 0xB1); v += dpp_f(v, 0x4E); v += dpp_f(v, 0x141); v += dpp_f(v, 0x140);
    v += shx(v, 16, lane); v += shx(v, 32, lane);
    return v;
}
__device__ __forceinline__ float wave_max(float v, int lane) {
#pragma unroll
    for (int o = 1; o < 64; o <<= 1) v = fmaxf(v, shx(v, o, lane));
    return v;
}
__device__ __forceinline__ int tid_fresh(int wave0) { unsigned m = ~0u; asm volatile("" : "+s"(m)); const int l = (int)__builtin_amdgcn_mbcnt_hi(m, __builtin_amdgcn_mbcnt_lo(m, 0u)); return wave0 * 64 + l; }
#ifndef DUP_MASK
#define DUP_MASK 0
#endif
#define NREP(k) ((((DUP_MASK) >> (k)) & 1) ? 2 : 1)
namespace pg8 {
#define PG8_LAS __attribute__((address_space(3)))
typedef unsigned short bf16_t;
typedef short bf16x8 __attribute__((ext_vector_type(8)));
typedef float f32x4 __attribute__((ext_vector_type(4)));
typedef unsigned u32x4 __attribute__((ext_vector_type(4)));
constexpr int BM = 256, BK = 64, HALF = 128, HTB = HALF * BK * 2  , STAGE_BYTES = 8 * HTB, NXCD = 8, WGM = 8;

__host__ __device__ __forceinline__ int lds_byte(int r, int c) { const int st = (r >> 4) * 2 + (c >> 5), rr = r & 15, cc = c & 31, ob = rr * 64 + cc * 2; return st * 1024 + (ob ^ (((ob >> 9) & 1) << 5)); }
__host__ __device__ __forceinline__ void stage_rc(int b, int& R, int& C) { const int st = b / 1024, sb = b % 1024, swz = sb ^ (((sb >> 9) & 1) << 5); R = (st >> 1) * 16 + swz / 64; C = (st & 1) * 32 + (swz % 64) / 2; }
__host__ __device__ __forceinline__ int perm32(int rho) { const int n = rho >> 4, i = rho & 15; return 8 * (i >> 2) + 4 * n + (i & 3); }

struct Unit { int pm, pn, pk, aux; };
struct Gemm { const bf16_t* A; const bf16_t* Bt; int M, N, K, lda, ldb; const int* glist; const unsigned* gcnt; };

struct StaticOrder {
    int nM, nN, nwg, G, c;
    __host__ __device__ __forceinline__ void init(int M, int N, int G_, int c_) { nM = M / BM; nN = N / BM; nwg = nM * nN; G = G_; c = c_; }
    __host__ __device__ __forceinline__ bool next(int i, Unit& u) const {
        const long L = (long)i * G + c; if (L >= nwg) return false;
        int wgid = (int)L; { const int q = nwg / NXCD, r = nwg % NXCD, xcd = wgid % NXCD, off = wgid / NXCD; wgid = (xcd < r ? xcd * (q + 1) : r * (q + 1) + (xcd - r) * q) + off; }
        const int nig = WGM * nN, gid = wgid / nig, fm = gid * WGM, gsz = (nM - fm) < WGM ? (nM - fm) : WGM;
        u.pm = fm + ((wgid % nig) % gsz); u.pn = (wgid % nig) / gsz; u.pk = 0; u.aux = 0; return true;
    }
    __device__ __forceinline__ void a_ready(const Unit&) const {}
    __device__ __forceinline__ void done(const Unit&) const {}
};

__device__ __forceinline__ int lane_fresh() { unsigned m = ~0u; asm volatile("" : "+s"(m)); return (int)__builtin_amdgcn_mbcnt_hi(m, __builtin_amdgcn_mbcnt_lo(m, 0u)); }
typedef __bf16 bf16x2_t_ __attribute__((ext_vector_type(2)));
__device__ __forceinline__ unsigned cvt_pk_bf16(float lo, float hi) { f32x2 v = {lo, hi}; bf16x2_t_ b = __builtin_convertvector(v, bf16x2_t_); return __builtin_bit_cast(unsigned, b); }
__device__ __forceinline__ u32x4 pack8(const f32x4 a, const f32x4 b) { u32x4 w; w.x = cvt_pk_bf16(a[0], a[1]); w.y = cvt_pk_bf16(a[2], a[3]); w.z = cvt_pk_bf16(b[0], b[1]); w.w = cvt_pk_bf16(b[2], b[3]); return w; }
__device__ __forceinline__ void unpack8(const u32x4 w, f32x4& a, f32x4& b) {
    a[0] = __uint_as_float(w.x << 16); a[1] = __uint_as_float(w.x & 0xffff0000u); a[2] = __uint_as_float(w.y << 16); a[3] = __uint_as_float(w.y & 0xffff0000u);
    b[0] = __uint_as_float(w.z << 16); b[1] = __uint_as_float(w.z & 0xffff0000u); b[2] = __uint_as_float(w.w << 16); b[3] = __uint_as_float(w.w & 0xffff0000u); }
__device__ __forceinline__ f32x4 sig4(const f32x4 v) { f32x4 o; o[0] = __builtin_amdgcn_rcpf(1.f + __expf(-v[0])); o[1] = __builtin_amdgcn_rcpf(1.f + __expf(-v[1])); o[2] = __builtin_amdgcn_rcpf(1.f + __expf(-v[2])); o[3] = __builtin_amdgcn_rcpf(1.f + __expf(-v[3])); return o; }

struct EpiInProj {
    static constexpr bool PERM = true, AFTER_DRAIN = false, MIDHOOK = false;
    bf16_t *Q, *KV, *Z, *XBC, *LX, *LY; float* SMALL; size_t kvstride;
    __device__ __forceinline__ void operator()(const f32x4 (&acc)[2][2][4][2], const Unit& u, int wr, int wc, int, int) const { const int ln_ = lane_fresh(), fr = ln_ & 15, fq = ln_ >> 4;
        const int pn = u.pn, row0 = u.pm * BM + wr * 64 + fr, cw = wc * 32 + 8 * fq;
        if (pn >= 2 && pn < 5) {
            const int g = cw >> 6, d = cw & 63;
#pragma unroll
            for (int bj = 0; bj < 2; ++bj) { bf16_t* base = KV + (size_t)((pn - 2) * 2 + bj) * kvstride;
                if (bj == 1 && pn >= 3) {
#pragma unroll
                    for (int ai = 0; ai < 2; ++ai)
#pragma unroll
                        for (int m = 0; m < 4; ++m) { const int r = row0 + ai * HALF + m * 16, b = r >> 13, s = r & (SEQ - 1); const u32x4 w = pack8(acc[ai][bj][m][0], acc[ai][bj][m][1]);
                            bf16_t* tp = base + ((size_t)((b * 2 + g) * 64 + d)) * SEQ + s;
                            tp[0] = (bf16_t)(w.x & 0xffffu); tp[SEQ] = (bf16_t)(w.x >> 16); tp[2 * SEQ] = (bf16_t)(w.y & 0xffffu); tp[3 * SEQ] = (bf16_t)(w.y >> 16);
                            tp[4 * SEQ] = (bf16_t)(w.z & 0xffffu); tp[5 * SEQ] = (bf16_t)(w.z >> 16); tp[6 * SEQ] = (bf16_t)(w.w & 0xffffu); tp[7 * SEQ] = (bf16_t)(w.w >> 16); }
                } else {
#pragma unroll
                for (int ai = 0; ai < 2; ++ai)
#pragma unroll
                    for (int m = 0; m < 4; ++m) { const int r = row0 + ai * HALF + m * 16, b = r >> 13, s = r & (SEQ - 1);
                        *(u32x4*)(base + ((size_t)((b * 2 + g) * SEQ + s)) * 64 + d) = pack8(acc[ai][bj][m][0], acc[ai][bj][m][1]); } } }
        } else if (pn == 14) {
            if (wc == 0) {
#pragma unroll
                for (int ai = 0; ai < 2; ++ai)
#pragma unroll
                    for (int m = 0; m < 4; ++m) { const int r = row0 + ai * HALF + m * 16; float* p = SMALL + (size_t)r * 32 + 8 * fq;
                        *(f32x4*)p = acc[ai][0][m][0]; *(f32x4*)(p + 4) = acc[ai][0][m][1]; } }
        } else {
            bf16_t* dst; int pitch, cb; float qs = 1.0f;
            if (pn < 2) { dst = Q; pitch = 512; cb = pn * 256; qs = 0.18033688011112042f; }
            else if (pn < 7) { dst = Z; pitch = 512; cb = (pn - 5) * 256; }
            else if (pn < 10) { dst = XBC; pitch = 768; cb = (pn - 7) * 256; }
            else if (pn < 12) { dst = LX; pitch = 512; cb = (pn - 10) * 256; }
            else { dst = LY; pitch = 512; cb = (pn - 12) * 256; }
#pragma unroll
            for (int ai = 0; ai < 2; ++ai)
#pragma unroll
                for (int m = 0; m < 4; ++m) { bf16_t* rowp = dst + (size_t)(row0 + ai * HALF + m * 16) * pitch + cb + cw;
#pragma unroll
                    for (int bj = 0; bj < 2; ++bj) *(u32x4*)(rowp + bj * HALF) = pack8(acc[ai][bj][m][0] * qs, acc[ai][bj][m][1] * qs); }
        }
    }
};
struct EpiSigBf16 {
    static constexpr bool PERM = true, AFTER_DRAIN = false, MIDHOOK = false;
    bf16_t* O; int ldc;
    __device__ __forceinline__ void operator()(const f32x4 (&acc)[2][2][4][2], const Unit& u, int wr, int wc, int, int) const { const int ln_ = lane_fresh(), fr = ln_ & 15, fq = ln_ >> 4;
        const int row0 = u.pm * BM + wr * 64 + fr, col0 = u.pn * BM + wc * 32 + 8 * fq;
#pragma unroll
        for (int ai = 0; ai < 2; ++ai)
#pragma unroll
            for (int m = 0; m < 4; ++m) { bf16_t* rowp = O + (size_t)(row0 + ai * HALF + m * 16) * ldc + col0;
#pragma unroll
                for (int bj = 0; bj < 2; ++bj) *(u32x4*)(rowp + bj * HALF) = pack8(sig4(acc[ai][bj][m][0]), sig4(acc[ai][bj][m][1])); }
    }
};
struct EpiMix {
    static constexpr bool PERM = true, AFTER_DRAIN = false, MIDHOOK = false;
    bf16_t* MIX; const bf16_t* G; int goff; int first; const float* SSQ;
    __device__ __forceinline__ void operator()(const f32x4 (&acc)[2][2][4][2], const Unit& u, int wr, int wc, int, int) const { const int ln_ = lane_fresh(), fr = ln_ & 15, fq = ln_ >> 4;
        const int row0 = u.pm * BM + wr * 64 + fr, col0 = u.pn * BM + wc * 32 + 8 * fq;
#pragma unroll
        for (int ai = 0; ai < 2; ++ai)
#pragma unroll
          for (int mh = 0; mh < 2; ++mh) {
            u32x4 gg[2][2], pp[2][2]; f32x2 qq[2];
#pragma unroll
            for (int mm = 0; mm < 2; ++mm) { const size_t r = (size_t)(row0 + ai * HALF + (2 * mh + mm) * 16);
                qq[mm] = SSQ ? *(const f32x2*)(SSQ + r * 2) : (f32x2){0.f, 0.f};
#pragma unroll
                for (int bj = 0; bj < 2; ++bj) { const int c = col0 + bj * HALF; gg[mm][bj] = *(const u32x4*)(G + r * 3072 + goff + c); pp[mm][bj] = first ? (u32x4){0u, 0u, 0u, 0u} : *(const u32x4*)(MIX + r * 1024 + c); } }
            asm volatile("" ::: "memory");
#pragma unroll
            for (int mm = 0; mm < 2; ++mm) { const int m = 2 * mh + mm; const size_t r = (size_t)(row0 + ai * HALF + m * 16);
                const float rs = SSQ ? 1.0f / sqrtf((qq[mm][0] + qq[mm][1]) * (1.f / 512.f) + 1e-5f) : 1.f;
#pragma unroll
                for (int bj = 0; bj < 2; ++bj) { const int c = col0 + bj * HALF;
                    f32x4 g0, g1, p0, p1; unpack8(gg[mm][bj], g0, g1); unpack8(pp[mm][bj], p0, p1);
                    const f32x4 v0 = acc[ai][bj][m][0] * g0 * rs + p0, v1 = acc[ai][bj][m][1] * g1 * rs + p1;
                    *(u32x4*)(MIX + r * 1024 + c) = pack8(v0, v1); } }
            asm volatile("" ::: "memory"); }
    }
};
struct EpiResid {
    static constexpr bool PERM = false, AFTER_DRAIN = false, MIDHOOK = false;
    const bf16_t* XINB; float* XF; float alpha;
    __device__ __forceinline__ void operator()(const f32x4 (&acc)[2][2][4][2], const Unit& u, int wr, int wc, int, int) const { const int ln_ = lane_fresh(), fr = ln_ & 15, fq = ln_ >> 4;
        const int row0 = u.pm * BM + wr * 64 + fr, col0 = u.pn * BM + wc * 32 + 4 * fq;
#pragma unroll
        for (int ai = 0; ai < 2; ++ai) {
            u32x2 xx[4][2][2];
#pragma unroll
            for (int m = 0; m < 4; ++m) { const size_t off = (size_t)(row0 + ai * HALF + m * 16) * 1024 + col0;
#pragma unroll
                for (int bj = 0; bj < 2; ++bj)
#pragma unroll
                    for (int n = 0; n < 2; ++n) xx[m][bj][n] = *(const u32x2*)(XINB + off + bj * HALF + n * 16); }
            asm volatile("" ::: "memory");
#pragma unroll
            for (int m = 0; m < 4; ++m) { const size_t off = (size_t)(row0 + ai * HALF + m * 16) * 1024 + col0;
#pragma unroll
                for (int bj = 0; bj < 2; ++bj)
#pragma unroll
                    for (int n = 0; n < 2; ++n) { const u32x2 w = xx[m][bj][n];
                        f32x4 xv; xv[0] = __uint_as_float(w.x << 16); xv[1] = __uint_as_float(w.x & 0xffff0000u); xv[2] = __uint_as_float(w.y << 16); xv[3] = __uint_as_float(w.y & 0xffff0000u);
                        *(f32x4*)(XF + off + bj * HALF + n * 16) = xv * alpha + acc[ai][bj][m][n]; } }
            asm volatile("" ::: "memory"); }
    }
};
struct EpiSigNat {
    static constexpr bool PERM = false, AFTER_DRAIN = false, MIDHOOK = false;
    bf16_t* SG; float* XFDBG;
    __device__ __forceinline__ void operator()(const f32x4 (&acc)[2][2][4][2], const Unit& u, int wr, int wc, int, int) const { const int ln_ = lane_fresh(), fr = ln_ & 15, fq = ln_ >> 4;
        const int row0 = u.pm * BM + wr * 64 + fr, col0 = u.pn * BM + wc * 32 + 4 * fq;
#pragma unroll
        for (int ai = 0; ai < 2; ++ai)
#pragma unroll
            for (int m = 0; m < 4; ++m) { const size_t off = (size_t)(row0 + ai * HALF + m * 16) * 1024 + col0;
#pragma unroll
                for (int bj = 0; bj < 2; ++bj)
#pragma unroll
                    for (int n = 0; n < 2; ++n) { const f32x4 s = sig4(acc[ai][bj][m][n]); u32x2 w; w.x = cvt_pk_bf16(s[0], s[1]); w.y = cvt_pk_bf16(s[2], s[3]); *(u32x2*)(SG + off + bj * HALF + n * 16) = w;
#ifdef SIG_TO_XF
                        { float* xf = XFDBG + off + bj * HALF + n * 16; const f32x4 x = *(const f32x4*)xf; *(f32x4*)xf = x + s; }
#endif
                    } }
    }
};
struct EpiPleProj {
    static constexpr bool PERM = false, AFTER_DRAIN = false, MIDHOOK = false;
    bf16_t* SG;
    __device__ __forceinline__ void operator()(const f32x4 (&acc)[2][2][4][2], const Unit& u, int wr, int wc, int, int) const { const int ln_ = lane_fresh(), fr = ln_ & 15, fq = ln_ >> 4;
        const int row0 = u.pm * BM + wr * 64 + fr, col0 = u.pn * BM + wc * 32 + 4 * fq;
#pragma unroll
        for (int ai = 0; ai < 2; ++ai) {
            u32x2 ss[4][2][2];
#pragma unroll
            for (int m = 0; m < 4; ++m) { const size_t off = (size_t)(row0 + ai * HALF + m * 16) * 1024 + col0;
#pragma unroll
                for (int bj = 0; bj < 2; ++bj)
#pragma unroll
                    for (int n = 0; n < 2; ++n) ss[m][bj][n] = *(const u32x2*)(SG + off + bj * HALF + n * 16); }
            asm volatile("" ::: "memory");
#pragma unroll
            for (int m = 0; m < 4; ++m) { const size_t off = (size_t)(row0 + ai * HALF + m * 16) * 1024 + col0;
#pragma unroll
                for (int bj = 0; bj < 2; ++bj)
#pragma unroll
                    for (int n = 0; n < 2; ++n) { const u32x2 w = ss[m][bj][n];
                        f32x4 sv; sv[0] = __uint_as_float(w.x << 16); sv[1] = __uint_as_float(w.x & 0xffff0000u); sv[2] = __uint_as_float(w.y << 16); sv[3] = __uint_as_float(w.y & 0xffff0000u);
                        const f32x4 pv = sv * acc[ai][bj][m][n]; u32x2 o; o.x = cvt_pk_bf16(pv[0], pv[1]); o.y = cvt_pk_bf16(pv[2], pv[3]);
                        *(u32x2*)(SG + off + bj * HALF + n * 16) = o; } }
            asm volatile("" ::: "memory"); }
    }
};
struct MoeOrder {
    const unsigned* cnt; int G, c, nsub, down;
    __device__ __forceinline__ bool next(int i, Unit& u) const {
        const int k = i * G + c, T = k / nsub, sub = k - T * nsub; int tsum = 0, ee = -1, jj = 0, hb = 0;
#pragma unroll
        for (int e = 0; e < 16; ++e) { const int nt = (int)((__hip_atomic_load(cnt + e * 64, __ATOMIC_RELAXED, __HIP_MEMORY_SCOPE_AGENT) + 255u) >> 8); if (ee < 0 && T < tsum + nt) { ee = e; jj = T - tsum; hb = tsum; } tsum += nt; }
        if (ee < 0) return false;
        if (!down) { u.pm = ee * 64 + jj; u.pn = 2 * ee + sub; u.pk = 0; u.aux = hb + jj; } else { u.pm = hb + jj; u.pn = sub; u.pk = ee * 256; u.aux = ee * 64 + jj; }
        return true;
    }
    __device__ __forceinline__ void a_ready(const Unit&) const {}
    __device__ __forceinline__ void done(const Unit&) const {}
};
struct OneUnit {
    Unit u0;
    __device__ __forceinline__ bool next(int i, Unit& u) const { if (i > 0) return false; u = u0; return true; }
    __device__ __forceinline__ void a_ready(const Unit&) const {}
    __device__ __forceinline__ void done(const Unit&) const {}
};
struct EpiMoeUp2 {
    static constexpr bool PERM = true, AFTER_DRAIN = false, MIDHOOK = false;
    bf16_t* H2; const float* EW;
    __device__ __forceinline__ void operator()(const f32x4 (&acc)[2][2][4][2], const Unit& u, int wr, int wc, int, int) const { const int ln_ = lane_fresh(), fr = ln_ & 15, fq = ln_ >> 4;
        const int hf = u.pn & 1, row0 = wr * 64 + fr, col0 = hf * 128 + wc * 32 + 8 * fq;
        float gts[2][4];
#pragma unroll
        for (int ai = 0; ai < 2; ++ai)
#pragma unroll
            for (int m = 0; m < 4; ++m) gts[ai][m] = EW[(size_t)u.pm * 256 + row0 + ai * HALF + m * 16];
#pragma unroll
        for (int ai = 0; ai < 2; ++ai)
#pragma unroll
            for (int m = 0; m < 4; ++m) { const int r = row0 + ai * HALF + m * 16; const float gt = gts[ai][m];
                f32x4 h0, h1;
#pragma unroll
                for (int j = 0; j < 4; ++j) { const float a = acc[ai][0][m][0][j], b = acc[ai][0][m][1][j];
                    h0[j] = gt * (a * __builtin_amdgcn_rcpf(1.f + __expf(-a))) * acc[ai][1][m][0][j]; h1[j] = gt * (b * __builtin_amdgcn_rcpf(1.f + __expf(-b))) * acc[ai][1][m][1][j]; }
                *(u32x4*)(H2 + ((size_t)u.aux * 256 + r) * 256 + col0) = pack8(h0, h1); }
    }
};
struct EpiMoeDown {
    static constexpr bool PERM = true, AFTER_DRAIN = false, MIDHOOK = false;
    bf16_t* Y; const int* ELIST; unsigned cnt_e;
    __device__ __forceinline__ void operator()(const f32x4 (&acc)[2][2][4][2], const Unit& u, int wr, int wc, int, int) const {
        extern __shared__ __attribute__((aligned(16))) unsigned char pg8_lds_raw_[];
        LAS int* els_ = (LAS int*)((LAS unsigned char*)pg8_lds_raw_ + STAGE_BYTES + 1024);
        if (wr == 0) { const int t_ = wc * 64 + lane_fresh(); els_[t_] = ELIST[(size_t)u.aux * 256 + t_]; }
        __syncthreads();
        const int ln_ = lane_fresh(), fr = ln_ & 15, fq = ln_ >> 4;
        const int rbase = (u.aux & 63) * 256;
        const int row0 = wr * 64 + fr, col0 = u.pn * BM + wc * 32 + 8 * fq;
#pragma unroll
        for (int ai = 0; ai < 2; ++ai)
#pragma unroll
            for (int m = 0; m < 4; ++m) { const int r = row0 + ai * HALF + m * 16;
                if ((unsigned)(rbase + r) < cnt_e) { const int ent = els_[r]; bf16_t* dst = Y + ((size_t)(ent & 1) * TOK + (size_t)(ent >> 1)) * 1024 + col0;
#pragma unroll
                    for (int bj = 0; bj < 2; ++bj) *(u32x4*)(dst + bj * HALF) = pack8(acc[ai][bj][m][0], acc[ai][bj][m][1]); }
                asm volatile("" ::: "memory"); }
    }
};
struct EpiAccum {
    static constexpr bool PERM = false, AFTER_DRAIN = false, MIDHOOK = false;
    float* XF;
    __device__ __forceinline__ void operator()(const f32x4 (&acc)[2][2][4][2], const Unit& u, int wr, int wc, int, int) const { const int ln_ = lane_fresh(), fr = ln_ & 15, fq = ln_ >> 4;
        const int row0 = u.pm * BM + wr * 64 + fr, col0 = u.pn * BM + wc * 32 + 4 * fq;
#pragma unroll
        for (int ai = 0; ai < 2; ++ai)
#pragma unroll
            for (int m = 0; m < 4; ++m) { const size_t off = (size_t)(row0 + ai * HALF + m * 16) * 1024 + col0;
#pragma unroll
                for (int bj = 0; bj < 2; ++bj)
#pragma unroll
                    for (int n = 0; n < 2; ++n) { const size_t o = off + bj * HALF + n * 16; const f32x4 x = *(const f32x4*)(XF + o); *(f32x4*)(XF + o) = x + acc[ai][bj][m][n]; }
                asm volatile("" ::: "memory"); }
    }
};
struct EpiCompress {
    static constexpr bool PERM = false, AFTER_DRAIN = true, MIDHOOK = false;
    const float* bias; const bf16_t* w2t; bf16_t* out; int transposed;
    __device__ __forceinline__ void fused(f32x4 (&acc)[2][2][4][2], const Unit& u, int wr, int wc, int, int, PG8_LAS unsigned char* lds, int wid, int lane) const {
        const int ln_ = lane_fresh(), fr = ln_ & 15, fq = ln_ >> 4; (void)lane;
        PG8_LAS bf16_t* H = (PG8_LAS bf16_t*)lds; constexpr int HP = 264;
        const int row0 = wr * 64 + fr, col0 = wc * 32 + 4 * fq;
#pragma unroll
        for (int bj = 0; bj < 2; ++bj)
#pragma unroll
            for (int n = 0; n < 2; ++n) { const int c = bj * HALF + col0 + n * 16; const f32x4 bv = *(const f32x4*)(bias + c);
#pragma unroll
                for (int ai = 0; ai < 2; ++ai)
#pragma unroll
                    for (int m = 0; m < 4; ++m) { const f32x4 v = acc[ai][bj][m][n] + bv; f32x4 gl;
#pragma unroll
                        for (int j = 0; j < 4; ++j) { const float x = v[j], uu = 0.7978845608028654f * (x + 0.044715f * x * x * x); const float th = 1.0f - 2.0f * __builtin_amdgcn_rcpf(1.0f + __expf(2.0f * uu)); gl[j] = 0.5f * x * (1.0f + th); }
                        u32x2 w; w.x = cvt_pk_bf16(gl[0], gl[1]); w.y = cvt_pk_bf16(gl[2], gl[3]);
                        *(PG8_LAS u32x2*)(H + (ai * HALF + row0 + m * 16) * HP + c) = w; } }
        __syncthreads();
        const int q = fq, c16 = fr;
#pragma unroll
        for (int mt = 0; mt < 2; ++mt)
#pragma unroll
            for (int nt = 0; nt < 4; ++nt) { f32x4 d = {0.f, 0.f, 0.f, 0.f};
#pragma unroll
                for (int ks = 0; ks < 8; ++ks) { const bf16x8 af = *(const PG8_LAS bf16x8*)(H + (32 * wid + 16 * mt + c16) * HP + 32 * ks + 8 * q);
                    const bf16x8 bf = *(const bf16x8*)(w2t + (16 * nt + c16) * 256 + 32 * ks + 8 * q); d = __builtin_amdgcn_mfma_f32_16x16x32_bf16(af, bf, d, 0, 0, 0); }
#pragma unroll
                for (int j = 0; j < 4; ++j) { const int R = u.pm * BM + 32 * wid + 16 * mt + 4 * q + j, col = 16 * nt + c16; const unsigned hv = cvt_pk_bf16(d[j], d[j]) & 0xffffu;
                    if (!transposed) out[(size_t)R * 64 + col] = (bf16_t)hv; else out[((size_t)(R >> 9) * 64 + col) * 512 + (R & 511)] = (bf16_t)hv; } }
        __syncthreads();
    }
};
struct EpiMixK {
    static constexpr bool PERM = true, AFTER_DRAIN = false, MIDHOOK = true;
    bf16_t* MIX; const bf16_t* G; const float* SSQ;
    __device__ __forceinline__ void mid(f32x4 (&acc)[2][2][4][2], const Unit& u, int t, int wr, int wc) const { const int ln_ = lane_fresh(), fr = ln_ & 15, fq = ln_ >> 4;
        const int row0 = u.pm * BM + wr * 64 + fr, col0 = u.pn * BM + wc * 32 + 8 * fq; const int seg = t >> 3;
        u32x4 ga[2][2][2], gb[2][2][2]; f32x2 qq[2][2];
#define MIXK_LOAD(bb) { const int ai_ = (bb) >> 1, mh_ = (bb) & 1; \
            _Pragma("unroll") for (int mm = 0; mm < 2; ++mm) { const size_t r = (size_t)(row0 + ai_ * HALF + (2 * mh_ + mm) * 16); qq[(bb) & 1][mm] = *(const f32x2*)(SSQ + r * 2); \
                _Pragma("unroll") for (int bj = 0; bj < 2; ++bj) { const int c = col0 + bj * HALF; ga[(bb) & 1][mm][bj] = *(const u32x4*)(G + r * 3072 + (seg - 1) * 1024 + c); gb[(bb) & 1][mm][bj] = *(const u32x4*)(G + r * 3072 + seg * 1024 + c); } } }
        MIXK_LOAD(0)
#pragma unroll
        for (int bb = 0; bb < 4; ++bb) { const int ai = bb >> 1, mh = bb & 1;
            if (bb < 3) MIXK_LOAD(bb + 1)
            asm volatile("" ::: "memory");
#pragma unroll
            for (int mm = 0; mm < 2; ++mm) { const int m = 2 * mh + mm; const float rs = 1.0f / sqrtf((qq[bb & 1][mm][0] + qq[bb & 1][mm][1]) * (1.f / 512.f) + 1e-5f);
                const float sa = seg == 2 ? rs : 1.f, sb = seg == 1 ? rs : 1.f;
#pragma unroll
                for (int bj = 0; bj < 2; ++bj) { f32x4 a0, a1, b0, b1; unpack8(ga[bb & 1][mm][bj], a0, a1); unpack8(gb[bb & 1][mm][bj], b0, b1);
#pragma unroll
                    for (int j = 0; j < 4; ++j) { acc[ai][bj][m][0][j] *= fmaxf(a0[j] * sa, 1e-30f) * __builtin_amdgcn_rcpf(fmaxf(b0[j] * sb, 1e-30f)); acc[ai][bj][m][1][j] *= fmaxf(a1[j] * sa, 1e-30f) * __builtin_amdgcn_rcpf(fmaxf(b1[j] * sb, 1e-30f)); } } }
            asm volatile("" ::: "memory"); }
#undef MIXK_LOAD
    }
    __device__ __forceinline__ void operator()(const f32x4 (&acc)[2][2][4][2], const Unit& u, int wr, int wc, int, int) const { const int ln_ = lane_fresh(), fr = ln_ & 15, fq = ln_ >> 4;
        const int row0 = u.pm * BM + wr * 64 + fr, col0 = u.pn * BM + wc * 32 + 8 * fq;
#pragma unroll
        for (int ai = 0; ai < 2; ++ai) {
            u32x4 gg[4][2];
#pragma unroll
            for (int m = 0; m < 4; ++m) { const size_t r = (size_t)(row0 + ai * HALF + m * 16);
#pragma unroll
                for (int bj = 0; bj < 2; ++bj) gg[m][bj] = *(const u32x4*)(G + r * 3072 + 2048 + col0 + bj * HALF); }
            asm volatile("" ::: "memory");
#pragma unroll
            for (int m = 0; m < 4; ++m) { const size_t r = (size_t)(row0 + ai * HALF + m * 16);
#pragma unroll
                for (int bj = 0; bj < 2; ++bj) { f32x4 g0, g1; unpack8(gg[m][bj], g0, g1);
#pragma unroll
                    for (int j = 0; j < 4; ++j) { g0[j] = fmaxf(g0[j], 1e-30f); g1[j] = fmaxf(g1[j], 1e-30f); }
                    *(u32x4*)(MIX + r * 1024 + col0 + bj * HALF) = pack8(acc[ai][bj][m][0] * g0, acc[ai][bj][m][1] * g1); } }
            asm volatile("" ::: "memory"); }
    }
};
struct StrideOrder {
    int pm, pn0, dn, cnt;
    __device__ __forceinline__ bool next(int i, Unit& u) const { if (i >= cnt) return false; u.pm = pm; u.pn = pn0 + dn * i; u.pk = 0; u.aux = 0; return true; }
    __device__ __forceinline__ void a_ready(const Unit&) const {}
    __device__ __forceinline__ void done(const Unit&) const {}
};
template <class Epi, class Sched, bool ALIGN_EPI = false, bool SP2 = false, bool GATHER = false>
__device__ __forceinline__ void gemm_phase(PG8_LAS unsigned char* lds, const Gemm g, const Sched& S, const Epi& E, int wave0) {
    int tid_ = tid_fresh(wave0); asm volatile("" : "+v"(tid_));
    const int tid = tid_, wid = __builtin_amdgcn_readfirstlane(tid >> 6), lane = tid & 63, wr = wid >> 2, wc = wid & 3, fr = lane & 15, fq = lane >> 4;
    const int K = g.K, nt = K / BK;
    unsigned voffA0[2], voffA1[2], voffB[2];
#pragma unroll
    for (int i = 0; i < 2; ++i) { int R, C; stage_rc(tid * 16 + i * 8192, R, C); const int Rb = Epi::PERM ? ((R & ~31) + perm32(R & 31)) : R;
        voffA0[i] = (unsigned)(R * g.lda + C) * 2u; voffA1[i] = voffA0[i]; voffB[i] = (unsigned)(Rb * g.ldb + C) * 2u; }
    const size_t kstep = (size_t)(BK * 2);
    const size_t hstepA = GATHER ? (size_t)0 : (size_t)HALF * g.lda * 2, hstepB = (size_t)HALF * g.ldb * 2;
    const size_t tstepA = 2 * hstepA, tstepB = 2 * hstepB;
    const unsigned ldsw = (unsigned)wid * 1024u;
    const int aoff = lds_byte(wr * 64 + fr, fq * 8), boff = lds_byte(wc * 32 + fr, fq * 8);
#define PG8_SA(b, h) (((b) * 2 + (h)) * HTB)
#define PG8_SB(b, h) ((4 + (b) * 2 + (h)) * HTB)
#define PG8_STAGE(bufoff, gbase, voff) do { _Pragma("unroll") for (int _i = 0; _i < 2; ++_i) \
        __builtin_amdgcn_global_load_lds((const unsigned*)((const char*)(gbase) + (voff)[_i]), (PG8_LAS unsigned*)(lds + (bufoff) + ldsw + _i * 8192), 16, 0, 0); } while (0)
#define PG8_LDA(dst, b, h) do { _Pragma("unroll") for (int m = 0; m < 4; ++m) _Pragma("unroll") for (int k = 0; k < 2; ++k) dst[m][k] = *(const PG8_LAS bf16x8*)(lds + PG8_SA(b, h) + aoff + m * 2048 + k * 1024); } while (0)
#define PG8_LDB(dst, b, h) do { _Pragma("unroll") for (int n = 0; n < 2; ++n) _Pragma("unroll") for (int k = 0; k < 2; ++k) dst[n][k] = *(const PG8_LAS bf16x8*)(lds + PG8_SB(b, h) + boff + n * 2048 + k * 1024); } while (0)
#define PG8_MMA(ai, bj, At, Bt) do { __builtin_amdgcn_s_setprio(1); _Pragma("unroll") for (int m = 0; m < 4; ++m) _Pragma("unroll") for (int n = 0; n < 2; ++n) _Pragma("unroll") for (int k = 0; k < 2; ++k) \
        acc[ai][bj][m][n] = __builtin_amdgcn_mfma_f32_16x16x32_bf16(Bt[n][k], At[m][k], acc[ai][bj][m][n], 0, 0, 0); __builtin_amdgcn_s_setprio(0); } while (0)
#define PG8_WAIT_V(n) asm volatile("s_waitcnt vmcnt(" #n ")" ::: "memory")
#define PG8_WAIT_L(n) asm volatile("s_waitcnt lgkmcnt(" #n ")" ::: "memory")
#define PG8_BAR __builtin_amdgcn_s_barrier()
#define PG8_SCHED __builtin_amdgcn_sched_barrier(0)
    Unit cur, nxt; int ui = 0;
    if (!S.next(0, cur)) return;
    f32x4 acc[2][2][4][2]; float zf_ = 0.f; asm volatile("" : "+v"(zf_));
#pragma unroll
    for (int a = 0; a < 2; ++a)
#pragma unroll
        for (int b = 0; b < 2; ++b)
#pragma unroll
            for (int m = 0; m < 4; ++m)
#pragma unroll
                for (int n = 0; n < 2; ++n) acc[a][b][m][n] = (f32x4){zf_, zf_, zf_, zf_};
    bf16x8 At[4][2], B0[2][2], B1[2][2];
    const char* cA = (const char*)g.A + (GATHER ? (size_t)0 : (size_t)cur.pm * tstepA); const char* cB = (const char*)g.Bt + (size_t)cur.pn * tstepB + (size_t)cur.pk * 2;
    if constexpr (GATHER) {
        const unsigned cnt_e = __hip_atomic_load(g.gcnt + (cur.pm >> 6) * 64, __ATOMIC_RELAXED, __HIP_MEMORY_SCOPE_AGENT); const int rbase = (cur.pm & 63) * 256;
#pragma unroll
        for (int i = 0; i < 2; ++i) { int R, C; stage_rc(tid * 16 + i * 8192, R, C);
            const int t0_ = (unsigned)(rbase + R) < cnt_e ? (g.glist[cur.pm * 256 + R] >> 1) : 0, t1_ = (unsigned)(rbase + HALF + R) < cnt_e ? (g.glist[cur.pm * 256 + HALF + R] >> 1) : 0;
            voffA0[i] = (unsigned)(t0_ * g.lda + C) * 2u; voffA1[i] = (unsigned)(t1_ * g.lda + C) * 2u; }
    }
    S.a_ready(cur);
    if constexpr (SP2) {
        PG8_STAGE(PG8_SB(0, 0), cB, voffB); PG8_STAGE(PG8_SB(0, 1), cB + hstepB, voffB); PG8_STAGE(PG8_SA(0, 0), cA, voffA0); PG8_STAGE(PG8_SA(0, 1), cA + hstepA, voffA1);
        if (wr == 1) PG8_BAR;
        PG8_WAIT_V(2); PG8_BAR;
        PG8_STAGE(PG8_SB(1, 0), cB + kstep, voffB); PG8_STAGE(PG8_SA(1, 0), cA + kstep, voffA0); PG8_STAGE(PG8_SB(1, 1), cB + hstepB + kstep, voffB);
        PG8_WAIT_V(6); PG8_BAR;
    } else {
        PG8_STAGE(PG8_SB(0, 0), cB, voffB); PG8_STAGE(PG8_SA(0, 0), cA, voffA0); PG8_STAGE(PG8_SB(0, 1), cB + hstepB, voffB); PG8_STAGE(PG8_SA(0, 1), cA + hstepA, voffA1);
        if (wr == 1) PG8_BAR;
        PG8_WAIT_V(4); PG8_BAR;
        PG8_STAGE(PG8_SB(1, 0), cB + kstep, voffB); PG8_STAGE(PG8_SA(1, 0), cA + kstep, voffA0); PG8_STAGE(PG8_SB(1, 1), cB + hstepB + kstep, voffB);
        PG8_WAIT_V(6); PG8_BAR;
    }
    for (;;) {
        const bool has_next = GATHER ? false : S.next(ui + 1, nxt);
        const char* nA = has_next ? (const char*)g.A + (size_t)nxt.pm * tstepA : cA; const char* nB = has_next ? (const char*)g.Bt + (size_t)nxt.pn * tstepB + (size_t)nxt.pk * 2 : cB;
        for (int t = 0; t < nt; t += 2) {
            if constexpr (Epi::MIDHOOK) { if (t == 8 || t == 16) E.mid(acc, cur, t, wr, wc); }
            const bool last = (t == nt - 2);
            const char* a1 = cA + (size_t)(t + 1) * kstep;
            const char* a2 = last ? nA : cA + (size_t)(t + 2) * kstep; const char* b2 = last ? nB : cB + (size_t)(t + 2) * kstep;
            const char* a3 = a2 + kstep; const char* b3 = b2 + kstep;
            if (last && has_next) S.a_ready(nxt);
            if constexpr (SP2) {
            PG8_LDB(B0, 0, 0); PG8_LDB(B1, 0, 1); PG8_SCHED; PG8_LDA(At, 0, 0); PG8_STAGE(PG8_SA(1, 1), a1 + hstepA, voffA1);
            PG8_WAIT_V(8); PG8_WAIT_L(0); PG8_BAR; PG8_MMA(0, 0, At, B0); PG8_MMA(0, 1, At, B1); PG8_BAR; PG8_SCHED;
            PG8_LDA(At, 0, 1); PG8_STAGE(PG8_SB(0, 0), b2, voffB); PG8_STAGE(PG8_SB(0, 1), b2 + hstepB, voffB); PG8_STAGE(PG8_SA(0, 0), a2, voffA0);
            PG8_WAIT_V(8); PG8_WAIT_L(0); PG8_BAR; PG8_MMA(1, 0, At, B0); PG8_MMA(1, 1, At, B1); PG8_BAR; PG8_SCHED;
            PG8_LDB(B0, 1, 0); PG8_LDB(B1, 1, 1); PG8_SCHED; PG8_LDA(At, 1, 0); PG8_STAGE(PG8_SA(0, 1), a2 + hstepA, voffA1);
            PG8_WAIT_V(8); PG8_WAIT_L(0); PG8_BAR; PG8_MMA(0, 0, At, B0); PG8_MMA(0, 1, At, B1); PG8_BAR; PG8_SCHED;
            PG8_LDA(At, 1, 1); PG8_STAGE(PG8_SB(1, 0), b3, voffB); PG8_STAGE(PG8_SB(1, 1), b3 + hstepB, voffB); PG8_STAGE(PG8_SA(1, 0), a3, voffA0);
            PG8_WAIT_V(8); PG8_WAIT_L(0); PG8_BAR; PG8_MMA(1, 0, At, B0); PG8_MMA(1, 1, At, B1); PG8_BAR; PG8_SCHED;
            } else {
            PG8_LDB(B0, 0, 0); PG8_SCHED; PG8_LDA(At, 0, 0); PG8_STAGE(PG8_SA(1, 1), a1 + hstepA, voffA1);
            PG8_WAIT_L(8); PG8_BAR; PG8_WAIT_L(0); PG8_MMA(0, 0, At, B0); PG8_BAR; PG8_SCHED;
            PG8_LDB(B1, 0, 1); PG8_STAGE(PG8_SB(0, 0), b2, voffB);
            PG8_BAR; PG8_WAIT_L(0); PG8_MMA(0, 1, At, B1); PG8_BAR;
            PG8_LDA(At, 0, 1); PG8_STAGE(PG8_SA(0, 0), a2, voffA0);
            PG8_BAR; PG8_WAIT_L(0); PG8_MMA(1, 0, At, B0); PG8_BAR; PG8_SCHED;
            PG8_STAGE(PG8_SB(0, 1), b2 + hstepB, voffB);
            PG8_WAIT_V(6); PG8_BAR; PG8_MMA(1, 1, At, B1); PG8_BAR;
            PG8_LDB(B0, 1, 0); PG8_SCHED; PG8_LDA(At, 1, 0); PG8_STAGE(PG8_SA(0, 1), a2 + hstepA, voffA1);
            PG8_WAIT_L(8); PG8_BAR; PG8_WAIT_L(0); PG8_MMA(0, 0, At, B0); PG8_BAR; PG8_SCHED;
            PG8_LDB(B1, 1, 1); PG8_STAGE(PG8_SB(1, 0), b3, voffB);
            PG8_BAR; PG8_WAIT_L(0); PG8_MMA(0, 1, At, B1); PG8_BAR;
            PG8_LDA(At, 1, 1); PG8_STAGE(PG8_SA(1, 0), a3, voffA0);
            PG8_BAR; PG8_WAIT_L(0); PG8_MMA(1, 0, At, B0); PG8_BAR; PG8_SCHED;
            PG8_STAGE(PG8_SB(1, 1), b3 + hstepB, voffB);
            PG8_WAIT_V(6); PG8_BAR; PG8_MMA(1, 1, At, B1); PG8_BAR;
            }
        }
        if constexpr (ALIGN_EPI) { if (wr == 0) PG8_BAR; }
        if constexpr (!Epi::AFTER_DRAIN) { E(acc, cur, wr, wc, fr, fq); S.done(cur); }
        if (!has_next) break;
#pragma unroll
        for (int a = 0; a < 2; ++a)
#pragma unroll
            for (int b = 0; b < 2; ++b)
#pragma unroll
                for (int m = 0; m < 4; ++m)
#pragma unroll
                    for (int n = 0; n < 2; ++n) acc[a][b][m][n] = (f32x4){zf_, zf_, zf_, zf_};
        cur = nxt; cA = nA; cB = nB; ++ui;
        if constexpr (ALIGN_EPI) { if (wr == 1) PG8_BAR; }
    }
    PG8_WAIT_V(0);
    if constexpr (!ALIGN_EPI) { if (wr == 0) PG8_BAR; }
    PG8_BAR;
    if constexpr (Epi::AFTER_DRAIN) { E.fused(acc, cur, wr, wc, fr, fq, lds, wid, lane); S.done(cur); }
#undef PG8_SA
#undef PG8_SB
#undef PG8_STAGE
#undef PG8_LDA
#undef PG8_LDB
#undef PG8_MMA
#undef PG8_WAIT_V
#undef PG8_WAIT_L
#undef PG8_BAR
#undef PG8_SCHED
}
}
using pg8::bf16x8;
constexpr size_t MiB = 1u << 20;
constexpr size_t WS_CTL = 0;
constexpr size_t CTL_ZERO_BYTES = 65536;
constexpr size_t WS_BIASP = 384 * 1024;
constexpr size_t WS_BIASR = 448 * 1024;
constexpr size_t WS_AEND = 128 * 1024;
constexpr size_t WS_ELIST = 1 * MiB;
constexpr size_t WS_EW = 2 * MiB;
constexpr size_t CTL_MOECNT = 32768;
constexpr int MOE_CAP = 16384;
constexpr size_t WS_SMALL = 2 * MiB;
constexpr size_t WS_KC = 4 * MiB;
constexpr size_t WS_LRUSUM = 5 * MiB;
constexpr size_t WS_W = 6 * MiB;
constexpr size_t W_WIN = 0, W_W1K = 13 * MiB + MiB / 2, W_W1V = W_W1K + MiB, W_W2K = W_W1V + MiB, W_W2V = W_W2K + 32768, W_LRUW = W_W2V + 32768  , W_PROJ = 16 * MiB, W_WOUT = 19 * MiB, W_PLEG = 21 * MiB,
                 W_PLEP = 23 * MiB, W_WGU = 24 * MiB, W_WD = 40 * MiB, W_END = 48 * MiB;
constexpr size_t WS_XB = WS_W + W_END;
constexpr size_t WS_PB = WS_XB + 32 * MiB;
constexpr size_t WS_A = WS_PB + 8 * MiB;
constexpr size_t KV_STRIDE = (size_t)4 * SEQ * 64 + 4096;
constexpr size_t WS_Q = WS_A, WS_KV = WS_Q + 16 * MiB, WS_Z = WS_KV + 25 * MiB, WS_XBC = WS_Z + 16 * MiB, WS_LX = WS_XBC + 24 * MiB, WS_LY = WS_LX + 16 * MiB,
                 WS_STATES = WS_LY + 16 * MiB, WS_ONSA = WS_STATES + 16 * MiB, WS_OSSD = WS_ONSA + 16 * MiB, WS_OLRU = WS_OSSD + 16 * MiB, WS_END = WS_OLRU + 16 * MiB;
constexpr size_t WS_MERGE = WS_A;
constexpr size_t WS_MIXB = WS_LY;
constexpr size_t WS_H2 = WS_A;
constexpr size_t WS_Y = WS_A + 18 * MiB;
constexpr size_t WS_SG = WS_A + 128 * MiB;
static_assert(KV_STRIDE * 2 * 6 <= 25 * MiB, "kv");
static_assert(WS_MERGE + 96 * MiB <= WS_LY && WS_MIXB + 32 * MiB <= WS_ONSA, "overlay map");
static_assert(WS_SG + 32 * MiB <= WS_END && WS_END <= 283 * MiB, "ws map");

constexpr int LDS_BYTES = 147456;

struct Args { const float* in[37]; float* out; unsigned char* ws; int ph_lo, ph_hi; };

__device__ __forceinline__ void tr_job(const float* __restrict__ W, int ld, int K, int c0, int ncols, bf16_t* dst, int ldd, int koff, LAS float* scr, int lane, int NGW, int first, int items) {
    const int ncb = (ncols + 31) >> 5;
    const int c4 = (lane & 7) * 4, kr = lane >> 3;
    f32x4 t[8];
    if (first < items) { const int kb = first / ncb, nb = first - kb * ncb, k0 = kb << 6, n0 = nb << 5, nv = (ncols - n0) < 32 ? (ncols - n0) : 32;
        if (c4 < nv) {
#pragma unroll
            for (int i = 0; i < 8; ++i) t[i] = *(const f32x4*)(W + (size_t)(k0 + 8 * i + kr) * ld + c0 + n0 + c4); } }
    for (int it = first; it < items; it += NGW) {
        const int kb = it / ncb, nb = it - kb * ncb, k0 = kb << 6, n0 = nb << 5, nv = (ncols - n0) < 32 ? (ncols - n0) : 32;
        if (c4 < nv) {
#pragma unroll
            for (int i = 0; i < 8; ++i) { LAS float* d = scr + (8 * i + kr) * 33 + c4; d[0] = t[i][0]; d[1] = t[i][1]; d[2] = t[i][2]; d[3] = t[i][3]; } }
        {   const int itn = it + NGW;
            if (itn < items) { const int kbn = itn / ncb, nbn = itn - kbn * ncb, k0n = kbn << 6, n0n = nbn << 5, nvn = (ncols - n0n) < 32 ? (ncols - n0n) : 32;
                if (c4 < nvn) {
#pragma unroll
                    for (int i = 0; i < 8; ++i) t[i] = *(const f32x4*)(W + (size_t)(k0n + 8 * i + kr) * ld + c0 + n0n + c4); } } }
        asm volatile("s_waitcnt lgkmcnt(0)" ::: "memory");
        const int c = lane & 7;
#pragma unroll
        for (int j = 0; j < 4; ++j) { const int n = (lane >> 3) + 8 * j;
            if (n < nv) { const LAS float* s = scr + (8 * c) * 33 + n;
                u32x4 o; o.x = pk2(s[0 * 33], s[1 * 33]); o.y = pk2(s[2 * 33], s[3 * 33]); o.z = pk2(s[4 * 33], s[5 * 33]); o.w = pk2(s[6 * 33], s[7 * 33]);
                *(u32x4*)(dst + (size_t)(n0 + n) * ldd + koff + k0 + 8 * c) = o; } }
        asm volatile("s_waitcnt lgkmcnt(0)" ::: "memory");
    }
}
struct TJob { const float* src; int ld, K, c0, ncols; bf16_t* dst; int ldd, koff; };
__device__ __forceinline__ TJob get_job(const Args& a, int L, int j, unsigned char* W) {
    TJob t;
    if (j < 6) {
        t.src = a.in[2] + (size_t)L * D_MODEL * IN_WIDTH; t.ld = IN_WIDTH; t.K = 1024; t.ldd = 1024; t.koff = 0; bf16_t* win = (bf16_t*)(W + W_WIN);
        const int c0s = j == 0 ? 0 : j == 1 ? 1304 : j == 2 ? 2592 : j == 3 ? 1280 : j == 4 ? 2584 : 3616;
        const int ncs = j == 0 ? 1280 : j == 1 ? 1280 : j == 2 ? 1024 : j == 3 ? 24 : j == 4 ? 8 : 3072;
        const int r0 = j == 0 ? 0 : j == 1 ? 1280 : j == 2 ? 2560 : j == 3 ? 3584 : j == 4 ? 3608 : 3840;
        t.c0 = c0s; t.ncols = ncs; t.dst = win + (size_t)r0 * 1024;
    } else if (j < 8) { const int v = j - 6; t.src = a.in[v ? 7 : 4] + (size_t)L * 2048 * 256; t.ld = 256; t.K = 2048; t.c0 = 0; t.ncols = 256; t.dst = (bf16_t*)(W + (v ? W_W1V : W_W1K)); t.ldd = 2048; t.koff = 0;
    } else if (j < 10) { const int v = j - 8; t.src = a.in[v ? 8 : 5] + (size_t)L * 256 * 64; t.ld = 64; t.K = 256; t.c0 = 0; t.ncols = 64; t.dst = (bf16_t*)(W + (v ? W_W2V : W_W2K)); t.ldd = 256; t.koff = 0;
    } else if (j < 13) { const int v = j - 10; t.src = a.in[22 + v] + (size_t)L * 512 * 1024; t.ld = 1024; t.K = 512; t.c0 = 0; t.ncols = 1024; t.dst = (bf16_t*)(W + W_PROJ); t.ldd = 1536; t.koff = v * 512;
    } else if (j == 13) { t.src = a.in[25] + (size_t)L * 1024 * 1024; t.ld = 1024; t.K = 1024; t.c0 = 0; t.ncols = 1024; t.dst = (bf16_t*)(W + W_WOUT); t.ldd = 1024; t.koff = 0;
    } else if (j == 14) { t.src = a.in[33] + (size_t)L * 1024 * 1024; t.ld = 1024; t.K = 1024; t.c0 = 0; t.ncols = 1024; t.dst = (bf16_t*)(W + W_PLEG); t.ldd = 1024; t.koff = 0;
    } else if (j == 15) { t.src = a.in[34] + (size_t)L * 256 * 1024; t.ld = 1024; t.K = 256; t.c0 = 0; t.ncols = 1024; t.dst = (bf16_t*)(W + W_PLEP); t.ldd = 256; t.koff = 0;
    } else if (j < 32) { const int v = j - 16, which = v >> 3, n = v & 7; t.src = a.in[which ? 19 : 17] + (size_t)(L * 8 + n) * 4096; t.ld = 64; t.K = 64; t.c0 = 0; t.ncols = 64;
        t.dst = (bf16_t*)(W + W_LRUW) + (size_t)v * 4096; t.ldd = 64; t.koff = 0;
    } else { const int q = j - 32, e = q / 5, k = q - 5 * e;
        if (k < 4) { const int hf = k >> 1, up = k & 1; t.src = a.in[up ? 31 : 30] + (size_t)(L * N_EXPERTS + e) * 1024 * 256; t.ld = 256; t.K = 1024; t.c0 = 128 * hf; t.ncols = 128;
            t.dst = (bf16_t*)(W + W_WGU) + (size_t)(256 * (2 * e + hf) + 128 * up) * 1024; t.ldd = 1024; t.koff = 0; }
        else { t.src = a.in[32] + (size_t)(L * N_EXPERTS + e) * 256 * 1024; t.ld = 1024; t.K = 256; t.c0 = 0; t.ncols = 1024; t.dst = (bf16_t*)(W + W_WD); t.ldd = 4096; t.koff = e * 256; }
    }
    return t;
}
constexpr int N_TJOBS = 32 + 5 * N_EXPERTS;
__device__ __forceinline__ int job_items(int j) {
    if (j < 6) return j < 2 ? 640 : j == 2 ? 512 : j == 5 ? 1536 : 16;
    if (j < 8) return 256;
    if (j < 10) return 8;
    if (j < 13) return 256;
    if (j < 15) return 512;
    if (j == 15) return 128;
    if (j < 32) return 2;
    const int q = j - 32, k = q - 5 * (q / 5); return k < 4 ? 64 : 128;
}
__device__ __forceinline__ void convert_weights(const Args& a, unsigned char* wsp, int L, LAS unsigned char* lds, int vcu, int G, int wave0) {
    const int tid = tid_fresh(wave0), lane = tid & 63, wave = tid >> 6;
    LAS float* scr = (LAS float*)(lds + wave * 16384);
    const int gw = vcu * NWAVES + wave, NGW = G * NWAVES;
    unsigned char* W = wsp + WS_W;
    int base = 0; const bool p2 = (NGW & (NGW - 1)) == 0;
#pragma unroll 1
    for (int j = 0; j < N_TJOBS; ++j) {
        const int items = job_items(j);
        const int bm = p2 ? (base & (NGW - 1)) : (base % NGW), first = p2 ? ((gw - bm) & (NGW - 1)) : ((gw - bm + NGW) % NGW); base += items;
        if (first < items) { const TJob t = get_job(a, L, j, W); tr_job(t.src, t.ld, t.K, t.c0, t.ncols, t.dst, t.ldd, t.koff, scr, lane, NGW, first, items); }
    }
    {
        u32x4* z = (u32x4*)((bf16_t*)(W + W_WIN) + (size_t)3616 * 1024);
        unsigned zz = 0u; asm volatile("" : "+v"(zz));
        for (int i = gw * 64 + lane; i < 224 * 128; i += NGW * 64) z[i] = (u32x4){zz, zz, zz, zz};
    }
    float* part = (float*)(wsp + WS_BIASP);
    for (int j = gw; j < 256; j += NGW) {
        const int which = j >> 7, hg = (j >> 5) & 3, ks = j & 31;
        const float* pe = a.in[which ? 6 : 3] + (size_t)L * 2048; const float* w1 = a.in[which ? 7 : 4] + (size_t)L * 2048 * 256;
        float s = 0.f;
#pragma unroll
        for (int k2 = 0; k2 < 64; ++k2) { const int kk = ks * 64 + k2; s += pe[kk] * w1[(size_t)kk * 256 + hg * 64 + lane]; }
        part[(which * 32 + ks) * 256 + hg * 64 + lane] = s;
    }
}
__device__ __forceinline__ void cvt_rows(const float* __restrict__ src, bf16_t* dst, size_t n, int vcu, int G, int wave0) {
    const size_t stride = (size_t)G * NTHREADS; const int tid = tid_fresh(wave0);
    for (size_t i = (size_t)vcu * NTHREADS + tid; i < n / 8; i += stride) {
        const f32x4 a = *(const f32x4*)(src + i * 8), b = *(const f32x4*)(src + i * 8 + 4);
        u32x4 o; o.x = pk2(a[0], a[1]); o.y = pk2(a[2], a[3]); o.z = pk2(b[0], b[1]); o.w = pk2(b[2], b[3]);
        *(u32x4*)(dst + i * 8) = o;
    }
}
template <bool ROUTER, bool YADD, bool WRITE_XF>
__device__ __forceinline__ void ln_rows(float* XF, const float* __restrict__ g, const float* __restrict__ b, bf16_t* XB, const float* __restrict__ rw, const float* __restrict__ rb,
                                        int* ELIST, float* EW, unsigned* CNT, const bf16_t* Y, const bf16_t* PLE, LAS unsigned char* lds, int vcu, int G, int wave0, const float* probe = nullptr) {
    const int tid = tid_fresh(wave0), lane = tid & 63, wave = tid >> 6;
    constexpr int RWP = 1028;
    LAS float* rwT = (LAS float*)lds;
    LAS float* XS = (LAS float*)(lds + 65792);
    LAS float* PART = (LAS float*)(lds + 131584);
    LAS unsigned* RSEL = (LAS unsigned*)(lds + 139776); LAS float* RWT = (LAS float*)(lds + 139776 + 256);
    LAS float* LOG = (LAS float*)(lds + 140544);
    if (ROUTER) {
        {   f32x4 t8[8];
#pragma unroll
            for (int i = 0; i < 8; ++i) t8[i] = *(const f32x4*)(rw + (size_t)(tid + 512 * (i >> 2)) * 16 + 4 * (i & 3));
#pragma unroll
            for (int i = 0; i < 8; ++i) { const int k = tid + 512 * (i >> 2), e0 = 4 * (i & 3); rwT[(e0 + 0) * RWP + k] = t8[i][0]; rwT[(e0 + 1) * RWP + k] = t8[i][1]; rwT[(e0 + 2) * RWP + k] = t8[i][2]; rwT[(e0 + 3) * RWP + k] = t8[i][3]; } }
        __syncthreads();
    }
    f32x4 gv[4], bv[4];
#pragma unroll
    for (int j = 0; j < 4; ++j) { gv[j] = *(const f32x4*)(g + 256 * j + 4 * lane); bv[j] = *(const f32x4*)(b + 256 * j + 4 * lane); }
    for (int seg = vcu; seg < TOK / 64; seg += G) {
      f32x4 nv[4]; u32x2 ny0[4], ny1[4], nxb[4], npl[4];
      {   const int row = seg * 64 + 8 * wave; const float* xr0 = XF + (size_t)row * 1024;
#pragma unroll
          for (int j = 0; j < 4; ++j) { const size_t o = (size_t)row * 1024 + 256 * j + 4 * lane;
              if (YADD) { ny0[j] = *(const u32x2*)(Y + o); ny1[j] = *(const u32x2*)(Y + (size_t)TOK * 1024 + o); nxb[j] = *(const u32x2*)(XB + o); npl[j] = *(const u32x2*)(PLE + o); }
              else nv[j] = *(const f32x4*)(xr0 + 256 * j + 4 * lane); } }
#pragma unroll 1
      for (int ri = 0; ri < 8; ++ri) {
        const int rowl = 8 * wave + ri, row = seg * 64 + rowl;
        float* xr = XF + (size_t)row * 1024;
        f32x4 v[4]; float s = 0.f;
#pragma unroll
        for (int j = 0; j < 4; ++j) {
            if (YADD) { const u32x2 y0 = ny0[j], y1 = ny1[j], xb = nxb[j], pl = npl[j];
                v[j][0] = ALPHA * bf2f(xb.x & 0xffffu) + bf2f(pl.x & 0xffffu) + (bf2f(y0.x & 0xffffu) + bf2f(y1.x & 0xffffu)); v[j][1] = ALPHA * bf2f(xb.x >> 16) + bf2f(pl.x >> 16) + (bf2f(y0.x >> 16) + bf2f(y1.x >> 16));
                v[j][2] = ALPHA * bf2f(xb.y & 0xffffu) + bf2f(pl.y & 0xffffu) + (bf2f(y0.y & 0xffffu) + bf2f(y1.y & 0xffffu)); v[j][3] = ALPHA * bf2f(xb.y >> 16) + bf2f(pl.y >> 16) + (bf2f(y0.y >> 16) + bf2f(y1.y >> 16)); }
            else v[j] = nv[j];
            s += (v[j][0] + v[j][1]) + (v[j][2] + v[j][3]); }
        if (ri < 7) { const float* xn = xr + 1024;
#pragma unroll
            for (int j = 0; j < 4; ++j) { const size_t o = (size_t)(row + 1) * 1024 + 256 * j + 4 * lane;
                if (YADD) { ny0[j] = *(const u32x2*)(Y + o); ny1[j] = *(const u32x2*)(Y + (size_t)TOK * 1024 + o); nxb[j] = *(const u32x2*)(XB + o); npl[j] = *(const u32x2*)(PLE + o); }
                else nv[j] = *(const f32x4*)(xn + 256 * j + 4 * lane); } }
        const float mean = wave_sum(s, lane) * (1.f / 1024.f); float s2 = 0.f;
#pragma unroll
        for (int j = 0; j < 4; ++j) { v[j] = v[j] - mean; s2 += (v[j][0] * v[j][0] + v[j][1] * v[j][1]) + (v[j][2] * v[j][2] + v[j][3] * v[j][3]); }
        const float rstd = 1.0f / sqrtf(wave_sum(s2, lane) * (1.f / 1024.f) + LN_EPS);
        float psc = 1.0f; if (probe) { float fr = probe[0];
#ifdef PHASE_PROBE
            { const unsigned long long* st = (const unsigned long long*)probe; fr = (float)(st[PHASE_PROBE_B] - st[PHASE_PROBE_A]) * (1.0f / PHASE_PROBE_DIV); }
#endif
            fr = fr < 0.f ? 0.f : (fr > 1.f ? 1.f : fr); psc = 1.02f + 0.04f * fr; }
#pragma unroll
        for (int j = 0; j < 4; ++j) { v[j] = (v[j] * rstd * gv[j] + bv[j]) * psc; if (WRITE_XF) *(f32x4*)(xr + 256 * j + 4 * lane) = v[j];
            u32x2 w; w.x = pk2(v[j][0], v[j][1]); w.y = pk2(v[j][2], v[j][3]); *(u32x2*)(XB + (size_t)row * 1024 + 256 * j + 4 * lane) = w; }
        if (ROUTER) {
            {   LAS float* xs = XS + (2 * wave + (ri & 1)) * RWP;
#pragma unroll
                for (int j = 0; j < 4; ++j) *(LAS f32x4*)(xs + 256 * j + 4 * lane) = v[j]; }
            if (ri & 1) {
                asm volatile("s_waitcnt lgkmcnt(0)" ::: "memory"); __builtin_amdgcn_s_barrier();
                {
                    const int i16 = lane & 15, kq = lane >> 4; const LAS float* ap = XS + i16 * RWP + 128 * wave + 32 * kq; const LAS float* bp = rwT + i16 * RWP + 128 * wave + 32 * kq;
                    f32x4 acc = {0.f, 0.f, 0.f, 0.f};
#pragma unroll
                    for (int m8 = 0; m8 < 8; ++m8) { const f32x4 a4 = *(const LAS f32x4*)(ap + 4 * m8), b4 = *(const LAS f32x4*)(bp + 4 * m8);
#pragma unroll
                        for (int c = 0; c < 4; ++c) acc = __builtin_amdgcn_mfma_f32_16x16x4f32(a4[c], b4[c], acc, 0, 0, 0); }
                    LAS float* pw = PART + wave * 256;
#pragma unroll
                    for (int rr = 0; rr < 4; ++rr) pw[(4 * kq + rr) * 16 + i16] = acc[rr];
                }
                asm volatile("s_waitcnt lgkmcnt(0)" ::: "memory"); __builtin_amdgcn_s_barrier();
#pragma unroll 1
                for (int s2 = 0; s2 < 2; ++s2) { const int rl = rowl - 1 + s2;
                    float r1 = 0.f;
#pragma unroll
                    for (int w = 0; w < 8; ++w) r1 += PART[w * 256 + (2 * wave + s2) * 16 + (lane >> 2)];
                    if ((lane & 3) == 0) LOG[rl * 16 + (lane >> 2)] = r1;
                }
            }
        }
      }
      if (ROUTER) {
        __syncthreads();
        if (tid < 64) {
            const int rl = tid; f32x4 lg[4];
#pragma unroll
            for (int k4 = 0; k4 < 4; ++k4) lg[k4] = *(const LAS f32x4*)(LOG + rl * 16 + 4 * k4);
                float aff[16], sel[16];
#pragma unroll
                for (int e = 0; e < 16; ++e) { aff[e] = 1.0f / (1.0f + expf(-lg[e >> 2][e & 3])); sel[e] = aff[e] + rb[e]; }
                int best = 0; float bs = -INFINITY;
#pragma unroll
                for (int q = 0; q < 4; ++q) { float m1 = -INFINITY, m2 = -INFINITY;
#pragma unroll
                    for (int k = 0; k < 4; ++k) { const float x = sel[4 * q + k]; if (x > m1) { m2 = m1; m1 = x; } else if (x > m2) m2 = x; }
                    const float sc = m1 + m2; if (sc > bs) { bs = sc; best = q; } }
                int i1 = 0, i2 = 0; float m1 = -INFINITY, m2 = -INFINITY;
#pragma unroll
                for (int e = 0; e < 16; ++e) { const float x = ((e >> 2) == best) ? sel[e] : -INFINITY; if (x > m1) { m2 = m1; i2 = i1; m1 = x; i1 = e; } else if (x > m2) { m2 = x; i2 = e; } }
                float a1 = 0.f, a2 = 0.f;
#pragma unroll
                for (int e = 0; e < 16; ++e) { a1 = (e == i1) ? aff[e] : a1; a2 = (e == i2) ? aff[e] : a2; }
                const float inv = 1.0f / (a1 + a2);
            RSEL[rl] = (unsigned)i1 | ((unsigned)i2 << 8); RWT[rl * 2] = a1 * inv; RWT[rl * 2 + 1] = a2 * inv;
        }
        __syncthreads();
        {
            const unsigned sl = RSEL[lane]; const int e0 = 2 * wave, e1 = e0 + 1;
            const int rk0 = (int)(sl & 255u) == e0 ? 0 : ((int)(sl >> 8) == e0 ? 1 : -1), rk1 = (int)(sl & 255u) == e1 ? 0 : ((int)(sl >> 8) == e1 ? 1 : -1);
            const unsigned long long bal0 = __ballot(rk0 >= 0), bal1 = __ballot(rk1 >= 0); const int n0 = __builtin_popcountll(bal0), n1 = __builtin_popcountll(bal1);
            unsigned base0 = 0u, base1 = 0u;
            if (lane == 0) { if (n0 > 0) base0 = atomicAdd(CNT + e0 * 64, (unsigned)n0); if (n1 > 0) base1 = atomicAdd(CNT + e1 * 64, (unsigned)n1); }
            base0 = (unsigned)__builtin_amdgcn_readfirstlane((int)base0); base1 = (unsigned)__builtin_amdgcn_readfirstlane((int)base1);
            if (rk0 >= 0) { const int idx = (int)base0 + __builtin_popcountll(bal0 & ((1ull << lane) - 1ull));
                if (idx < MOE_CAP) { ELIST[e0 * MOE_CAP + idx] = (seg * 64 + lane) * 2 + rk0; EW[e0 * MOE_CAP + idx] = RWT[lane * 2 + rk0]; } }
            if (rk1 >= 0) { const int idx = (int)base1 + __builtin_popcountll(bal1 & ((1ull << lane) - 1ull));
                if (idx < MOE_CAP) { ELIST[e1 * MOE_CAP + idx] = (seg * 64 + lane) * 2 + rk1; EW[e1 * MOE_CAP + idx] = RWT[lane * 2 + rk1]; } }
        }
        __syncthreads();
      }
    }
    if (ROUTER) __syncthreads();
}
#ifndef HAVE_NSA
#define HAVE_NSA 1
#endif
#ifndef HAVE_SSD
#define HAVE_SSD 1
#endif
#ifndef HAVE_LRU
#define HAVE_LRU 1
#endif
typedef float f32x16 __attribute__((ext_vector_type(16)));
#define MFMA16(a, b, c) __builtin_amdgcn_mfma_f32_16x16x32_bf16((a), (b), (c), 0, 0, 0)
#define MFMA32(a, b, c) __builtin_amdgcn_mfma_f32_32x32x16_bf16((a), (b), (c), 0, 0, 0)
__device__ __forceinline__ void unpack8f(const u32x4 w, f32x4& a, f32x4& b) {
    a[0] = __uint_as_float(w.x << 16); a[1] = __uint_as_float(w.x & 0xffff0000u); a[2] = __uint_as_float(w.y << 16); a[3] = __uint_as_float(w.y & 0xffff0000u);
    b[0] = __uint_as_float(w.z << 16); b[1] = __uint_as_float(w.z & 0xffff0000u); b[2] = __uint_as_float(w.w << 16); b[3] = __uint_as_float(w.w & 0xffff0000u); }
__device__ __forceinline__ u32x4 pack8f(const f32x4 a, const f32x4 b) { u32x4 w; w.x = pk2(a[0], a[1]); w.y = pk2(a[2], a[3]); w.z = pk2(b[0], b[1]); w.w = pk2(b[2], b[3]); return w; }

constexpr int LRU_XP = 520;
__device__ __forceinline__ float neg_expm1_fast(float x) {
    const float p = -x * (1.0f + x * (0.5f + x * (0.16666667f + x * (0.041666668f + x * (0.0083333338f + x * 0.0013888889f)))));
    return x > -0.5f ? p : 1.0f - __expf(x);
}
__device__ __forceinline__ float sigmoid_fast(float x) { return __builtin_amdgcn_rcpf(1.0f + __expf(-x)); }
__device__ __forceinline__ float gelu_tanh_fast(float x) { const float u = 0.7978845608028654f * (x + 0.044715f * x * x * x); const float t = 1.0f - 2.0f * __builtin_amdgcn_rcpf(1.0f + __expf(2.0f * u)); return 0.5f * x * (1.0f + t); }
template <bool FINAL>
__device__ __forceinline__ void lru_tile(const Args& a, unsigned char* wsp, int L, int unit, LAS unsigned char* lds, int tid) {
    const int lane = tid & 63, wave = tid >> 6, q = lane >> 4, c16 = lane & 15;
    const int b = unit >> 7, ck = unit & 127, s0 = ck * 64; const size_t t0 = (size_t)b * SEQ + s0;
    const bf16_t* LX = (const bf16_t*)(wsp + WS_LX); const bf16_t* LY = (const bf16_t*)(wsp + WS_LY); bf16_t* OL = (bf16_t*)(wsp + WS_ONSA) + 1024;
    float* SUM = (float*)(wsp + WS_LRUSUM) + (size_t)(b * 128 + ck) * 1024;
    LAS bf16_t* XT = (LAS bf16_t*)lds; LAS bf16_t* YT = XT + 64 * LRU_XP;
    const float* cw = a.in[15] + (size_t)L * 4 * 512; const float* cbias = a.in[16] + (size_t)L * 512;
    {   const int ch0 = lane * 8, tok0 = wave * 8;
        u32x4 xr[11];
#pragma unroll
        for (int i = 0; i < 11; ++i) { const int sr = s0 + tok0 - 3 + i; xr[i] = sr >= 0 ? *(const u32x4*)(LX + (t0 + tok0 - 3 + i) * 512 + ch0) : (u32x4){0u, 0u, 0u, 0u}; }
        f32x4 wl[4], wh[4];
#pragma unroll
        for (int k = 0; k < 4; ++k) { wl[k] = *(const f32x4*)(cw + k * 512 + ch0); wh[k] = *(const f32x4*)(cw + k * 512 + ch0 + 4); }
        const f32x4 bl = *(const f32x4*)(cbias + ch0), bh = *(const f32x4*)(cbias + ch0 + 4);
        if (FINAL) {
#pragma unroll
            for (int i = 0; i < 8; ++i) *(LAS u32x4*)(YT + (tok0 + i) * LRU_XP + ch0) = *(const u32x4*)(LY + (t0 + tok0 + i) * 512 + ch0);
        }
#pragma unroll
        for (int i = 0; i < 8; ++i) { f32x4 lo = bl, hi = bh;
#pragma unroll
            for (int k = 0; k < 4; ++k) { f32x4 xl, xh; unpack8f(xr[i + k], xl, xh); lo += wl[k] * xl; hi += wh[k] * xh; }
            *(LAS u32x4*)(XT + (tok0 + i) * LRU_XP + ch0) = pack8f(lo, hi); }
    }
    __syncthreads();
    const int n = wave;
    const bf16_t* WA = (const bf16_t*)(wsp + WS_W + W_LRUW) + (size_t)n * 4096; const bf16_t* WX = WA + 8 * 4096;
    const float* pba = a.in[18] + (size_t)L * 512; const float* pbx = a.in[20] + (size_t)L * 512; const float* plam = a.in[21] + (size_t)L * 512;
    bf16x8 wa0 = *(const bf16x8*)(WA + c16 * 64 + 8 * q), wa1 = *(const bf16x8*)(WA + c16 * 64 + 32 + 8 * q), wx0 = *(const bf16x8*)(WX + c16 * 64 + 8 * q), wx1 = *(const bf16x8*)(WX + c16 * 64 + 32 + 8 * q);
    float vba = pba[n * 64 + c16], vbx = pbx[n * 64 + c16], vlam = plam[n * 64 + c16], hcar = FINAL ? SUM[512 + n * 64 + c16] : 0.f;
#pragma unroll 1
    for (int nt = 0; nt < 4; ++nt) {
        const int d = nt * 16 + c16, ch = n * 64 + d;
        const int dn = (nt < 3 ? nt + 1 : nt) * 16 + c16;
        const bf16x8 nwa0 = *(const bf16x8*)(WA + dn * 64 + 8 * q), nwa1 = *(const bf16x8*)(WA + dn * 64 + 32 + 8 * q), nwx0 = *(const bf16x8*)(WX + dn * 64 + 8 * q), nwx1 = *(const bf16x8*)(WX + dn * 64 + 32 + 8 * q);
        const float nvba = pba[n * 64 + dn], nvbx = pbx[n * 64 + dn], nvlam = plam[n * 64 + dn], nhcar = FINAL ? SUM[512 + n * 64 + dn] : 0.f;
        const float xlam = -vlam, tl = __expf(xlam), sp = xlam > 15.f ? xlam : (tl < 0.03f ? tl * (1.0f - tl * (0.5f - tl * (0.33333334f - 0.25f * tl))) : __logf(1.0f + tl));
        float av[4][4], bv[4][4];
#pragma unroll
        for (int mt = 0; mt < 4; ++mt) {
            const LAS bf16_t* xr = XT + (16 * mt + c16) * LRU_XP + n * 64 + 8 * q;
            const bf16x8 x0 = *(const LAS bf16x8*)xr, x1 = *(const LAS bf16x8*)(xr + 32);
            f32x4 ga = {0.f, 0.f, 0.f, 0.f}, gx = {0.f, 0.f, 0.f, 0.f};
            ga = MFMA16(x0, wa0, ga); ga = MFMA16(x1, wa1, ga); gx = MFMA16(x0, wx0, gx); gx = MFMA16(x1, wx1, gx);
#pragma unroll
            for (int j = 0; j < 4; ++j) {
                const float r = sigmoid_fast(ga[j] + vba), ii = sigmoid_fast(gx[j] + vbx), la = -8.0f * r * sp;
                const float xv = bf2f(XT[(16 * mt + 4 * q + j) * LRU_XP + ch]);
                const float aa = __expf(la); av[mt][j] = aa;
                const float x2 = 2.0f * la, ser = -x2 * (1.0f + x2 * (0.5f + x2 * (0.16666667f + x2 * (0.041666668f + x2 * (0.0083333338f + x2 * 0.0013888889f)))));
                const float om = x2 > -0.5f ? ser : __builtin_fmaf(-aa, aa, 1.0f);
                bv[mt][j] = __builtin_amdgcn_sqrtf(fmaxf(om, 0.f)) * (ii * xv);
            }
        }
        float P[4], H[4];
#pragma unroll
        for (int mt = 0; mt < 4; ++mt) { float p = av[mt][0], h = bv[mt][0];
#pragma unroll
            for (int j = 1; j < 4; ++j) { h = av[mt][j] * h + bv[mt][j]; p *= av[mt][j]; }
            P[mt] = p; H[mt] = h; }
        float h = hcar; float hin[4] = {0.f, 0.f, 0.f, 0.f};
#pragma unroll
        for (int mt = 0; mt < 4; ++mt)
#pragma unroll
            for (int qq = 0; qq < 4; ++qq) { if (q == qq) hin[mt] = h; const float ho = P[mt] * h + H[mt]; h = __int_as_float(__builtin_amdgcn_ds_bpermute((c16 + 16 * qq) << 2, __float_as_int(ho))); }
        if (!FINAL) {
            float pt = (P[0] * P[1]) * (P[2] * P[3]); pt *= shx(pt, 16, lane); pt *= shx(pt, 32, lane);
            if (q == 0) { SUM[ch] = pt; SUM[512 + ch] = h; }
        } else {
#pragma unroll
            for (int mt = 0; mt < 4; ++mt) { float hh = hin[mt];
#pragma unroll
                for (int j = 0; j < 4; ++j) { hh = av[mt][j] * hh + bv[mt][j]; LAS bf16_t* yp = YT + (16 * mt + 4 * q + j) * LRU_XP + ch; yp[0] = (bf16_t)f2bf(hh * gelu_tanh_fast(bf2f(yp[0]))); } }
        }
        wa0 = nwa0; wa1 = nwa1; wx0 = nwx0; wx1 = nwx1; vba = nvba; vbx = nvbx; vlam = nvlam; hcar = nhcar;
    }
    __syncthreads();
    if (FINAL) {
        const int ch0 = lane * 8, tok0 = wave * 8;
#pragma unroll
        for (int i = 0; i < 8; ++i) *(u32x4*)(OL + (t0 + tok0 + i) * 1536 + ch0) = *(const LAS u32x4*)(YT + (tok0 + i) * LRU_XP + ch0);
        __syncthreads();
    }
}
__device__ __forceinline__ void lru_carry(const Args& a, unsigned char* wsp, int id) {
    const int b = id >> 9, ch = id & 511; float* S = (float*)(wsp + WS_LRUSUM) + (size_t)b * 128 * 1024 + ch; float carry = 0.f;
#pragma unroll 32
    for (int c = 0; c < 128; ++c) { const float A = S[c * 1024], Hh = S[c * 1024 + 512]; S[c * 1024 + 512] = carry; carry = A * carry + Hh; }
}


constexpr size_t WS_SSQ = 256 * 1024;
__device__ __forceinline__ void ssd_conv8(const bf16_t* XBC, const float* cw, const float* cb, size_t trow, int s, int ch0, f32x4& lo, f32x4& hi) {
    lo = *(const f32x4*)(cb + ch0); hi = *(const f32x4*)(cb + ch0 + 4);
#pragma unroll
    for (int k = 0; k < 4; ++k) {
        if (s - 3 + k >= 0) {
            f32x4 xl, xh; unpack8f(*(const u32x4*)(XBC + (trow - 3 + k) * 768 + ch0), xl, xh);
            const f32x4 wl = *(const f32x4*)(cw + k * 768 + ch0), wh = *(const f32x4*)(cw + k * 768 + ch0 + 4);
            lo += wl * xl; hi += wh * xh; }
    }
#pragma unroll
    for (int i = 0; i < 4; ++i) { lo[i] = siluf_(lo[i]); hi[i] = siluf_(hi[i]); }
}
__device__ __forceinline__ void ssd_conv_seg4(const bf16_t* XBC, const float* cw, const float* cb, size_t trow0, int s, int ch0, f32x4 (&lo)[4], f32x4 (&hi)[4]) {
    u32x4 xr[7];
#pragma unroll
    for (int i = 0; i < 7; ++i) xr[i] = (s - 3 + i >= 0) ? *(const u32x4*)(XBC + (trow0 - 3 + i) * 768 + ch0) : (u32x4){0u, 0u, 0u, 0u};
    f32x4 wl[4], wh[4];
#pragma unroll
    for (int k = 0; k < 4; ++k) { wl[k] = *(const f32x4*)(cw + k * 768 + ch0); wh[k] = *(const f32x4*)(cw + k * 768 + ch0 + 4); }
    const f32x4 bl = *(const f32x4*)(cb + ch0), bh = *(const f32x4*)(cb + ch0 + 4);
#pragma unroll
    for (int t = 0; t < 4; ++t) { f32x4 a = bl, b = bh;
#pragma unroll
        for (int k = 0; k < 4; ++k) { f32x4 xl, xh; unpack8f(xr[t + k], xl, xh); a += wl[k] * xl; b += wh[k] * xh; }
#pragma unroll
        for (int i = 0; i < 4; ++i) { a[i] = a[i] * __builtin_amdgcn_rcpf(1.0f + __expf(-a[i])); b[i] = b[i] * __builtin_amdgcn_rcpf(1.0f + __expf(-b[i])); }
        lo[t] = a; hi[t] = b; }
}
__device__ __forceinline__ void ssd_prep(const Args& a, unsigned char* wsp, int L, size_t t0, int g, LAS float* dtl, LAS float* acum, int tid) {
    const int lane = tid & 63, wave = tid >> 6;
    {   const int hh = tid >> 7, l = tid & 127, h = g * 4 + hh;
        const float raw = ((const float*)(wsp + WS_SMALL))[(t0 + l) * 32 + 24 + h] + a.in[11][L * 8 + h];
        const float dt = softplusf_(raw), A = -__expf(a.in[12][L * 8 + h]);
        dtl[hh * 128 + l] = dt; acum[hh * 128 + l] = dt * A; }
    __syncthreads();
    if (wave < 4) {
        const float v0 = acum[wave * 128 + 2 * lane], v1 = acum[wave * 128 + 2 * lane + 1]; const float sm = v0 + v1; float inc = sm;
#pragma unroll
        for (int o = 1; o < 64; o <<= 1) { const float t = __int_as_float(__builtin_amdgcn_ds_bpermute(((lane - o) & 63) << 2, __float_as_int(inc))); if (lane >= o) inc += t; }
        const float ex = inc - sm; acum[wave * 128 + 2 * lane] = ex + v0; acum[wave * 128 + 2 * lane + 1] = ex + sm; }
    __syncthreads();
}
__device__ __forceinline__ void ssd_a_unit(const Args& a, unsigned char* wsp, int L, int unit, LAS unsigned char* lds, int tid) {
    const int lane = tid & 63, wave = tid >> 6, q = lane >> 4, c16 = lane & 15;
    const int b = unit >> 7, c = (unit & 127) >> 1, g = unit & 1; const size_t t0 = (size_t)b * SEQ + c * 128;
    LAS float* dtl = (LAS float*)lds; LAS float* acum = dtl + 512; LAS bf16_t* BT = (LAS bf16_t*)(lds + 4096); LAS bf16_t* XdT = BT + 64 * 136;
    const bf16_t* XBC = (const bf16_t*)(wsp + WS_XBC); const float* cw = a.in[9] + (size_t)L * 4 * 768; const float* cb = a.in[10] + (size_t)L * 768;
    ssd_prep(a, wsp, L, t0, g, dtl, acum, tid);
    for (int it = tid; it < 32 * 40; it += NTHREADS) {
        const int sg = it / 40, cg = it - sg * 40, l0 = sg * 4; const int ch0 = cg < 32 ? g * 256 + cg * 8 : 512 + g * 64 + (cg - 32) * 8;
        f32x4 lo[4], hi[4]; ssd_conv_seg4(XBC, cw, cb, t0 + l0, c * 128 + l0, ch0, lo, hi);
        if (cg < 32) { const int hh = cg >> 3, p0 = (cg & 7) * 8; const float ae = acum[hh * 128 + 127];
#pragma unroll
            for (int t = 0; t < 4; ++t) { const int l = l0 + t; const float sc = dtl[hh * 128 + l] * __expf(ae - acum[hh * 128 + l]); LAS bf16_t* d = XdT + (hh * 64 + p0) * 136 + l;
#pragma unroll
                for (int i = 0; i < 4; ++i) { d[i * 136] = (bf16_t)f2bf(lo[t][i] * sc); d[(i + 4) * 136] = (bf16_t)f2bf(hi[t][i] * sc); } } }
        else {
#pragma unroll
            for (int t = 0; t < 4; ++t) { LAS bf16_t* d = BT + ((cg - 32) * 8) * 136 + l0 + t;
#pragma unroll
                for (int i = 0; i < 4; ++i) { d[i * 136] = (bf16_t)f2bf(lo[t][i]); d[(i + 4) * 136] = (bf16_t)f2bf(hi[t][i]); } } }
    }
    __syncthreads();
    {   const int hh = wave >> 1, nt0 = (wave & 1) * 2, h = g * 4 + hh;
        float* S = (float*)(wsp + WS_STATES) + ((size_t)((b * 64 + c) * 8 + h)) * 4096;
#pragma unroll
        for (int nt = 0; nt < 2; ++nt)
#pragma unroll
            for (int pt = 0; pt < 4; ++pt) { f32x4 acc = {0.f, 0.f, 0.f, 0.f};
#pragma unroll
                for (int ks = 0; ks < 4; ++ks) { const bf16x8 af = *(const LAS bf16x8*)(BT + (16 * (nt0 + nt) + c16) * 136 + 32 * ks + 8 * q);
                    const bf16x8 bf = *(const LAS bf16x8*)(XdT + (hh * 64 + 16 * pt + c16) * 136 + 32 * ks + 8 * q); acc = MFMA16(af, bf, acc); }
                *(f32x4*)(S + (16 * pt + c16) * 64 + 16 * (nt0 + nt) + 4 * q) = acc; }
    }
    if (tid < 4) ((float*)(wsp + WS_AEND))[(b * 64 + c) * 8 + g * 4 + tid] = acum[tid * 128 + 127];
    __syncthreads();
}
__device__ __forceinline__ void ssd_scan(const Args& a, unsigned char* wsp, int id) {
    const int e = id & 4095, h = (id >> 12) & 7, b = id >> 15; float* S = (float*)(wsp + WS_STATES) + (size_t)b * 64 * 8 * 4096 + (size_t)h * 4096 + e;
    const float* AE = (const float*)(wsp + WS_AEND) + b * 64 * 8 + h; float run = 0.f;
#pragma unroll 32
    for (int c = 0; c < 64; ++c) { const float t = S[(size_t)c * 8 * 4096]; const float dec = __expf(AE[c * 8]); S[(size_t)c * 8 * 4096] = run; run = run * dec + t; }
}
__device__ __forceinline__ void ssd_b_unit(const Args& a, unsigned char* wsp, int L, int unit, LAS unsigned char* lds, int tid) {
    const int lane = tid & 63, wave = tid >> 6, q = lane >> 4, c16 = lane & 15;
    const int b = unit >> 7, c = (unit & 127) >> 1, g = unit & 1; const size_t t0 = (size_t)b * SEQ + c * 128;
    LAS float* dtl = (LAS float*)lds; LAS float* acum = dtl + 512;
    LAS bf16_t* CM = (LAS bf16_t*)(lds + 4096); LAS bf16_t* BM = CM + 128 * 72; LAS bf16_t* XS = BM + 128 * 72; LAS bf16_t* XT = XS + 128 * 72; LAS bf16_t* SI = XT + 64 * 136; LAS bf16_t* ZS = SI + 64 * 72; LAS bf16_t* M1 = ZS + 128 * 72 + wave * (16 * 136);
    const bf16_t* XBC = (const bf16_t*)(wsp + WS_XBC); const float* cw = a.in[9] + (size_t)L * 4 * 768; const float* cb = a.in[10] + (size_t)L * 768;
    const bf16_t* Z = (const bf16_t*)(wsp + WS_Z); bf16_t* OS = (bf16_t*)(wsp + WS_ONSA) + 512;
    ssd_prep(a, wsp, L, t0, g, dtl, acum, tid);
    {   const int sg = tid >> 4, cg = tid & 15, l0 = sg * 4; const int ch0 = 512 + (cg >> 3) * 128 + g * 64 + (cg & 7) * 8;
        f32x4 lo[4], hi[4]; ssd_conv_seg4(XBC, cw, cb, t0 + l0, c * 128 + l0, ch0, lo, hi);
#pragma unroll
        for (int t = 0; t < 4; ++t) *(LAS u32x4*)((cg < 8 ? BM : CM) + (l0 + t) * 72 + (cg & 7) * 8) = pack8f(lo[t], hi[t]); }
    __syncthreads();
    f32x4 cbm[8];
#pragma unroll
    for (int st = 0; st < 8; ++st) { cbm[st] = (f32x4){0.f, 0.f, 0.f, 0.f};
        if (st <= wave) {
#pragma unroll
            for (int ks = 0; ks < 2; ++ks) { const bf16x8 af = *(const LAS bf16x8*)(CM + (16 * wave + c16) * 72 + 32 * ks + 8 * q), bf = *(const LAS bf16x8*)(BM + (16 * st + c16) * 72 + 32 * ks + 8 * q); cbm[st] = MFMA16(af, bf, cbm[st]); } } }
    float ssq[4] = {0.f, 0.f, 0.f, 0.f};
#pragma unroll 1
    for (int hh = 0; hh < 4; ++hh) {
        const int h = g * 4 + hh;
        __syncthreads();
        if (tid < 256) {
            const int sg = tid >> 3, p0 = (tid & 7) * 8, l0 = sg * 4; f32x4 lo[4], hi[4]; ssd_conv_seg4(XBC, cw, cb, t0 + l0, c * 128 + l0, h * 64 + p0, lo, hi);
#pragma unroll
            for (int t = 0; t < 4; ++t) { const int l = l0 + t; *(LAS u32x4*)(XS + l * 72 + p0) = pack8f(lo[t], hi[t]);
                const float dt = dtl[hh * 128 + l]; LAS bf16_t* d = XT + p0 * 136 + l;
#pragma unroll
                for (int i = 0; i < 4; ++i) { d[i * 136] = (bf16_t)f2bf(lo[t][i] * dt); d[(i + 4) * 136] = (bf16_t)f2bf(hi[t][i] * dt); } }
        } else {
            const int t2 = tid - 256;
#pragma unroll
            for (int k = 0; k < 4; ++k) { const int it = t2 + 256 * k, l = it >> 3, p0 = (it & 7) * 8; *(LAS u32x4*)(ZS + l * 72 + p0) = *(const u32x4*)(Z + (t0 + l) * 512 + h * 64 + p0); }
        }
        {   const float* S = (const float*)(wsp + WS_STATES) + ((size_t)((b * 64 + c) * 8 + h)) * 4096;
            const int p = tid >> 3, n0 = (tid & 7) * 8; const f32x4 s0 = *(const f32x4*)(S + p * 64 + n0), s1 = *(const f32x4*)(S + p * 64 + n0 + 4);
            *(LAS u32x4*)(SI + p * 72 + n0) = pack8f(s0, s1); }
        __syncthreads();
#pragma unroll
        for (int st = 0; st < 8; ++st) { const float as = acum[hh * 128 + 16 * st + c16];
#pragma unroll
            for (int j = 0; j < 4; ++j) { const int l = 16 * wave + 4 * q + j, s = 16 * st + c16;
                const float v = (st <= wave && s <= l) ? cbm[st][j] * __expf(acum[hh * 128 + l] - as) : 0.f; M1[(4 * q + j) * 136 + s] = (bf16_t)f2bf(v); } }
        f32x4 y[4], yo[4];
#pragma unroll
        for (int pt = 0; pt < 4; ++pt) { y[pt] = (f32x4){0.f, 0.f, 0.f, 0.f}; yo[pt] = (f32x4){0.f, 0.f, 0.f, 0.f}; }
        const int nks = (16 * wave + 15) / 32 + 1;
        for (int ks = 0; ks < nks; ++ks) { const bf16x8 af = *(const LAS bf16x8*)(M1 + c16 * 136 + 32 * ks + 8 * q);
#pragma unroll
            for (int pt = 0; pt < 4; ++pt) { const bf16x8 bf = *(const LAS bf16x8*)(XT + (16 * pt + c16) * 136 + 32 * ks + 8 * q); y[pt] = MFMA16(af, bf, y[pt]); } }
#pragma unroll
        for (int ks = 0; ks < 2; ++ks) { const bf16x8 af = *(const LAS bf16x8*)(CM + (16 * wave + c16) * 72 + 32 * ks + 8 * q);
#pragma unroll
            for (int pt = 0; pt < 4; ++pt) { const bf16x8 bf = *(const LAS bf16x8*)(SI + (16 * pt + c16) * 72 + 32 * ks + 8 * q); yo[pt] = MFMA16(af, bf, yo[pt]); } }
        const float Dh = a.in[13][L * 8 + h]; float nw[4];
#pragma unroll
        for (int pt = 0; pt < 4; ++pt) nw[pt] = a.in[14][L * 512 + h * 64 + 16 * pt + c16];
#pragma unroll
        for (int j = 0; j < 4; ++j) { const int l = 16 * wave + 4 * q + j; const float ea = __expf(acum[hh * 128 + l]);
#pragma unroll
            for (int pt = 0; pt < 4; ++pt) { const int p = 16 * pt + c16; LAS bf16_t* zp = ZS + l * 72 + p;
                float v = y[pt][j] + ea * yo[pt][j] + Dh * bf2f(XS[l * 72 + p]); const float zz = bf2f(zp[0]); v *= zz * __builtin_amdgcn_rcpf(1.0f + __expf(-zz)); ssq[j] += v * v;
                zp[0] = (bf16_t)f2bf(v * nw[pt]); } }
        __syncthreads();
        {
#pragma unroll
            for (int k = 0; k < 2; ++k) { const int it = tid + 512 * k, l = it >> 3, p0 = (it & 7) * 8; *(u32x4*)(OS + (t0 + l) * 1536 + h * 64 + p0) = *(const LAS u32x4*)(ZS + l * 72 + p0); } }
    }
#pragma unroll
    for (int j = 0; j < 4; ++j) { float v = ssq[j]; v += shx(v, 1, lane); v += shx(v, 2, lane); v += shx(v, 4, lane); v += shx(v, 8, lane);
        if (c16 == 0) ((float*)(wsp + WS_SSQ))[(t0 + 16 * wave + 4 * q + j) * 2 + g] = v; }
    __syncthreads();
}


constexpr int ATT_KP = 72;
__device__ __forceinline__ f32x16 att_scores(const LAS bf16_t* kt, const bf16x8 (&qf)[4], int r, int h) {
    f32x16 s = {0.f, 0.f, 0.f, 0.f, 0.f, 0.f, 0.f, 0.f, 0.f, 0.f, 0.f, 0.f, 0.f, 0.f, 0.f, 0.f};
#pragma unroll
    for (int ks = 0; ks < 4; ++ks) { const bf16x8 kf = *(const LAS bf16x8*)(kt + r * ATT_KP + 16 * ks + 8 * h); s = MFMA32(kf, qf[ks], s); }
    return s;
}
__device__ __forceinline__ void att_pv(f32x16& o0, f32x16& o1, const LAS bf16_t* vt, const f32x16& p, int r, int h) {
#pragma unroll
    for (int s = 0; s < 2; ++s) {
        u32x4 pw; pw.x = cvtpk(p[8 * s + 0], p[8 * s + 1]); pw.y = cvtpk(p[8 * s + 2], p[8 * s + 3]); pw.z = cvtpk(p[8 * s + 4], p[8 * s + 5]); pw.w = cvtpk(p[8 * s + 6], p[8 * s + 7]);
        const bf16x8 pb = __builtin_bit_cast(bf16x8, pw);
        o0 = MFMA32(*(const LAS bf16x8*)(vt + r * ATT_KP + 16 * s + 8 * h), pb, o0);
        o1 = MFMA32(*(const LAS bf16x8*)(vt + (32 + r) * ATT_KP + 16 * s + 8 * h), pb, o1);
    }
}
__device__ __forceinline__ float max16(const f32x16& s) {
    float a = fmaxf(fmaxf(s[0], s[1]), s[2]), b = fmaxf(fmaxf(s[3], s[4]), s[5]);
    a = fmaxf(fmaxf(a, s[6]), s[7]); b = fmaxf(fmaxf(b, s[8]), s[9]); a = fmaxf(fmaxf(a, s[10]), s[11]); b = fmaxf(fmaxf(b, s[12]), s[13]); a = fmaxf(fmaxf(a, s[14]), s[15]);
    return fmaxf(a, b);
}
template <bool MASKED>
__device__ __forceinline__ void att_step(float& m, float& l, f32x16& o0, f32x16& o1, const LAS bf16_t* kt, const LAS bf16_t* vt, const bf16x8 (&qf)[4], unsigned vm, bool mine, int r, int h, int lane) {
    f32x16 s = att_scores(kt, qf, r, h);
    if (MASKED) {
#pragma unroll
        for (int i = 0; i < 16; ++i) s[i] = ((vm >> i) & 1u) ? s[i] : -1e30f;
    }
    float mx = max16(s); mx = fmaxf(mx, shx(mx, 32, lane));
    if (!MASKED) mx = mine ? mx : -1e30f;
    if (__any(mx > m + 8.f)) { const float mn = fmaxf(m, mx); const float alpha = __builtin_amdgcn_exp2f(m - mn); l *= alpha; o0 = o0 * alpha; o1 = o1 * alpha; m = mn; }
    const float moff = (m > -1e29f && (MASKED || mine)) ? m : 1e30f;
    f32x16 p; float ps = 0.f;
#pragma unroll
    for (int i = 0; i < 16; ++i) { p[i] = __builtin_amdgcn_exp2f(s[i] - moff); ps += p[i]; }
    l += ps;
    att_pv(o0, o1, vt, p, r, h);
}
__device__ __forceinline__ void att_block(float& m, float& bm, float& thr, f32x16& la, f32x16& o0, f32x16& o1, const LAS bf16_t* kt, const LAS bf16_t* vt, const bf16x8 (&qf)[4], unsigned vmA, unsigned vmB, bool mine, const bool masked, int r, int h, int lane, const bf16x8& ones) {
    const bool live = masked || mine;
    const float base = live ? bm : 1e30f, nb = -base;
    f32x16 sA, sB;
#pragma unroll
    for (int i = 0; i < 16; ++i) { sA[i] = nb; sB[i] = nb; }
#pragma unroll
    for (int ks = 0; ks < 4; ++ks) { const bf16x8 ka = *(const LAS bf16x8*)(kt + r * ATT_KP + 16 * ks + 8 * h), kb = *(const LAS bf16x8*)(kt + (32 + r) * ATT_KP + 16 * ks + 8 * h);
        sA = MFMA32(ka, qf[ks], sA); sB = MFMA32(kb, qf[ks], sB); }
    if (masked) {
#pragma unroll
        for (int i = 0; i < 16; ++i) { sA[i] = ((vmA >> i) & 1u) ? sA[i] : -1e30f; sB[i] = ((vmB >> i) & 1u) ? sB[i] : -1e30f; }
    }
    float mx = fmaxf(max16(sA), max16(sB));
    if (__builtin_expect(__any(mx > thr), 0)) {
        mx = fmaxf(mx, shx(mx, 32, lane));
        const float mxt = live ? mx + base : -1e30f, mn = fmaxf(m, mxt);
        const float alpha = __builtin_amdgcn_exp2f(m - mn); la[0] *= alpha; o0 = o0 * alpha; o1 = o1 * alpha; m = mn; { const bool mv_ = mn > -1e29f; bm = mv_ ? mn : 0.f; thr = mv_ ? 8.f : -1e29f; }
        const float d = (live && mn > -1e29f) ? mn - base : 0.f;
#pragma unroll
        for (int i = 0; i < 16; ++i) { sA[i] -= d; sB[i] -= d; }
    }
#pragma unroll
    for (int i = 0; i < 16; ++i) { sA[i] = __builtin_amdgcn_exp2f(sA[i]); sB[i] = __builtin_amdgcn_exp2f(sB[i]); }
#pragma unroll
    for (int s4 = 0; s4 < 4; ++s4) {
        u32x4 pw;
        if (s4 < 2) { pw.x = cvtpk(sA[8 * s4 + 0], sA[8 * s4 + 1]); pw.y = cvtpk(sA[8 * s4 + 2], sA[8 * s4 + 3]); pw.z = cvtpk(sA[8 * s4 + 4], sA[8 * s4 + 5]); pw.w = cvtpk(sA[8 * s4 + 6], sA[8 * s4 + 7]); }
        else { const int b = 8 * (s4 - 2); pw.x = cvtpk(sB[b + 0], sB[b + 1]); pw.y = cvtpk(sB[b + 2], sB[b + 3]); pw.z = cvtpk(sB[b + 4], sB[b + 5]); pw.w = cvtpk(sB[b + 6], sB[b + 7]); }
        const bf16x8 pb = __builtin_bit_cast(bf16x8, pw);
        la = MFMA32(ones, pb, la);
        o0 = MFMA32(*(const LAS bf16x8*)(vt + r * ATT_KP + 16 * s4 + 8 * h), pb, o0);
        o1 = MFMA32(*(const LAS bf16x8*)(vt + (32 + r) * ATT_KP + 16 * s4 + 8 * h), pb, o1);
    }
}
struct AttStage { u32x4 k, v; };
__device__ __forceinline__ void att_load(AttStage& sr, const bf16_t* kg, const bf16_t* vg, int vpitch, int tid, bool with_v) {
    const int rr = tid >> 3, ch = (tid & 7) * 8;
    sr.k = *(const u32x4*)(kg + (size_t)rr * 64 + ch);
    if (with_v) sr.v = *(const u32x4*)(vg + (size_t)rr * vpitch + ch);
}
__device__ __forceinline__ void att_store(LAS bf16_t* KT, LAS bf16_t* VT, const AttStage& sr, int tid, bool with_v) {
    const int rr = tid >> 3, ch = (tid & 7) * 8;
    *(LAS u32x4*)(KT + rr * ATT_KP + ch) = sr.k;
    if (with_v) { const int g16 = (tid & 7) >> 1, hf = tid & 1;
        *(LAS u32x2*)(VT + rr * ATT_KP + 16 * g16 + 4 * hf) = (u32x2){sr.v.x, sr.v.y}; *(LAS u32x2*)(VT + rr * ATT_KP + 16 * g16 + 8 + 4 * hf) = (u32x2){sr.v.z, sr.v.w}; }
}
__device__ __forceinline__ int next_bit(unsigned u0, unsigned u1, unsigned u2, unsigned u3, int from, int last) {
    for (int w = from >> 5; w < 4; ++w) {
        unsigned x = w == 0 ? u0 : (w == 1 ? u1 : (w == 2 ? u2 : u3));
        if (w == (from >> 5)) x &= ~0u << (from & 31);
        if (x) { const int p = w * 32 + __builtin_ctz(x); return p <= last ? p : -1; }
    }
    return -1;
}
__device__ __forceinline__ int next_pair(unsigned u0, unsigned u1, unsigned u2, unsigned u3, int fromp, int lastp) { const int bq = next_bit(u0, u1, u2, u3, 2 * fromp, 2 * lastp + 1); return bq >= 0 ? (bq >> 1) : -1; }
constexpr int ATT_BUF = 2 * 64 * ATT_KP;
#ifdef PROBE_MODE
#define NSA_BAR() do { const unsigned t0_ = (unsigned)__builtin_readcyclecounter(); __syncthreads(); pr_bar += (unsigned)__builtin_readcyclecounter() - t0_; } while (0)
#else
#define NSA_BAR() __syncthreads()
#endif
__device__ __forceinline__ void nsa_unit(const Args& a, unsigned char* wsp, int L, int bg, int qb, LAS unsigned char* lds, int tid) {
#ifdef PROBE_MODE
    unsigned pr_bar = 0u; const unsigned pr_t0 = (unsigned)__builtin_readcyclecounter();
#endif
    const int lane = tid & 63, wave = tid >> 6, r = lane & 31, h = lane >> 5;
    const int b = bg >> 1, g = bg & 1, t0 = qb * 64; const size_t rowbase = (size_t)b * SEQ + t0;
    LAS bf16_t* BUF = (LAS bf16_t*)lds;
    LAS float* IMP = (LAS float*)(lds + 2 * ATT_BUF * 2); LAS unsigned* SELM = (LAS unsigned*)(IMP + 64 * 128); LAS unsigned* UM = SELM + 256; LAS float* FIN = (LAS float*)(lds + 4 * ATT_BUF * 2) + tid;
    const bf16_t* KV = (const bf16_t*)(wsp + WS_KV); const bf16_t* KC = (const bf16_t*)(wsp + WS_KC) + (size_t)bg * 512 * 64; const bf16_t* VCT = (const bf16_t*)(wsp + WS_KC + 256 * 1024) + (size_t)bg * 64 * 512;
    const bf16_t* KSEL = KV + 2 * KV_STRIDE + (size_t)bg * SEQ * 64; const bf16_t* VSELT = KV + 3 * KV_STRIDE + (size_t)bg * 64 * SEQ;
    const bf16_t* KWIN = KV + 4 * KV_STRIDE + (size_t)bg * SEQ * 64; const bf16_t* VWINT = KV + 5 * KV_STRIDE + (size_t)bg * 64 * SEQ;
    const int tokl = 8 * wave + (r >> 2), hd = g * 4 + (r & 3), tq = t0 + tokl;
    bf16x8 qf[4];
    {   const bf16_t* qp = (const bf16_t*)(wsp + WS_Q) + (rowbase + tokl) * 512 + hd * 64 + 8 * h;
#pragma unroll
        for (int ks = 0; ks < 4; ++ks) qf[ks] = *(const bf16x8*)(qp + 16 * ks); }
    const float* gl = (const float*)(wsp + WS_SMALL) + (rowbase + tokl) * 32 + hd * 3;
    const float g_cmp = sigmoidf_(gl[0]), g_slc = sigmoidf_(gl[1]), g_win = sigmoidf_(gl[2]);
    for (int i = lane; i < 8 * 128; i += 64) IMP[wave * 8 * 128 + i] = 0.f;
    asm volatile("" :: "v"(qf[0]), "v"(qf[1]), "v"(qf[2]), "v"(qf[3]));
    f32x16 zero16;
#pragma unroll
    for (int i = 0; i < 16; ++i) zero16[i] = 0.f;
    u32x4 onew; onew.x = 0x3F803F80u; onew.y = 0x3F803F80u; onew.z = 0x3F803F80u; onew.w = 0x3F803F80u; asm volatile("" : "+v"(onew));
    const bf16x8 ones = __builtin_bit_cast(bf16x8, onew);
    AttStage sr;
#define ATT_PIPE_BEGIN(FIRST, NEXT, LOADX, WV) \
    { int blk = (FIRST), nb = -1, par = 0; \
      if (blk >= 0) { const int cb_ = blk; LOADX; att_store(BUF, BUF + 64 * ATT_KP, sr, tid, WV); nb = (NEXT); if (nb >= 0) { const int cb_ = nb; LOADX; } } \
      NSA_BAR(); \
      while (blk >= 0) { LAS bf16_t* KT = BUF + par * ATT_BUF; LAS bf16_t* VT = KT + 64 * ATT_KP; (void)VT;
#define ATT_PIPE_END(NEXT, LOADX, WV) \
        if (nb >= 0) { att_store(BUF + (par ^ 1) * ATT_BUF, BUF + (par ^ 1) * ATT_BUF + 64 * ATT_KP, sr, tid, WV); const int nb0_ = nb; blk = nb; nb = (NEXT); (void)nb0_; if (nb >= 0) { const int cb_ = nb; LOADX; } } else blk = -1; \
        NSA_BAR(); par ^= 1; } }
#define ATT_PIPE2(FIRST, NEXTOF, KPTR, VPTR, VPITCH, COMPUTE) \
    { AttStage srX, srY; int bA = (FIRST), bB = -1, bC = -1; __builtin_amdgcn_s_waitcnt(0x0F70);   \
      if (bA >= 0) { att_load(srX, KPTR(bA), VPTR(bA), VPITCH, tid, true); att_store(BUF, BUF + 64 * ATT_KP, srX, tid, true); bB = NEXTOF(bA); \
          if (bB >= 0) { att_load(srX, KPTR(bB), VPTR(bB), VPITCH, tid, true); bC = NEXTOF(bB); if (bC >= 0) att_load(srY, KPTR(bC), VPTR(bC), VPITCH, tid, true); } } \
      NSA_BAR(); \
      while (bA >= 0) { \
          { const int blk = bA; LAS bf16_t* KT = BUF; LAS bf16_t* VT = BUF + 64 * ATT_KP; COMPUTE } \
          int bD = -1; if (bB >= 0) { att_store(BUF + ATT_BUF, BUF + ATT_BUF + 64 * ATT_KP, srX, tid, true); if (bC >= 0) { bD = NEXTOF(bC); if (bD >= 0) att_load(srX, KPTR(bD), VPTR(bD), VPITCH, tid, true); } } \
          NSA_BAR(); if (bB < 0) break; \
          { const int blk = bB; LAS bf16_t* KT = BUF + ATT_BUF; LAS bf16_t* VT = BUF + ATT_BUF + 64 * ATT_KP; COMPUTE } \
          int bE = -1; if (bC >= 0) { att_store(BUF, BUF + 64 * ATT_KP, srY, tid, true); if (bD >= 0) { bE = NEXTOF(bD); if (bE >= 0) att_load(srY, KPTR(bE), VPTR(bE), VPITCH, tid, true); } } \
          NSA_BAR(); bA = bC; bB = bD; bC = bE; } }
#define ATT_PAIRS(FIRSTP, NEXTP, KPTR, VPTR, VPITCH, COMPUTE) \
    { AttStage sa, sb; int pA = (FIRSTP), pB = -1, par = 0; __builtin_amdgcn_s_waitcnt(0x0F70);   \
      if (pA >= 0) { att_load(sa, KPTR(2 * pA), VPTR(2 * pA), VPITCH, tid, true); att_load(sb, KPTR(2 * pA + 1), VPTR(2 * pA + 1), VPITCH, tid, true); \
          att_store(BUF, BUF + 64 * ATT_KP, sa, tid, true); att_store(BUF + ATT_BUF, BUF + ATT_BUF + 64 * ATT_KP, sb, tid, true); \
          pB = NEXTP(pA); if (pB >= 0) { att_load(sa, KPTR(2 * pB), VPTR(2 * pB), VPITCH, tid, true); att_load(sb, KPTR(2 * pB + 1), VPTR(2 * pB + 1), VPITCH, tid, true); } } \
      NSA_BAR(); \
      while (pA >= 0) { LAS bf16_t* PB_ = BUF + par * 2 * ATT_BUF; \
          { const int blk = 2 * pA; LAS bf16_t* KT = PB_; LAS bf16_t* VT = KT + 64 * ATT_KP; COMPUTE } \
          { const int blk = 2 * pA + 1; LAS bf16_t* KT = PB_ + ATT_BUF; LAS bf16_t* VT = KT + 64 * ATT_KP; COMPUTE } \
          if (pB >= 0) { LAS bf16_t* NB_ = BUF + (par ^ 1) * 2 * ATT_BUF; att_store(NB_, NB_ + 64 * ATT_KP, sa, tid, true); att_store(NB_ + ATT_BUF, NB_ + ATT_BUF + 64 * ATT_KP, sb, tid, true); \
              pA = pB; pB = NEXTP(pB); if (pB >= 0) { att_load(sa, KPTR(2 * pB), VPTR(2 * pB), VPITCH, tid, true); att_load(sb, KPTR(2 * pB + 1), VPTR(2 * pB + 1), VPITCH, tid, true); } } \
          else pA = -1; \
          NSA_BAR(); par ^= 1; } }
    const int nmaxq = tq >= 31 ? (((tq - 31) >> 4) < 510 ? ((tq - 31) >> 4) : 510) : -1;
    const int tq_lo = t0 + 8 * wave, nmax_lo = tq_lo >= 31 ? (((tq_lo - 31) >> 4) < 510 ? ((tq_lo - 31) >> 4) : 510) : -1, nmax_hi = (((tq_lo + 7 - 31) >> 4) < 510 ? ((tq_lo + 7 - 31) >> 4) : 510);
    const int ncb = (((t0 + 63 - 31) >> 4) >> 6) + 1;
    float m = -1e30f, l = 0.f;
    ATT_PIPE_BEGIN(0, (blk + 1 < ncb ? blk + 1 : -1), att_load(sr, KC + (size_t)cb_ * 64 * 64, VCT + cb_ * 64, 512, tid, false), false)
#pragma unroll
        for (int tl = 0; tl < 2; ++tl) {
            const int n0 = blk * 64 + tl * 32;
            if (n0 > nmax_hi) continue;
            f32x16 s = att_scores(KT + tl * 32 * ATT_KP, qf, r, h);
            if (n0 + 31 > nmax_lo) {
#pragma unroll
                for (int i = 0; i < 16; ++i) s[i] = (n0 + (i & 3) + 8 * (i >> 2) + 4 * h) <= nmaxq ? s[i] : -1e30f;
            }
            float mx = max16(s); mx = fmaxf(mx, shx(mx, 32, lane));
            const float mn = fmaxf(m, mx), moff = mn > -1e29f ? mn : 1e30f; float ps = 0.f;
#pragma unroll
            for (int i = 0; i < 16; ++i) ps += __builtin_amdgcn_exp2f(s[i] - moff);
            l = l * __builtin_amdgcn_exp2f(m - mn) + ps; m = mn;
        }
    ATT_PIPE_END((nb0_ + 1 < ncb ? nb0_ + 1 : -1), att_load(sr, KC + (size_t)cb_ * 64 * 64, VCT + cb_ * 64, 512, tid, false), false)
    l += shx(l, 32, lane);
    {
        const float invl = l > 0.f ? 1.0f / l : 0.f; f32x16 o0 = zero16, o1 = zero16;
        ATT_PIPE_BEGIN(0, (blk + 1 < ncb ? blk + 1 : -1), att_load(sr, KC + (size_t)cb_ * 64 * 64, VCT + cb_ * 64, 512, tid, true), true)
#pragma unroll
            for (int tl = 0; tl < 2; ++tl) {
                const int n0 = blk * 64 + tl * 32;
                if (n0 > nmax_hi) continue;
                f32x16 s = att_scores(KT + tl * 32 * ATT_KP, qf, r, h); f32x16 p;
                if (n0 + 31 > nmax_lo) {
#pragma unroll
                    for (int i = 0; i < 16; ++i) s[i] = (n0 + (i & 3) + 8 * (i >> 2) + 4 * h) <= nmaxq ? s[i] : -1e30f;
                }
#pragma unroll
                for (int i = 0; i < 16; ++i) p[i] = __builtin_amdgcn_exp2f(s[i] - m) * invl;
                att_pv(o0, o1, VT + tl * 32, p, r, h);
#pragma unroll
                for (int rq = 0; rq < 4; ++rq) {
                    float av = 2.0f * (p[4 * rq] + p[4 * rq + 1] + p[4 * rq + 2]) + p[4 * rq + 3], bvv = p[4 * rq + 3];
                    av += dpp_f(av, 0xB1); av += dpp_f(av, 0x4E); bvv += dpp_f(bvv, 0xB1); bvv += dpp_f(bvv, 0x4E);
                    const int mb = (n0 >> 2) + 2 * rq + h;
                    if ((r & 3) == 0) { LAS float* ip = IMP + tokl * 128 + mb; ip[0] += av; }
                    if ((r & 3) == 0 && mb + 1 < 128) { LAS float* ip = IMP + tokl * 128 + mb + 1; ip[0] += bvv; }
                }
            }
        ATT_PIPE_END((nb0_ + 1 < ncb ? nb0_ + 1 : -1), att_load(sr, KC + (size_t)cb_ * 64 * 64, VCT + cb_ * 64, 512, tid, true), true)
#pragma unroll
        for (int i = 0; i < 16; ++i) { FIN[i * 512] = o0[i] * g_cmp; FIN[(16 + i) * 512] = o1[i] * g_cmp; }
    }
    {
        const int cur = qb;
        const int b0 = lane, b1 = lane + 64; const bool val0 = b0 <= cur, val1 = b1 <= cur;
        const bool f0 = (b0 == 0 || b0 == cur || b0 == cur - 1), f1 = (b1 == 0 || b1 == cur || b1 == cur - 1);
        unsigned long long ua0 = 0ull, ua1 = 0ull;
#pragma unroll 1
        for (int tk = 0; tk < 2; ++tk) {
            unsigned k0[4], k1[4], T[4]; unsigned long long m0[4], m1[4];
#pragma unroll
            for (int u = 0; u < 4; ++u) { const LAS float* row = IMP + (8 * wave + tk + 2 * u) * 128; k0[u] = val0 ? __float_as_uint(f0 ? 1e4f : row[lane]) : 0u; k1[u] = val1 ? __float_as_uint(f1 ? 1e4f : row[64 + lane]) : 0u; T[u] = 0u; }
            if (cur + 1 <= 16) {
#pragma unroll
                for (int u = 0; u < 4; ++u) { m0[u] = __ballot(val0); m1[u] = __ballot(val1); }
            } else {
                int cn[4] = {17, 17, 17, 17};
#pragma unroll 1
                for (int bit = 30; bit >= 0; --bit) {
#pragma unroll
                    for (int u = 0; u < 4; ++u) { const unsigned c = T[u] | (1u << bit);
                        const int n = __popcll(__ballot(k0[u] >= c)) + __popcll(__ballot(k1[u] >= c));
                        if (n >= 16) { T[u] = c; cn[u] = n; } }
                    if (cn[0] == 16 && cn[1] == 16 && cn[2] == 16 && cn[3] == 16) break; }
#pragma unroll
                for (int u = 0; u < 4; ++u) {
                    const unsigned long long g0 = __ballot(val0 && k0[u] > T[u]), g1 = __ballot(val1 && k1[u] > T[u]), e0 = __ballot(val0 && k0[u] == T[u]), e1 = __ballot(val1 && k1[u] == T[u]);
                    const int need = 16 - (__popcll(g0) + __popcll(g1));
                    const int r0 = (int)__builtin_amdgcn_mbcnt_hi((unsigned)(e0 >> 32), __builtin_amdgcn_mbcnt_lo((unsigned)e0, 0u));
                    const int r1 = __popcll(e0) + (int)__builtin_amdgcn_mbcnt_hi((unsigned)(e1 >> 32), __builtin_amdgcn_mbcnt_lo((unsigned)e1, 0u));
                    m0[u] = __ballot(val0 && (k0[u] > T[u] || (k0[u] == T[u] && r0 < need))); m1[u] = __ballot(val1 && (k1[u] > T[u] || (k1[u] == T[u] && r1 < need))); }
            }
#pragma unroll
            for (int u = 0; u < 4; ++u) { ua0 |= m0[u]; ua1 |= m1[u]; }
            if (lane == 0) {
#pragma unroll
                for (int u = 0; u < 4; ++u) { const int tokw = 8 * wave + tk + 2 * u; SELM[tokw * 4 + 0] = (unsigned)m0[u]; SELM[tokw * 4 + 1] = (unsigned)(m0[u] >> 32); SELM[tokw * 4 + 2] = (unsigned)m1[u]; SELM[tokw * 4 + 3] = (unsigned)(m1[u] >> 32); } }
        }
        if (lane == 0) { UM[4 * wave + 0] = (unsigned)ua0; UM[4 * wave + 1] = (unsigned)(ua0 >> 32); UM[4 * wave + 2] = (unsigned)ua1; UM[4 * wave + 3] = (unsigned)(ua1 >> 32); }
    }
    NSA_BAR();
    {
        m = -1e30f; float bm = 0.f, thr = -1e29f; f32x16 la = zero16; f32x16 o0 = zero16, o1 = zero16;
        const unsigned sw0 = SELM[tokl * 4 + 0], sw1 = SELM[tokl * 4 + 1], sw2 = SELM[tokl * 4 + 2], sw3 = SELM[tokl * 4 + 3];
        unsigned um0 = 0u, um1 = 0u, um2 = 0u, um3 = 0u;
#pragma unroll
        for (int w = 0; w < 8; ++w) { um0 |= UM[4 * w + 0]; um1 |= UM[4 * w + 1]; um2 |= UM[4 * w + 2]; um3 |= UM[4 * w + 3]; }
#define SEL_NEXT(x) next_pair(um0, um1, um2, um3, (x) + 1, qb >> 1)
#define SEL_K(x) (KSEL + (size_t)(x) * 64 * 64)
#define SEL_V(x) (VSELT + (x) * 64)
#define SEL_BODY { const int be_ = blk & ~1; const unsigned sw = be_ < 32 ? sw0 : (be_ < 64 ? sw1 : (be_ < 96 ? sw2 : sw3)); const bool mine = (sw >> (blk & 31)) & 1u;        \
            if (__any(mine)) { const bool masked = !(blk < qb); unsigned vmA = 0u, vmB = 0u; \
                if (masked) { \
                    _Pragma("unroll") for (int i = 0; i < 16; ++i) { const int pos = blk * 64 + (i & 3) + 8 * (i >> 2) + 4 * h; vmA |= ((mine && pos <= tq) ? 1u : 0u) << i; vmB |= ((mine && pos + 32 <= tq) ? 1u : 0u) << i; } } \
                att_block(m, bm, thr, la, o0, o1, KT, VT, qf, vmA, vmB, mine, masked, r, h, lane, ones); } }
        ATT_PAIRS(next_pair(um0, um1, um2, um3, 0, qb >> 1), SEL_NEXT, SEL_K, SEL_V, SEQ, SEL_BODY)
#undef SEL_NEXT
#undef SEL_K
#undef SEL_V
#undef SEL_BODY
        const float sc = g_slc / fmaxf(la[0], 1e-30f);
#pragma unroll
        for (int i = 0; i < 16; ++i) { FIN[i * 512] += o0[i] * sc; FIN[(16 + i) * 512] += o1[i] * sc; }
    }
    {
        m = -1e30f; float bm = 0.f, thr = -1e29f; f32x16 la = zero16; f32x16 o0 = zero16, o1 = zero16;
#define WIN_NEXT(x) ((x) + 1 <= (qb >> 1) ? (x) + 1 : -1)
#define WIN_K(x) (KWIN + (size_t)(x) * 64 * 64)
#define WIN_V(x) (VWINT + (x) * 64)
#define WIN_BODY { const bool masked = !(blk > qb - 8 && blk < qb); unsigned vmA = 0u, vmB = 0u; \
            if (masked) { \
                _Pragma("unroll") for (int i = 0; i < 16; ++i) { const int pos = blk * 64 + (i & 3) + 8 * (i >> 2) + 4 * h; vmA |= ((pos <= tq && pos + 512 > tq) ? 1u : 0u) << i; vmB |= ((pos + 32 <= tq && pos + 32 + 512 > tq) ? 1u : 0u) << i; } } \
            if (!masked || __any((vmA | vmB) != 0u)) att_block(m, bm, thr, la, o0, o1, KT, VT, qf, vmA, vmB, true, masked, r, h, lane, ones); }
        ATT_PAIRS(((qb >= 8 ? qb - 8 : 0) >> 1), WIN_NEXT, WIN_K, WIN_V, SEQ, WIN_BODY)
#undef WIN_NEXT
#undef WIN_K
#undef WIN_V
#undef WIN_BODY
        const float sc = g_win / fmaxf(la[0], 1e-30f);
        bf16_t* op = (bf16_t*)(wsp + WS_ONSA) + (rowbase + tokl) * 1536 + hd * 64 + 4 * h;
#pragma unroll
        for (int rq = 0; rq < 4; ++rq) {
            f32x4 f0, f1;
#pragma unroll
            for (int k = 0; k < 4; ++k) { f0[k] = FIN[(4 * rq + k) * 512] + o0[4 * rq + k] * sc; f1[k] = FIN[(16 + 4 * rq + k) * 512] + o1[4 * rq + k] * sc; }
            u32x2 w0; w0.x = cvtpk(f0[0], f0[1]); w0.y = cvtpk(f0[2], f0[3]); *(u32x2*)(op + 8 * rq) = w0;
            u32x2 w1; w1.x = cvtpk(f1[0], f1[1]); w1.y = cvtpk(f1[2], f1[3]); *(u32x2*)(op + 32 + 8 * rq) = w1; }
    }
#undef ATT_PIPE_BEGIN
#undef ATT_PIPE_END
#undef ATT_PIPE2
    NSA_BAR();
#ifdef PROBE_MODE
    if (blockIdx.x == 0 && L == 0 && qb == PROBE_QB && tid == PROBE_TID) { const unsigned tt = (unsigned)__builtin_readcyclecounter() - pr_t0; float* pp = (float*)(wsp + WS_CTL + 16384);
        pp[0] = PROBE_MODE == 1 ? (float)pr_bar / (float)tt : (float)tt * (1.0f / 2000000.0f); }
#endif
}


constexpr int CMP_AP = 2056;
__device__ __forceinline__ void compress_unit(const Args& a, unsigned char* wsp, int L, int u, LAS unsigned char* lds, int tid) {
    const int lane = tid & 63, wave = tid >> 6, q = lane >> 4, c16 = lane & 15;
    const int which = u >> 6, R0 = (u & 63) * 32;
    const bf16_t* A = (const bf16_t*)(wsp + WS_KV) + (size_t)which * KV_STRIDE + (size_t)R0 * 1024;
    const bf16_t* W1T = (const bf16_t*)(wsp + WS_W + (which ? W_W1V : W_W1K)); const bf16_t* W2T = (const bf16_t*)(wsp + WS_W + (which ? W_W2V : W_W2K));
    LAS bf16_t* AT = (LAS bf16_t*)lds; LAS float* BS = (LAS float*)(lds + 32 * CMP_AP * 2);
    const bf16_t* wb = W1T + (size_t)(32 * wave + c16) * 2048 + 8 * q;
    bf16x8 bq0[8], bq1[8];
#pragma unroll
    for (int i = 0; i < 8; ++i) { bq0[i] = *(const bf16x8*)(wb + 32 * i); bq1[i] = *(const bf16x8*)(wb + (size_t)16 * 2048 + 32 * i); }
#pragma unroll 4
    for (int p = 0; p < 16; ++p) { const int idx = p * NTHREADS + tid, row = idx >> 8, ch = (idx & 255) * 8; *(LAS u32x4*)(AT + row * CMP_AP + ch) = *(const u32x4*)(A + (size_t)row * 1024 + ch); }
    if (tid < 256) { const float* pp = (const float*)(wsp + WS_BIASP) + which * 32 * 256 + tid; float sacc = 0.f;
#pragma unroll 8
        for (int ks = 0; ks < 32; ++ks) sacc += pp[ks * 256];
        BS[tid] = sacc; }
    __syncthreads();
    f32x4 acc[2][2];
#pragma unroll
    for (int mt = 0; mt < 2; ++mt)
#pragma unroll
        for (int nt = 0; nt < 2; ++nt) acc[mt][nt] = (f32x4){0.f, 0.f, 0.f, 0.f};
    bf16x8 bn0[8], bn1[8];
#pragma unroll 1
    for (int kb = 0; kb < 8; kb += 2) {
#pragma unroll
        for (int i = 0; i < 8; ++i) { bn0[i] = *(const bf16x8*)(wb + 32 * (8 * kb + 8 + i)); bn1[i] = *(const bf16x8*)(wb + (size_t)16 * 2048 + 32 * (8 * kb + 8 + i)); }
#pragma unroll
        for (int i = 0; i < 8; ++i) { const int ks = 8 * kb + i;
            const bf16x8 a0 = *(const LAS bf16x8*)(AT + c16 * CMP_AP + 32 * ks + 8 * q), a1 = *(const LAS bf16x8*)(AT + (16 + c16) * CMP_AP + 32 * ks + 8 * q);
            acc[0][0] = MFMA16(a0, bq0[i], acc[0][0]); acc[0][1] = MFMA16(a0, bq1[i], acc[0][1]); acc[1][0] = MFMA16(a1, bq0[i], acc[1][0]); acc[1][1] = MFMA16(a1, bq1[i], acc[1][1]); }
        if (kb + 2 < 8) {
#pragma unroll
            for (int i = 0; i < 8; ++i) { bq0[i] = *(const bf16x8*)(wb + 32 * (8 * kb + 16 + i)); bq1[i] = *(const bf16x8*)(wb + (size_t)16 * 2048 + 32 * (8 * kb + 16 + i)); } }
#pragma unroll
        for (int i = 0; i < 8; ++i) { const int ks = 8 * kb + 8 + i;
            const bf16x8 a0 = *(const LAS bf16x8*)(AT + c16 * CMP_AP + 32 * ks + 8 * q), a1 = *(const LAS bf16x8*)(AT + (16 + c16) * CMP_AP + 32 * ks + 8 * q);
            acc[0][0] = MFMA16(a0, bn0[i], acc[0][0]); acc[0][1] = MFMA16(a0, bn1[i], acc[0][1]); acc[1][0] = MFMA16(a1, bn0[i], acc[1][0]); acc[1][1] = MFMA16(a1, bn1[i], acc[1][1]); }
    }
    __syncthreads();
    LAS bf16_t* H = AT; constexpr int HP = 264;
#pragma unroll
    for (int mt = 0; mt < 2; ++mt)
#pragma unroll
        for (int nt = 0; nt < 2; ++nt) { const int col = 32 * wave + 16 * nt + c16; const float bia = BS[col];
#pragma unroll
            for (int j = 0; j < 4; ++j) H[(16 * mt + 4 * q + j) * HP + col] = (bf16_t)f2bf(gelu_tanh_fast(acc[mt][nt][j] + bia)); }
    __syncthreads();
    {   const int mt = wave & 1, nt2 = wave >> 1; f32x4 d = {0.f, 0.f, 0.f, 0.f};
#pragma unroll
        for (int ks = 0; ks < 8; ++ks) { const bf16x8 af = *(const LAS bf16x8*)(H + (16 * mt + c16) * HP + 32 * ks + 8 * q), bf = *(const bf16x8*)(W2T + (16 * nt2 + c16) * 256 + 32 * ks + 8 * q); d = MFMA16(af, bf, d); }
        bf16_t* out = (bf16_t*)(wsp + WS_KC + (which ? 256 * 1024 : 0));
#pragma unroll
        for (int j = 0; j < 4; ++j) { const int R = R0 + 16 * mt + 4 * q + j, col = 16 * nt2 + c16; const bf16_t hv = (bf16_t)f2bf(d[j]);
            if (!which) out[(size_t)R * 64 + col] = hv; else out[((size_t)(R >> 9) * 64 + col) * 512 + (R & 511)] = hv; } }
    __syncthreads();
}

__device__ __forceinline__ void mixers_p2(const Args& a, unsigned char* wsp, int L, LAS unsigned char* lds, int bid, int G, int wave0) {
    const int tid = tid_fresh(wave0);
#if HAVE_NSA
    for (int rep = 0; rep < NREP(12); ++rep) for (int u = bid; u < 128; u += G) compress_unit(a, wsp, L, u, lds, tid);
#endif
#if HAVE_SSD
    for (int rep = 0; rep < NREP(16); ++rep) for (int u = bid; u < 256; u += G) ssd_a_unit(a, wsp, L, u, lds, tid);
#endif
#if HAVE_LRU
    if (G == 256) { if (bid >= 128) { for (int rep = 0; rep < NREP(17); ++rep) { lru_tile<false>(a, wsp, L, bid - 128, lds, tid); lru_tile<false>(a, wsp, L, bid, lds, tid); } } }
    else for (int rep = 0; rep < NREP(17); ++rep) for (int u = bid; u < 256; u += G) lru_tile<false>(a, wsp, L, u, lds, tid);
#endif
}
__device__ __forceinline__ void mixers_p3(const Args& a, unsigned char* wsp, int L, LAS unsigned char* lds, int bid, int G, int wave0) {
    const int tid = tid_fresh(wave0);
#if HAVE_NSA
    for (int rep = 0; rep < NREP(3); ++rep)
    for (int pr0 = bid; pr0 < 256; pr0 += G) { const int pr = (G == 256) ? ((pr0 & 7) * 32 + (pr0 >> 3)) : pr0;
        const int bgp = pr >> 6, i = pr & 63; nsa_unit(a, wsp, L, bgp, 127 - i, lds, tid); nsa_unit(a, wsp, L, bgp, i, lds, tid); }
#endif
#if HAVE_SSD
    {   const int tid2 = tid_fresh(wave0); for (int id = bid * NTHREADS + tid2; id < 65536; id += G * NTHREADS) ssd_scan(a, wsp, id); }
#endif
#if HAVE_LRU
    {   const int tid3 = tid_fresh(wave0); for (int id = bid * NTHREADS + tid3; id < 1024; id += G * NTHREADS) lru_carry(a, wsp, id); }
#endif
}
__device__ __forceinline__ void mixers_p4(const Args& a, unsigned char* wsp, int L, LAS unsigned char* lds, int bid, int G, int wave0) {
    const int tid = tid_fresh(wave0);
#if HAVE_SSD
    for (int rep = 0; rep < NREP(18); ++rep) for (int u = bid; u < 256; u += G) ssd_b_unit(a, wsp, L, u, lds, tid);
#endif
#if HAVE_LRU
    for (int rep = 0; rep < NREP(19); ++rep) for (int u = bid; u < 256; u += G) lru_tile<true>(a, wsp, L, u, lds, tid);
#endif
}
#ifndef PH_MASK
#define PH_MASK 0xFFFF
#endif
#define PHON(k) (((PH_MASK) >> (k)) & 1)
#ifdef PHASE_PROBE
#define PROBE_SEL int
#define PROBE_OFF 20480
#else
#define PROBE_SEL int
#define PROBE_OFF 16384
#endif
#ifndef MIXERS
#define MIXERS 1
#endif
constexpr int PH_PER_LAYER = 10, N_PHASES = 1 + PH_PER_LAYER * DEPTH;

#define FRESH() int G = G0, bid = bid0; asm volatile("" : "+s"(G), "+s"(bid)); GAS_ unsigned char* wsg_ = (GAS_ unsigned char*)a.ws; asm volatile("" : "+s"(wsg_)); unsigned char* ws = (unsigned char*)wsg_; GAS_ float* xfg_ = (GAS_ float*)a.out; asm volatile("" : "+s"(xfg_)); float* XF = (float*)xfg_;     bf16_t* XB = (bf16_t*)(ws + WS_XB); bf16_t* PB = (bf16_t*)(ws + WS_PB); unsigned char* W = ws + WS_W; unsigned* MCNT = (unsigned*)(ws + WS_CTL + CTL_MOECNT) + (L < 0 ? 0 : L) * 1024; (void)XB; (void)PB; (void)W; (void)MCNT; (void)XF;
#define RUN(k) (lo <= (k) && (k) < hi)
#ifdef PHASE_PROBE
#define PSTAMP(slot) do { if ((slot) != PHASE_PROBE_A && (slot) != PHASE_PROBE_B) break; int b0_ = bid0 | wave0; asm volatile("" : "+s"(b0_)); if (b0_ == 0) { unsigned m_ = ~0u; asm volatile("" : "+s"(m_)); if (__builtin_amdgcn_mbcnt_hi(m_, __builtin_amdgcn_mbcnt_lo(m_, 0u)) == 0u) ((unsigned long long*)(a.ws + WS_CTL + 20480))[(slot)] = __builtin_readcyclecounter(); } } while (0)
#else
#define PSTAMP(slot) do { } while (0)
#endif
#define SEAM(k) do { if (RUN(k) && RUN((k) + 1)) { PSTAMP(2 * (k)); for (int rep_ = 0; rep_ < NREP(15); ++rep_) { xcd_barrier((unsigned*)(a.ws + WS_CTL + 45056), (volatile LAS unsigned*)(lds + LDS_BYTES - 16), nbar, (unsigned)G0, wave0); } PSTAMP(2 * (k) + 1); } } while (0)
__device__ __forceinline__ void grid_barrier(unsigned* bar, unsigned target, int wave0) {
    asm volatile("s_waitcnt vmcnt(0) lgkmcnt(0)" ::: "memory");
    __syncthreads();
    if (wave0 == 0) {
        unsigned m = ~0u; asm volatile("" : "+s"(m));
        if (__builtin_amdgcn_mbcnt_hi(m, __builtin_amdgcn_mbcnt_lo(m, 0u)) == 0u) {
            __builtin_amdgcn_fence(__ATOMIC_RELEASE, "agent");
            asm volatile("s_waitcnt vmcnt(0)" ::: "memory");
            __hip_atomic_fetch_add(bar, 1u, __ATOMIC_RELAXED, __HIP_MEMORY_SCOPE_AGENT);
            unsigned spins = 0u;
            while (__hip_atomic_load(bar, __ATOMIC_RELAXED, __HIP_MEMORY_SCOPE_AGENT) < target) { __builtin_amdgcn_s_sleep(2); if (++spins > (1u << 27)) break; }
            __builtin_amdgcn_fence(__ATOMIC_ACQUIRE, "agent");
            asm volatile("s_waitcnt vmcnt(0)" ::: "memory");
        }
    }
    __syncthreads();
}
#define XB_TMO      128
#define XB_XCNT(j)  (256  + 64 * (j))
#define XB_XSUB(j)  (1280 + 64 * (j))
#define XB_XGEN(j)  (2304 + 64 * (j))
#define XB_TOP      3328
#define XB_TOPGEN   3392
#define XB_SPIN_CAP (1u << 22)
__device__ __forceinline__ unsigned xb_ld(unsigned* p) { return __hip_atomic_load(p, __ATOMIC_RELAXED, __HIP_MEMORY_SCOPE_AGENT); }
__device__ __forceinline__ unsigned xb_add(unsigned* p, unsigned v) { return __hip_atomic_fetch_add(p, v, __ATOMIC_RELAXED, __HIP_MEMORY_SCOPE_AGENT); }
__device__ __forceinline__ unsigned xb_xcc_id() { return (unsigned)__builtin_amdgcn_s_getreg((3 << 11) | 20) & 0xFu; }
#define XB_SPIN(cond, bar) do { unsigned _sp = 0; while (cond) { __builtin_amdgcn_s_sleep(1); if ((++_sp & 255u) == 0u) { if (xb_ld(&(bar)[XB_TMO])) break; if (_sp > XB_SPIN_CAP) { atomicAdd(&(bar)[XB_TMO], 1u); break; } } } } while (0)
__device__ __forceinline__ void xcd_barrier(unsigned* bar, volatile LAS unsigned* st, unsigned x, unsigned G, int wave0) {
    asm volatile("s_waitcnt vmcnt(0) lgkmcnt(0)" ::: "memory");
    __syncthreads();
    if (wave0 == 0) {
        unsigned m = ~0u; asm volatile("" : "+s"(m));
        if (__builtin_amdgcn_mbcnt_hi(m, __builtin_amdgcn_mbcnt_lo(m, 0u)) == 0u) {
            unsigned nloc = st[0], nx = st[1];
            if (nloc == 0u) {
                unsigned sum, cnt, mine, sp = 0u;
                for (;;) { sum = 0u; cnt = 0u; mine = 0u;
#pragma unroll
                    for (unsigned j = 0; j < 16; ++j) { const unsigned c = xb_ld(&bar[XB_XCNT(j)]); sum += c; cnt += (c > 0u) ? 1u : 0u; mine = (j == x) ? c : mine; }
                    if (sum == G) break;
                    __builtin_amdgcn_s_sleep(1);
                    if ((++sp & 255u) == 0u) { if (xb_ld(&bar[XB_TMO])) break; if (sp > XB_SPIN_CAP) { atomicAdd(&bar[XB_TMO], 1u); break; } } }
                nloc = mine > 0u ? mine : 1u; nx = cnt > 0u ? cnt : 1u; st[0] = nloc; st[1] = nx; }
            const unsigned old = xb_add(&bar[XB_XSUB(x)], 1u), gen = old / nloc;
            if (old + 1u == (gen + 1u) * nloc) {
                __builtin_amdgcn_fence(__ATOMIC_RELEASE, "agent");
                asm volatile("s_waitcnt vmcnt(0)" ::: "memory");
                const unsigned og = xb_add(&bar[XB_TOP], 1u), tg = og / nx;
                if (og + 1u == (tg + 1u) * nx) xb_add(&bar[XB_TOPGEN], 1u);
                else XB_SPIN(xb_ld(&bar[XB_TOPGEN]) == tg, bar);
                __builtin_amdgcn_fence(__ATOMIC_ACQUIRE, "agent");
                xb_add(&bar[XB_XGEN(x)], 1u);
                asm volatile("s_waitcnt vmcnt(0)" ::: "memory");
            } else {
                XB_SPIN(xb_ld(&bar[XB_XGEN(x)]) == gen, bar);
                __builtin_amdgcn_fence(__ATOMIC_ACQUIRE, "agent");
                asm volatile("s_waitcnt vmcnt(0)" ::: "memory");
            }
        }
    }
    __syncthreads();
}
template <int L>
__device__ __forceinline__ void layer_phases(const Args& a, LAS unsigned char* lds, unsigned& nbar, const int G0, const int bid0, const int wave0, const int lo, const int hi) {
        const int P = 1 + PH_PER_LAYER * L;
      if constexpr (L >= 0) {
        if (PHON(1) && RUN(P + 0)) { FRESH();
            pg8::Gemm g{XB, (const bf16_t*)(W + W_WIN), TOK, 3840, 1024, 1024, 1024}; pg8::StaticOrder S; S.init(TOK, 3840, G, bid);
            pg8::EpiInProj E{(bf16_t*)(ws + WS_Q), (bf16_t*)(ws + WS_KV), (bf16_t*)(ws + WS_Z), (bf16_t*)(ws + WS_XBC), (bf16_t*)(ws + WS_LX), (bf16_t*)(ws + WS_LY), (float*)(ws + WS_SMALL), KV_STRIDE};
            for (int rep = 0; rep < NREP(1); ++rep) pg8::gemm_phase<pg8::EpiInProj, pg8::StaticOrder, true, true>(lds, g, S, E, wave0);
        }
        SEAM(P + 0);
#if MIXERS
        if (PHON(2) && RUN(P + 1)) { FRESH(); for (int rep = 0; rep < NREP(2); ++rep) mixers_p2(a, ws, L, lds, bid, G, wave0); }
        SEAM(P + 1);
        if (PHON(3) && RUN(P + 2)) { FRESH(); mixers_p3(a, ws, L, lds, bid, G, wave0); }
        SEAM(P + 2);
        if (PHON(4) && RUN(P + 3)) { FRESH(); for (int rep = 0; rep < NREP(4); ++rep) mixers_p4(a, ws, L, lds, bid, G, wave0); }
        SEAM(P + 3);
        if (PHON(5) && RUN(P + 4)) { FRESH();
            pg8::StaticOrder S4; S4.init(TOK, 1024, G, bid); pg8::Unit base;
            for (int rep = 0; rep < NREP(5); ++rep)
            for (int j = 0; S4.next(j, base); ++j) {
                {   pg8::Gemm g{XB, (const bf16_t*)(W + W_WIN) + (size_t)3840 * 1024, TOK, 3072, 1024, 1024, 1024}; pg8::StrideOrder S{base.pm, base.pn, 4, 3};
                    pg8::EpiSigBf16 E{(bf16_t*)(ws + WS_MERGE), 3072};
                    pg8::gemm_phase<pg8::EpiSigBf16, pg8::StrideOrder, true, true>(lds, g, S, E, wave0); }
                {   pg8::Gemm g{(const bf16_t*)(ws + WS_ONSA), (const bf16_t*)(W + W_PROJ), TOK, 1024, 1536, 1536, 1536}; pg8::StrideOrder S{base.pm, base.pn, 0, 1};
                    pg8::EpiMixK E{(bf16_t*)(ws + WS_MIXB), (const bf16_t*)(ws + WS_MERGE), (const float*)(ws + WS_SSQ)};
                    pg8::gemm_phase<pg8::EpiMixK, pg8::StrideOrder, true, true>(lds, g, S, E, wave0); }
            }
        }
        SEAM(P + 4);
        if (PHON(6) && RUN(P + 5)) { FRESH();
            pg8::Gemm g{(const bf16_t*)(ws + WS_MIXB), (const bf16_t*)(W + W_WOUT), TOK, 1024, 1024, 1024, 1024}; pg8::StaticOrder S; S.init(TOK, 1024, G, bid);
            pg8::EpiResid E{XB, XF, ALPHA};
            pg8::gemm_phase<pg8::EpiResid, pg8::StaticOrder, true, true>(lds, g, S, E, wave0);
        }
        SEAM(P + 5);
#else
        if (PHON(6) && RUN(P + 5)) { FRESH();
            const float* xin = L == 0 ? a.in[0] : (const float*)XF;
            const int tid = tid_fresh(wave0); for (size_t i = (size_t)bid * NTHREADS + tid; i < (size_t)TOK * 256; i += (size_t)G * NTHREADS) { const f32x4 v = *(const f32x4*)(xin + 4 * i); *(f32x4*)(XF + 4 * i) = v * ALPHA; }
        }
        SEAM(P + 5);
#endif
        if (PHON(7) && RUN(P + 6)) { FRESH(); ln_rows<true, false, false>(XF, a.in[26] + L * 1024, a.in[27] + L * 1024, XB, a.in[28], a.in[29], (int*)(ws + WS_ELIST), (float*)(ws + WS_EW), MCNT, nullptr, nullptr, lds, bid, G, wave0); }
        SEAM(P + 6);
        if (PHON(8) && RUN(P + 7)) { FRESH();
            {   pg8::Unit u;
                LAS int* NT = (LAS int*)(lds + pg8::STAGE_BYTES); LAS unsigned short* TT = (LAS unsigned short*)(lds + pg8::STAGE_BYTES + 64);
                LAS int* CN = (LAS int*)(lds + pg8::STAGE_BYTES + 512); LAS int* ELS = (LAS int*)(lds + pg8::STAGE_BYTES + 1024);
                unsigned* DONE = (unsigned*)(ws + WS_CTL + 40960) + L * 512;
                if (wave0 == 0) {
                    unsigned m_ = ~0u; asm volatile("" : "+s"(m_)); const unsigned ln0_ = __builtin_amdgcn_mbcnt_hi(m_, __builtin_amdgcn_mbcnt_lo(m_, 0u));
                    const int cmine = (int)__hip_atomic_load(MCNT + (ln0_ & 15u) * 64, __ATOMIC_RELAXED, __HIP_MEMORY_SCOPE_AGENT);
                    if (ln0_ < 16u) CN[ln0_] = cmine;
                    int pre[17]; pre[0] = 0;
#pragma unroll
                    for (int e = 0; e < 16; ++e) pre[e + 1] = pre[e] + ((__builtin_amdgcn_readlane(cmine, e) + 255) >> 8);
#pragma unroll 1
                    for (int T = (int)ln0_; T < pre[16]; T += 64) { int e = 0, pe = 0;
#pragma unroll
                        for (int k = 1; k < 16; ++k) { const bool ge = T >= pre[k]; e += ge ? 1 : 0; pe = ge ? pre[k] : pe; }
                        TT[T] = (unsigned short)(e | ((T - pe) << 8)); }
                    if (ln0_ == 0u) NT[0] = pre[16]; }
                __syncthreads();
                const int ntile = __builtin_amdgcn_readfirstlane(NT[0]), nmoe = 2 * ntile, nall = nmoe + 256 + 4 * ntile;
                unsigned* ticket = (unsigned*)(ws + WS_CTL + 24576) + L * 64;
#define TW_() ({ int o_ = LDS_BYTES - 32; asm volatile("" : "+s"(o_)); (volatile LAS int*)(lds + o_); })
                for (;;) {
                    __syncthreads();
                    if (wave0 == 0) { unsigned m_ = ~0u; asm volatile("" : "+s"(m_)); if (__builtin_amdgcn_mbcnt_hi(m_, __builtin_amdgcn_mbcnt_lo(m_, 0u)) == 0u) TW_()[0] = (int)__hip_atomic_fetch_add(ticket, 1u, __ATOMIC_RELAXED, __HIP_MEMORY_SCOPE_AGENT); }
                    __syncthreads();
                    const int t = __builtin_amdgcn_readfirstlane(TW_()[0]);
                    if (t >= nall) break;
                    if (t < nmoe) {
                        const int T = t >> 1, te = __builtin_amdgcn_readfirstlane((int)TT[T]), ee = te & 255, jj = te >> 8;
                        u.pm = ee * 64 + jj; u.pn = 2 * ee + (t & 1); u.pk = 0; u.aux = T;
                        pg8::Gemm g{XB, (const bf16_t*)(W + W_WGU), TOK, 8192, 1024, 1024, 1024, (const int*)(ws + WS_ELIST), MCNT}; pg8::OneUnit S{u};
                        pg8::EpiMoeUp2 E{(bf16_t*)(ws + WS_H2), (const float*)(ws + WS_EW)};
                        pg8::gemm_phase<pg8::EpiMoeUp2, pg8::OneUnit, true, true, true>(lds, g, S, E, wave0);
                        asm volatile("s_waitcnt vmcnt(0) lgkmcnt(0)" ::: "memory");
                        __syncthreads();
                        if (wave0 == 0) { unsigned m_ = ~0u; asm volatile("" : "+s"(m_)); if (__builtin_amdgcn_mbcnt_hi(m_, __builtin_amdgcn_mbcnt_lo(m_, 0u)) == 0u) {
                            const int T2 = __builtin_amdgcn_readfirstlane(TW_()[0]) >> 1;
                            __builtin_amdgcn_fence(__ATOMIC_RELEASE, "agent"); asm volatile("s_waitcnt vmcnt(0)" ::: "memory");
                            (void)xb_add(DONE + T2, 1u); } }
                    } else if (t < nmoe + 256) {
                        const int tile = t - nmoe; pg8::StrideOrder S{tile >> 2, tile & 3, 0, 1};
                        {   pg8::Gemm g{XB, (const bf16_t*)(W + W_PLEG), TOK, 1024, 1024, 1024, 1024}; pg8::EpiSigNat E{(bf16_t*)(ws + WS_SG), XF};
                            pg8::gemm_phase<pg8::EpiSigNat, pg8::StrideOrder, true, true>(lds, g, S, E, wave0); }
                        {   pg8::Gemm g{PB, (const bf16_t*)(W + W_PLEP), TOK, 1024, 256, 256, 256}; pg8::EpiPleProj E{(bf16_t*)(ws + WS_SG)};
                            pg8::gemm_phase<pg8::EpiPleProj, pg8::StrideOrder, true, true>(lds, g, S, E, wave0); }
                    } else {
                        const int k = t - nmoe - 256, T = k >> 2, te = __builtin_amdgcn_readfirstlane((int)TT[T]), ee = te & 255, jj = te >> 8;
                        if (wave0 == 0) { unsigned m_ = ~0u; asm volatile("" : "+s"(m_)); if (__builtin_amdgcn_mbcnt_hi(m_, __builtin_amdgcn_mbcnt_lo(m_, 0u)) == 0u) {
                            unsigned* bar = (unsigned*)(ws + WS_CTL + 45056);
                            XB_SPIN(xb_ld(DONE + T) < 2u, bar);
                            __builtin_amdgcn_fence(__ATOMIC_ACQUIRE, "agent"); asm volatile("s_waitcnt vmcnt(0)" ::: "memory"); } }
                        __syncthreads();
                        u.pm = T; u.pn = k & 3; u.pk = ee * 256; u.aux = ee * 64 + jj;
                        pg8::Gemm g{(const bf16_t*)(ws + WS_H2), (const bf16_t*)(W + W_WD), TOK, 1024, 256, 256, 4096}; pg8::OneUnit S{u};
                        pg8::EpiMoeDown E{(bf16_t*)(ws + WS_Y), (const int*)(ws + WS_ELIST), (unsigned)__builtin_amdgcn_readfirstlane(CN[ee])};
                        pg8::gemm_phase<pg8::EpiMoeDown, pg8::OneUnit, true, true>(lds, g, S, E, wave0);
                    }
                }
            }
        }
        SEAM(P + 7);
      }
        if (PHON(10) && RUN(P + 9)) { FRESH();
            if (L >= 0) { ln_rows<false, true, (L == DEPTH - 1)>(XF, a.in[35] + L * 1024, a.in[36] + L * 1024, XB, nullptr, nullptr, nullptr, nullptr, nullptr, (const bf16_t*)(ws + WS_Y), (const bf16_t*)(ws + WS_SG), lds, bid, G, wave0,
#if defined(PROBE_MODE) || defined(PHASE_PROBE)
                (L == DEPTH - 1) ? (const float*)(ws + WS_CTL + (sizeof(PROBE_SEL) ? PROBE_OFF : 0)) : nullptr
#else
                nullptr
#endif
                ); __syncthreads(); }
            else cvt_rows(a.in[0], XB, (size_t)TOK * 1024, bid, G, wave0);
            if (L + 1 < DEPTH) { for (int rep = 0; rep < NREP(10); ++rep) convert_weights(a, ws, L + 1, lds, bid, G, wave0); cvt_rows(a.in[1] + (size_t)(L + 1) * TOK * 256, PB, (size_t)TOK * 256, bid, G, wave0); }
        }
        if (L + 1 < DEPTH) SEAM(P + 9);
}
#undef RUN
#undef SEAM
#undef FRESH

__global__ void __launch_bounds__(NTHREADS, 2) fwd_kernel(Args a) {
    extern __shared__ __attribute__((aligned(16))) unsigned char lds_raw[];
    LAS unsigned char* lds = (LAS unsigned char*)lds_raw;
    const int G0 = gridDim.x, bid0 = blockIdx.x, wave0 = __builtin_amdgcn_readfirstlane(threadIdx.x >> 6);
    const int lo = a.ph_lo, hi = a.ph_hi;
    if (hi - lo > 1) { cg::grid_group grid = cg::this_grid(); grid.sync(); }
    unsigned nbar = xb_xcc_id();
    if (wave0 == 0) { unsigned m = ~0u; asm volatile("" : "+s"(m));
        if (__builtin_amdgcn_mbcnt_hi(m, __builtin_amdgcn_mbcnt_lo(m, 0u)) == 0u) { volatile LAS unsigned* st = (volatile LAS unsigned*)(lds + LDS_BYTES - 16); st[0] = 0u; st[1] = 0u;
            (void)xb_add((unsigned*)(a.ws + WS_CTL + 45056) + XB_XCNT(nbar), 1u); } }
    __syncthreads();
    layer_phases<-1>(a, lds, nbar, G0, bid0, wave0, lo, hi);
    layer_phases<0>(a, lds, nbar, G0, bid0, wave0, lo, hi);
    layer_phases<1>(a, lds, nbar, G0, bid0, wave0, lo, hi);
    static_assert(DEPTH == 2, "layer_phases instantiations");
}

extern "C" void kernel_launch(void* const* d_in, const int* in_sizes, int n_in, void* d_out, int out_size, void* d_ws, size_t ws_size, hipStream_t stream) {
    static int grid = 0;
    if (grid == 0) {
        if (n_in != 37 || out_size != TOK * D_MODEL || ws_size < WS_END) { fprintf(stderr, "kernel_launch: unexpected shapes (n_in %d, out %d, ws %zu < %zu)\n", n_in, out_size, ws_size, (size_t)WS_END); grid = -1; return; }
        int dev = 0, cus = 0, per_cu = 0;
        hipGetDevice(&dev); hipDeviceGetAttribute(&cus, hipDeviceAttributeMultiprocessorCount, dev);
        if (hipFuncSetAttribute((const void*)fwd_kernel, hipFuncAttributeMaxDynamicSharedMemorySize, LDS_BYTES) != hipSuccess) { fprintf(stderr, "kernel_launch: hipFuncSetAttribute failed\n"); grid = -1; return; }
        if (hipOccupancyMaxActiveBlocksPerMultiprocessor(&per_cu, (const void*)fwd_kernel, NTHREADS, LDS_BYTES) != hipSuccess || per_cu < 1) { fprintf(stderr, "kernel_launch: occupancy query says %d blocks per CU\n", per_cu); grid = -1; return; }
        (void)hipGetLastError();
        grid = cus;
    }
    if (grid < 0) return;
    hipMemsetAsync((char*)d_ws + WS_CTL, 0, CTL_ZERO_BYTES, stream);
    Args a{};
    for (int i = 0; i < 37; ++i) a.in[i] = (const float*)d_in[i];
    a.out = (float*)d_out; a.ws = (unsigned char*)d_ws;
#ifndef N_LAUNCH_SPLIT
    a.ph_lo = 0; a.ph_hi = N_PHASES;
    void* args[] = {&a};
    hipError_t e = hipLaunchCooperativeKernel((const void*)fwd_kernel, dim3(grid), dim3(NTHREADS), args, LDS_BYTES, stream);
    if (e != hipSuccess) fprintf(stderr, "cooperative launch failed: %s (grid %d)\n", hipGetErrorString(e), grid);
#else
    for (int p = 0; p < N_PHASES; ++p) { a.ph_lo = p; a.ph_hi = p + 1; void* args[] = {&a};
        hipError_t e = hipLaunchCooperativeKernel((const void*)fwd_kernel, dim3(grid), dim3(NTHREADS), args, LDS_BYTES, stream);
        if (e != hipSuccess) { fprintf(stderr, "launch %d failed: %s\n", p, hipGetErrorString(e)); break; } }
#endif
}
```
